# Optimizing an MI355X kernel written in HIP

```python
import jax, jax.numpy as jnp
from jax import lax
import numpy as np

D_MODEL = 1024
BATCH = 2
SEQ = 16384
DEPTH = 4

PLE_DIM = 256
EPS = 1e-6

A_GROUPS = 8
A_WIDTH = D_MODEL
CONV_WIDTH = 3
B_GROUPS = 8
B_WIDTH = D_MODEL
B_GDIM = B_WIDTH // B_GROUPS
B_CHUNK = 128
EVEN_IN = 4 * A_WIDTH + 3 * B_WIDTH
EVEN_MIX = A_WIDTH + B_WIDTH
EVEN_SPLITS = [A_WIDTH, 2 * A_WIDTH, 3 * A_WIDTH, 4 * A_WIDTH,
               4 * A_WIDTH + B_WIDTH, 4 * A_WIDTH + 2 * B_WIDTH]

C_HEADS = 8
C_DQK = D_MODEL // C_HEADS
C_DV = 2 * D_MODEL // C_HEADS
C_QK = C_HEADS * C_DQK
C_WIDTH = C_HEADS * C_DV
C_CHUNK = 128
ODD_IN = 2 * C_QK + 3 * C_WIDTH + 2 * C_HEADS
ODD_SPLITS = [C_QK, 2 * C_QK, 2 * C_QK + C_WIDTH, 2 * C_QK + 2 * C_WIDTH, 2 * C_QK + 3 * C_WIDTH]

N_EVEN = (DEPTH + 1) // 2
N_ODD = DEPTH // 2

kernel_name = 'hybrid_conv_gmlp_mlstm_trunk'


def rmsnorm(x, g):
    xf = x.astype(jnp.float32)
    y = xf * lax.rsqrt(jnp.mean(xf * xf, axis=-1, keepdims=True) + EPS)
    return (y * g.astype(jnp.float32)).astype(x.dtype)


def layernorm(x, g, b):
    xf = x.astype(jnp.float32)
    mu = jnp.mean(xf, axis=-1, keepdims=True)
    xc = xf - mu
    y = xc * lax.rsqrt(jnp.mean(xc * xc, axis=-1, keepdims=True) + EPS)
    return (y * g.astype(jnp.float32) + b.astype(jnp.float32)).astype(x.dtype)


def causal_short_conv(z, w):
    seq = z.shape[1]
    zp = jnp.pad(z, ((0, 0), (CONV_WIDTH - 1, 0), (0, 0)))
    out = w[CONV_WIDTH - 1] * z
    for j in range(CONV_WIDTH - 1):
        out = out + w[j] * zp[:, j:j + seq]
    return out


def conv_gmlp_mixer(xn, w_in, conv_w, ln_g, ln_b, w_s, b_s, w_out):
    bsz, seq, _ = xn.shape
    n_chunks = seq // B_CHUNK
    proj = xn @ w_in
    a_b, a_c, a_x, a_gate, b_u, b_v, b_gate = jnp.split(proj, EVEN_SPLITS, axis=-1)
    y_a = a_b * causal_short_conv(a_c * a_x, conv_w) * jax.nn.silu(a_gate)
    v = layernorm(b_v, ln_g, ln_b).reshape(bsz, n_chunks, B_CHUNK, B_GROUPS, B_GDIM)
    causal = jnp.tril(jnp.ones((B_CHUNK, B_CHUNK), dtype=bool))
    w_causal = jnp.where(causal, w_s, jnp.zeros_like(w_s))
    s = jnp.einsum('gts,bnsgc->bntgc', w_causal, v) + b_s[None, None, :, :, None]
    y_b = b_u * s.reshape(bsz, seq, B_WIDTH) * jax.nn.silu(b_gate)
    return jnp.concatenate([y_a, y_b], axis=-1) @ w_out


def mlstm_mixer(xn, w_in, b_if, mh_g, w_out):
    bsz, seq, _ = xn.shape
    nc, L, H = seq // C_CHUNK, C_CHUNK, C_HEADS
    f32 = jnp.float32
    proj = xn @ w_in
    q, k, v, o, z, gif = jnp.split(proj, ODD_SPLITS, axis=-1)
    gif = gif.astype(f32) + b_if.astype(f32)
    i_pre = gif[..., :H].reshape(bsz, nc, L, H)
    log_f = jax.nn.log_sigmoid(gif[..., H:]).reshape(bsz, nc, L, H)
    q = q.astype(f32).reshape(bsz, nc, L, H, C_DQK) * (C_DQK ** -0.5)
    k = k.astype(f32).reshape(bsz, nc, L, H, C_DQK)
    v = v.astype(f32).reshape(bsz, nc, L, H, C_DV)

    b = jnp.cumsum(log_f, axis=2)
    g = b[:, :, -1]
    a = g[:, :, None] - b + i_pre

    def chunk_step(carry, xs):
        c_st, n_st, m_st = carry
        k_c, v_c, a_c, g_c = xs
        m_new = jnp.maximum(g_c + m_st, jnp.max(a_c, axis=1))
        decay = jnp.exp(g_c + m_st - m_new)
        w = jnp.exp(a_c - m_new[:, None])
        c_new = decay[..., None, None] * c_st + jnp.einsum('blh,blhk,blhv->bhkv', w, k_c, v_c)
        n_new = decay[..., None] * n_st + jnp.einsum('blh,blhk->bhk', w, k_c)
        return (c_new, n_new, m_new), (c_st, n_st, m_st)

    init = (jnp.zeros((bsz, H, C_DQK, C_DV), f32), jnp.zeros((bsz, H, C_DQK), f32),
            jnp.zeros((bsz, H), f32))
    xs = (jnp.moveaxis(k, 1, 0), jnp.moveaxis(v, 1, 0), jnp.moveaxis(a, 1, 0), jnp.moveaxis(g, 1, 0))
    _, (c_all, n_all, m_all) = lax.scan(chunk_step, init, xs)
    c_all = jnp.moveaxis(c_all, 0, 1)
    n_all = jnp.moveaxis(n_all, 0, 1)
    m_all = jnp.moveaxis(m_all, 0, 1)

    bt = jnp.moveaxis(b, 3, 2)
    it = jnp.moveaxis(i_pre, 3, 2)
    causal = jnp.tril(jnp.ones((L, L), dtype=bool))
    d = jnp.where(causal, bt[..., :, None] - bt[..., None, :] + it[..., None, :], -jnp.inf)
    m_inter = bt + m_all[..., None]
    m_t = jnp.maximum(m_inter, jnp.max(d, axis=-1))
    p_mat = jnp.exp(d - m_t[..., None]) * jnp.einsum('bnthk,bnshk->bnhts', q, k)
    inter_scale = jnp.exp(m_inter - m_t)
    num = (inter_scale[..., None] * jnp.einsum('bnthk,bnhkv->bnhtv', q, c_all)
           + jnp.einsum('bnhts,bnshv->bnhtv', p_mat, v))
    den = inter_scale * jnp.einsum('bnthk,bnhk->bnht', q, n_all) + jnp.sum(p_mat, axis=-1)
    hc = num / jnp.maximum(jnp.abs(den), jnp.exp(-m_t))[..., None]
    hc = hc * lax.rsqrt(jnp.mean(hc * hc, axis=-1, keepdims=True) + EPS) * mh_g.astype(f32)[:, None, :]
    hc = jnp.moveaxis(hc, 2, 3).reshape(bsz, seq, C_WIDTH).astype(xn.dtype)
    y = hc * jax.nn.sigmoid(o) * jax.nn.silu(z)
    return y @ w_out


def setup_inputs(seed: int = 0) -> dict:
    key = jax.random.key(seed)
    ks = jax.random.split(key, 20)

    def nrm(k, shape, scale):
        return scale * jax.random.normal(k, shape, jnp.float32)

    f_bias = jnp.linspace(3.0, 6.0, C_HEADS, dtype=jnp.float32)
    b_if = jnp.concatenate([nrm(ks[16], (N_ODD, C_HEADS), 0.1),
                            f_bias[None, :] + nrm(ks[17], (N_ODD, C_HEADS), 0.1)], axis=-1)
    return {
        'x': nrm(ks[0], (BATCH, SEQ, D_MODEL), 1.0),
        'p': nrm(ks[1], (DEPTH, BATCH, SEQ, PLE_DIM), 1.0),
        'pre_g': 1.0 + nrm(ks[2], (DEPTH, D_MODEL), 0.02),
        'post_g': 1.0 + nrm(ks[3], (DEPTH, D_MODEL), 0.02),
        'ple_g': 1.0 + nrm(ks[4], (DEPTH, D_MODEL), 0.02),
        'w_ple': nrm(ks[5], (DEPTH, PLE_DIM, D_MODEL), PLE_DIM ** -0.5),
        'w_ple_gate': nrm(ks[6], (DEPTH, D_MODEL, D_MODEL), D_MODEL ** -0.5),
        'even_w_in': nrm(ks[7], (N_EVEN, D_MODEL, EVEN_IN), D_MODEL ** -0.5),
        'even_conv_w': nrm(ks[8], (N_EVEN, CONV_WIDTH, A_WIDTH), CONV_WIDTH ** -0.5),
        'even_ln_g': 1.0 + nrm(ks[9], (N_EVEN, B_WIDTH), 0.02),
        'even_ln_b': nrm(ks[10], (N_EVEN, B_WIDTH), 0.02),
        'even_w_s': nrm(ks[11], (N_EVEN, B_GROUPS, B_CHUNK, B_CHUNK), B_CHUNK ** -0.5),
        'even_b_s': nrm(ks[12], (N_EVEN, B_CHUNK, B_GROUPS), 0.1),
        'even_w_out': nrm(ks[13], (N_EVEN, EVEN_MIX, D_MODEL), EVEN_MIX ** -0.5),
        'odd_w_in': nrm(ks[14], (N_ODD, D_MODEL, ODD_IN), D_MODEL ** -0.5),
        'odd_b_if': b_if,
        'odd_mh_g': 1.0 + nrm(ks[15], (N_ODD, C_HEADS, C_DV), 0.02),
        'odd_w_out': nrm(ks[18], (N_ODD, C_WIDTH, D_MODEL), C_WIDTH ** -0.5),
    }


def reference(x, p, pre_g, post_g, ple_g, w_ple, w_ple_gate, even_w_in, even_conv_w, even_ln_g,
              even_ln_b, even_w_s, even_b_s, even_w_out, odd_w_in, odd_b_if, odd_mh_g, odd_w_out):
    h = x
    for i in range(DEPTH):
        j = i // 2
        xn = rmsnorm(h, pre_g[i])
        if i % 2 == 0:
            y = conv_gmlp_mixer(xn, even_w_in[j], even_conv_w[j], even_ln_g[j], even_ln_b[j],
                                even_w_s[j], even_b_s[j], even_w_out[j])
        else:
            y = mlstm_mixer(xn, odd_w_in[j], odd_b_if[j], odd_mh_g[j], odd_w_out[j])
        h = h + rmsnorm(y, post_g[i])
        gate = jax.nn.sigmoid(rmsnorm(h, ple_g[i]) @ w_ple_gate[i])
        h = h + gate * (p[i] @ w_ple[i])
    return h
```

```cpp
#include <hip/hip_runtime.h>
#include <cstdio>
#include <cstdint>
namespace pg8 {
#define PG8_LAS __attribute__((address_space(3)))
typedef unsigned short bf16_t;
typedef short bf16x8 __attribute__((ext_vector_type(8)));
typedef float f32x4 __attribute__((ext_vector_type(4)));
typedef unsigned u32x4 __attribute__((ext_vector_type(4)));
constexpr int BM = 256, BK = 64, HALF = 128, HTB = HALF * BK * 2  , STAGE_BYTES = 8 * HTB, NXCD = 8, WGM = 8;

__host__ __device__ __forceinline__ int lds_byte(int r, int c) { const int st = (r >> 4) * 2 + (c >> 5), rr = r & 15, cc = c & 31, ob = rr * 64 + cc * 2; return st * 1024 + (ob ^ (((ob >> 9) & 1) << 5)); }
__host__ __device__ __forceinline__ void stage_rc(int b, int& R, int& C) { const int st = b / 1024, sb = b % 1024, swz = sb ^ (((sb >> 9) & 1) << 5); R = (st >> 1) * 16 + swz / 64; C = (st & 1) * 32 + (swz % 64) / 2; }
__host__ __device__ __forceinline__ int perm32(int rho) { const int n = rho >> 4, i = rho & 15; return 8 * (i >> 2) + 4 * n + (i & 3); }

struct Unit { int pm, pn; };
struct Gemm { const bf16_t* A; const bf16_t* Bt; int M, N, K; };

struct StaticOrder {
    int nM, nN, nwg, G, c;
    __host__ __device__ void init(int M, int N, int G_, int c_) { nM = M / BM; nN = N / BM; nwg = nM * nN; G = G_; c = c_; }
    __host__ __device__ bool next(int i, Unit& u) const {
        const long L = (long)i * G + c; if (L >= nwg) return false;
        int wgid = (int)L; { const int q = nwg / NXCD, r = nwg % NXCD, xcd = wgid % NXCD, off = wgid / NXCD; wgid = (xcd < r ? xcd * (q + 1) : r * (q + 1) + (xcd - r) * q) + off; }
        const int nig = WGM * nN, gid = wgid / nig, fm = gid * WGM, gsz = (nM - fm) < WGM ? (nM - fm) : WGM;
        u.pm = fm + ((wgid % nig) % gsz); u.pn = (wgid % nig) / gsz; return true;
    }
    __device__ __forceinline__ void a_ready(const Unit&) const {}
    __device__ __forceinline__ void done(const Unit&) const {}
};
__device__ __forceinline__ unsigned cvt_pk_bf16(float lo, float hi) { unsigned r; asm volatile("v_cvt_pk_bf16_f32 %0, %1, %2" : "=v"(r) : "v"(lo), "v"(hi)); return r; }
typedef float f32x2 __attribute__((ext_vector_type(2)));
template <class Epi, class Sched, bool STAMP = false>
__device__ __forceinline__ void gemm_phase(PG8_LAS unsigned char* lds, const Gemm g, const Sched& S, const Epi& E, unsigned long long* stamps) {
    int tid_l_ = threadIdx.x; asm volatile("" : "+v"(tid_l_));
    const int tid = tid_l_, wid = __builtin_amdgcn_readfirstlane(tid >> 6), lane = tid & 63, wr = wid >> 2, wc = wid & 3, fr = lane & 15, fq = lane >> 4;
    const int K = g.K, nt = K / BK;
    int ts_lo = 0, ts_hi = 0, nts = 0; const unsigned long long rt_entry = STAMP ? (unsigned long long)wall_clock64() : 0ull;
#define PG8_STAMP() do { if (STAMP && wid == 0 && nts < 64) { const unsigned long long _c = (unsigned long long)clock64(); \
        ts_lo = (lane == nts) ? (int)(unsigned)_c : ts_lo; ts_hi = (lane == nts) ? (int)(unsigned)(_c >> 32) : ts_hi; ++nts; } } while (0)
    PG8_STAMP();
    unsigned voffA[2], voffB[2];
#pragma unroll
    for (int i = 0; i < 2; ++i) { int R, C; stage_rc(tid * 16 + i * 8192, R, C); const int Rb = Epi::PERM ? ((R & ~31) + perm32(R & 31)) : R;
        voffA[i] = (unsigned)(R * K + C) * 2u; voffB[i] = (unsigned)(Rb * K + C) * 2u; }
    const size_t kstep = (size_t)(BK * 2);
    const size_t hstep = (size_t)HALF * K * 2;
    const size_t tstep = 2 * hstep;
    const unsigned ldsw = (unsigned)wid * 1024u;
    const int aoff = lds_byte(wr * 64 + fr, fq * 8), boff = lds_byte(wc * 32 + fr, fq * 8);
#define PG8_SA(b, h) (((b) * 2 + (h)) * HTB)
#define PG8_SB(b, h) ((4 + (b) * 2 + (h)) * HTB)
#define PG8_STAGE(bufoff, gbase, voff) do { _Pragma("unroll") for (int _i = 0; _i < 2; ++_i) \
        __builtin_amdgcn_global_load_lds((const unsigned*)((const char*)(gbase) + (voff)[_i]), (PG8_LAS unsigned*)(lds + (bufoff) + ldsw + _i * 8192), 16, 0, 0); } while (0)
#define PG8_LDA(dst, b, h) do { _Pragma("unroll") for (int m = 0; m < 4; ++m) _Pragma("unroll") for (int k = 0; k < 2; ++k) dst[m][k] = *(const PG8_LAS bf16x8*)(lds + PG8_SA(b, h) + aoff + m * 2048 + k * 1024); } while (0)
#define PG8_LDB(dst, b, h) do { _Pragma("unroll") for (int n = 0; n < 2; ++n) _Pragma("unroll") for (int k = 0; k < 2; ++k) dst[n][k] = *(const PG8_LAS bf16x8*)(lds + PG8_SB(b, h) + boff + n * 2048 + k * 1024); } while (0)
#define PG8_MMA(ai, bj, At, Bt) do { __builtin_amdgcn_s_setprio(1); _Pragma("unroll") for (int m = 0; m < 4; ++m) _Pragma("unroll") for (int n = 0; n < 2; ++n) _Pragma("unroll") for (int k = 0; k < 2; ++k) \
        acc[ai][bj][m][n] = __builtin_amdgcn_mfma_f32_16x16x32_bf16(Bt[n][k], At[m][k], acc[ai][bj][m][n], 0, 0, 0); __builtin_amdgcn_s_setprio(0); } while (0)
#define PG8_WAIT_V(n) asm volatile("s_waitcnt vmcnt(" #n ")" ::: "memory")
#define PG8_WAIT_L(n) asm volatile("s_waitcnt lgkmcnt(" #n ")" ::: "memory")
#define PG8_BAR __builtin_amdgcn_s_barrier()
#define PG8_SCHED __builtin_amdgcn_sched_barrier(0)
    Unit cur, nxt; int ui = 0;
    if (!S.next(0, cur)) return;
    f32x4 acc[2][2][4][2];
#pragma unroll
    for (int a = 0; a < 2; ++a)
#pragma unroll
        for (int b = 0; b < 2; ++b)
#pragma unroll
            for (int m = 0; m < 4; ++m)
#pragma unroll
                for (int n = 0; n < 2; ++n) acc[a][b][m][n] = (f32x4){0.f, 0.f, 0.f, 0.f};
    bf16x8 At[4][2], B0[2][2], B1[2][2];
    const char* cA = (const char*)g.A + (size_t)cur.pm * tstep; const char* cB = (const char*)g.Bt + (size_t)cur.pn * tstep;
    S.a_ready(cur);
    PG8_STAGE(PG8_SB(0, 0), cB, voffB); PG8_STAGE(PG8_SA(0, 0), cA, voffA); PG8_STAGE(PG8_SB(0, 1), cB + hstep, voffB); PG8_STAGE(PG8_SA(0, 1), cA + hstep, voffA);
    if (wr == 1) PG8_BAR;
    PG8_WAIT_V(4); PG8_BAR;
    PG8_STAGE(PG8_SB(1, 0), cB + kstep, voffB); PG8_STAGE(PG8_SA(1, 0), cA + kstep, voffA); PG8_STAGE(PG8_SB(1, 1), cB + hstep + kstep, voffB);
    PG8_WAIT_V(6); PG8_BAR;
    PG8_STAMP();
    for (;;) {
        const bool has_next = S.next(ui + 1, nxt);
        const char* nA = has_next ? (const char*)g.A + (size_t)nxt.pm * tstep : cA; const char* nB = has_next ? (const char*)g.Bt + (size_t)nxt.pn * tstep : cB;
        for (int t = 0; t < nt; t += 2) {
            const bool last = (t == nt - 2);
            const char* a1 = cA + (size_t)(t + 1) * kstep;
            const char* a2 = last ? nA : cA + (size_t)(t + 2) * kstep; const char* b2 = last ? nB : cB + (size_t)(t + 2) * kstep;
            const char* a3 = a2 + kstep; const char* b3 = b2 + kstep;
            if (last && has_next) S.a_ready(nxt);
            PG8_LDB(B0, 0, 0); PG8_SCHED; PG8_LDA(At, 0, 0); PG8_STAGE(PG8_SA(1, 1), a1 + hstep, voffA);
            PG8_WAIT_L(8); PG8_BAR; PG8_WAIT_L(0); PG8_MMA(0, 0, At, B0); PG8_BAR; PG8_SCHED;
            PG8_LDB(B1, 0, 1); PG8_STAGE(PG8_SB(0, 0), b2, voffB);
            PG8_BAR; PG8_WAIT_L(0); PG8_MMA(0, 1, At, B1); PG8_BAR;
            PG8_LDA(At, 0, 1); PG8_STAGE(PG8_SA(0, 0), a2, voffA);
            PG8_BAR; PG8_WAIT_L(0); PG8_MMA(1, 0, At, B0); PG8_BAR; PG8_SCHED;
            PG8_STAGE(PG8_SB(0, 1), b2 + hstep, voffB);
            PG8_WAIT_V(6); PG8_BAR; PG8_MMA(1, 1, At, B1); PG8_BAR;
            PG8_LDB(B0, 1, 0); PG8_SCHED; PG8_LDA(At, 1, 0); PG8_STAGE(PG8_SA(0, 1), a2 + hstep, voffA);
            PG8_WAIT_L(8); PG8_BAR; PG8_WAIT_L(0); PG8_MMA(0, 0, At, B0); PG8_BAR; PG8_SCHED;
            PG8_LDB(B1, 1, 1); PG8_STAGE(PG8_SB(1, 0), b3, voffB);
            PG8_BAR; PG8_WAIT_L(0); PG8_MMA(0, 1, At, B1); PG8_BAR;
            PG8_LDA(At, 1, 1); PG8_STAGE(PG8_SA(1, 0), a3, voffA);
            PG8_BAR; PG8_WAIT_L(0); PG8_MMA(1, 0, At, B0); PG8_BAR; PG8_SCHED;
            PG8_STAGE(PG8_SB(1, 1), b3 + hstep, voffB);
            PG8_WAIT_V(6); PG8_BAR; PG8_MMA(1, 1, At, B1); PG8_BAR;
        }
        PG8_STAMP();
        if constexpr (!Epi::AFTER_DRAIN) { E(acc, cur, wr, wc, fr, fq); S.done(cur); }
        PG8_STAMP();
        if (!has_next) break;
#pragma unroll
        for (int a = 0; a < 2; ++a)
#pragma unroll
            for (int b = 0; b < 2; ++b)
#pragma unroll
                for (int m = 0; m < 4; ++m)
#pragma unroll
                    for (int n = 0; n < 2; ++n) acc[a][b][m][n] = (f32x4){0.f, 0.f, 0.f, 0.f};
        cur = nxt; cA = nA; cB = nB; ++ui;
    }
    PG8_WAIT_V(0);
    if (wr == 0) PG8_BAR;
    PG8_BAR;
    if constexpr (Epi::AFTER_DRAIN) { E.fused(acc, cur, wr, wc, fr, fq, lds, wid, lane); S.done(cur); }
    PG8_STAMP();
    if (STAMP && wid == 0) { stamps[lane] = lane < nts ? (((unsigned long long)(unsigned)ts_hi << 32) | (unsigned)ts_lo) : 0ull;
        if (lane == 62) stamps[62] = rt_entry; if (lane == 63) stamps[63] = (unsigned long long)wall_clock64(); }
#undef PG8_STAMP
#undef PG8_SA
#undef PG8_SB
#undef PG8_STAGE
#undef PG8_LDA
#undef PG8_LDB
#undef PG8_MMA
#undef PG8_WAIT_V
#undef PG8_WAIT_L
#undef PG8_BAR
#undef PG8_SCHED
}
}
#define XB_TMO      128
#define XB_XCNT(j)  (256  + 64 * (j))
#define XB_XSUB(j)  (1280 + 64 * (j))
#define XB_XGEN(j)  (2304 + 64 * (j))
#define XB_TOP      3328
#define XB_TOPGEN   3392
#define XCD_BAR_WORDS 3456
#define XB_SPIN_CAP (1u << 18)
#define LAS __attribute__((address_space(3)))

__device__ __forceinline__ unsigned xb_ld(unsigned* p)              { return __hip_atomic_load(p, __ATOMIC_RELAXED, __HIP_MEMORY_SCOPE_AGENT); }
__device__ __forceinline__ unsigned xb_add(unsigned* p, unsigned v) { return __hip_atomic_fetch_add(p, v, __ATOMIC_RELAXED, __HIP_MEMORY_SCOPE_AGENT); }
__device__ __forceinline__ unsigned xb_xcc_id() { return (unsigned)__builtin_amdgcn_s_getreg((3 << 11) | 20) & 0xFu; }
#define XB_SPIN(cond, bar) do { unsigned _sp = 0; while (cond) { __builtin_amdgcn_s_sleep(1); \
    if ((++_sp & 255u) == 0u) { if (xb_ld(&(bar)[XB_TMO])) break; if (_sp > XB_SPIN_CAP) { atomicAdd(&(bar)[XB_TMO], 1u); break; } } } } while (0)

struct XcdBarrier {
    unsigned* bar; unsigned x;
    volatile LAS unsigned* st;
};

__device__ __forceinline__ XcdBarrier xcd_barrier_post(unsigned* bar, volatile LAS unsigned* st) {
    XcdBarrier b; b.bar = bar; b.x = xb_xcc_id(); b.st = st;
    if (threadIdx.x == 0) (void)xb_add(&bar[XB_XCNT(b.x)], 1u);
    return b;
}
__device__ __forceinline__ void xcd_barrier_complete(unsigned* bar, unsigned x, unsigned& nloc, unsigned& nx) {
    const unsigned G = gridDim.x * gridDim.y * gridDim.z;
    unsigned sum, cnt, mine, sp = 0u;
    for (;;) {
        sum = 0u; cnt = 0u; mine = 0u;
#pragma unroll
        for (unsigned j = 0; j < 16; ++j) { const unsigned c = xb_ld(&bar[XB_XCNT(j)]); sum += c; cnt += (c > 0u) ? 1u : 0u; mine = (j == x) ? c : mine; }
        if (sum == G) break;
        __builtin_amdgcn_s_sleep(1);
        if ((++sp & 255u) == 0u) { if (xb_ld(&bar[XB_TMO])) break; if (sp > XB_SPIN_CAP) { atomicAdd(&bar[XB_TMO], 1u); break; } }
    }
    nloc = mine > 0u ? mine : 1u; nx = cnt > 0u ? cnt : 1u;
}

__device__ __forceinline__ void xcd_barrier(const XcdBarrier& b) {
    asm volatile("s_waitcnt vmcnt(0)" ::: "memory");
    __syncthreads();
    if (threadIdx.x == 0) {
        unsigned* bar = b.bar;
        __builtin_amdgcn_s_waitcnt(0);
        unsigned nloc = b.st[0], nx = b.st[1];
        if (nloc == 0u) { xcd_barrier_complete(bar, b.x, nloc, nx); b.st[0] = nloc; b.st[1] = nx; }
        const unsigned old = xb_add(&bar[XB_XSUB(b.x)], 1u);
        const unsigned gen = old / nloc;
        if (old + 1u == (gen + 1u) * nloc) {
            __builtin_amdgcn_fence(__ATOMIC_RELEASE, "agent");
            asm volatile("s_waitcnt vmcnt(0)" ::: "memory");
            const unsigned og = xb_add(&bar[XB_TOP], 1u);
            const unsigned tg = og / nx;
            if (og + 1u == (tg + 1u) * nx) xb_add(&bar[XB_TOPGEN], 1u);
            else XB_SPIN(xb_ld(&bar[XB_TOPGEN]) == tg, bar);
            __builtin_amdgcn_fence(__ATOMIC_ACQUIRE, "agent");
            xb_add(&bar[XB_XGEN(b.x)], 1u);
            asm volatile("s_waitcnt vmcnt(0)" ::: "memory");
        } else {
            XB_SPIN(xb_ld(&bar[XB_XGEN(b.x)]) == gen, bar);
            __builtin_amdgcn_fence(__ATOMIC_ACQUIRE, "agent");
            asm volatile("s_waitcnt vmcnt(0)" ::: "memory");
        }
    }
    __syncthreads();
}


typedef unsigned short bf16_t;
typedef float f32x4 __attribute__((ext_vector_type(4)));
typedef unsigned u32x4 __attribute__((ext_vector_type(4)));
typedef unsigned u32x2 __attribute__((ext_vector_type(2)));
constexpr int DM = 1024, NBATCH = 2, SEQ = 16384, M = NBATCH * SEQ, DEPTH = 4, PLE = 256;
constexpr float EPS = 1e-6f;
constexpr int EVEN_IN = 7168, ODD_IN = 8208;
constexpr int N1A_E = 3072, N1B_E = 4096, N1A_O = 4352, N1B_O = 4096;
constexpr int NUNIT_O = 2048;
constexpr int LDS_BYTES = 147456;
constexpr int LDS_BAR_OFF = LDS_BYTES - 16;

constexpr size_t MiB = 1u << 20;
constexpr size_t WS_CTL = 0, CTL_BYTES = 64 * 1024;
constexpr size_t WS_SSQA = 1 * MiB, WS_SSQY = 3 * MiB, WS_RSTD1 = 5 * MiB, WS_GATE = 6 * MiB, WS_GB = 8 * MiB, WS_CS = 10 * MiB, WS_MS = 10 * MiB + 65536, WS_NS = 11 * MiB;
constexpr size_t WS_WG = 12 * MiB, WS_WP = 20 * MiB, WS_WIN = 22 * MiB, WS_WOUT = 39 * MiB;
constexpr size_t WS_HBA = 44 * MiB, WS_R1 = 108 * MiB, WS_R2 = 172 * MiB, WS_R3 = 236 * MiB, WS_R4 = 364 * MiB, WS_END = 492 * MiB;

__device__ __forceinline__ float bf2f(bf16_t b) { return __uint_as_float(((unsigned)b) << 16); }
__device__ __forceinline__ bf16_t f2bf(float f) { unsigned u = __float_as_uint(f); u += 0x7FFFu + ((u >> 16) & 1u); return (bf16_t)(u >> 16); }
__device__ __forceinline__ unsigned pk2(float lo, float hi) { return pg8::cvt_pk_bf16(lo, hi); }
__device__ __forceinline__ void unpack8(const u32x4 w, float (&f)[8]) {
    f[0] = __uint_as_float(w.x << 16); f[1] = __uint_as_float(w.x & 0xffff0000u); f[2] = __uint_as_float(w.y << 16); f[3] = __uint_as_float(w.y & 0xffff0000u);
    f[4] = __uint_as_float(w.z << 16); f[5] = __uint_as_float(w.z & 0xffff0000u); f[6] = __uint_as_float(w.w << 16); f[7] = __uint_as_float(w.w & 0xffff0000u);
}
__device__ __forceinline__ u32x4 pack8(const float (&f)[8]) { u32x4 w; w.x = pk2(f[0], f[1]); w.y = pk2(f[2], f[3]); w.z = pk2(f[4], f[5]); w.w = pk2(f[6], f[7]); return w; }
__device__ __forceinline__ float sigmoidf_(float x) { return __builtin_amdgcn_rcpf(1.0f + __expf(-x)); }
__device__ __forceinline__ float siluf_(float x) { return x * sigmoidf_(x); }
__device__ __forceinline__ float logsigmoidf_(float x) { return fminf(x, 0.f) - log1pf(__expf(-fabsf(x))); }
__device__ __forceinline__ float wave_sum(float s) { s += __shfl_xor(s, 1); s += __shfl_xor(s, 2); s += __shfl_xor(s, 4); s += __shfl_xor(s, 8); s += __shfl_xor(s, 16); s += __shfl_xor(s, 32); return s; }
__device__ __forceinline__ float rstd16(const float* p) {
    const f32x4 a = *(const f32x4*)p, b = *(const f32x4*)(p + 4), c = *(const f32x4*)(p + 8), d = *(const f32x4*)(p + 12);
    const float s = ((a[0] + a[1]) + (a[2] + a[3])) + ((b[0] + b[1]) + (b[2] + b[3])) + ((c[0] + c[1]) + (c[2] + c[3])) + ((d[0] + d[1]) + (d[2] + d[3]));
    return rsqrtf(s * (1.0f / 1024.0f) + EPS);
}

namespace pg8 {
#define EPI_ROWS_BEGIN  _Pragma("unroll") for (int ai = 0; ai < 2; ++ai) _Pragma("unroll") for (int m = 0; m < 4; ++m) { const int row = rowb + ai * HALF + m * 16;
#define EPI_ROWS_END    asm volatile("" ::: "memory"); }
struct EpiE1a { static constexpr bool PERM = true, AFTER_DRAIN = false;
    const float* ssq; bf16_t* U; bf16_t* BV;
    __device__ __forceinline__ void operator()(const f32x4 (&acc)[2][2][4][2], const Unit& u, int wr, int wc, int fr, int fq) const {
        const int rowb = u.pm * BM + wr * 64 + fr, cw = wc * 32 + 8 * fq;
        EPI_ROWS_BEGIN
            const float rs = rstd16(ssq + (size_t)row * 16);
            if (u.pn < 8) {
                const f32x4 p0 = (acc[ai][0][m][0] * rs) * (acc[ai][1][m][0] * rs), p1 = (acc[ai][0][m][1] * rs) * (acc[ai][1][m][1] * rs);
                u32x4 w; w.x = cvt_pk_bf16(p0[0], p0[1]); w.y = cvt_pk_bf16(p0[2], p0[3]); w.z = cvt_pk_bf16(p1[0], p1[1]); w.w = cvt_pk_bf16(p1[2], p1[3]);
                *(u32x4*)(U + (size_t)row * 1024 + u.pn * 128 + cw) = w;
            } else {
#pragma unroll
                for (int bj = 0; bj < 2; ++bj) { const f32x4 v0 = acc[ai][bj][m][0] * rs, v1 = acc[ai][bj][m][1] * rs;
                    u32x4 w; w.x = cvt_pk_bf16(v0[0], v0[1]); w.y = cvt_pk_bf16(v0[2], v0[3]); w.z = cvt_pk_bf16(v1[0], v1[1]); w.w = cvt_pk_bf16(v1[2], v1[3]);
                    *(u32x4*)(BV + (size_t)row * 1024 + (u.pn - 8) * 256 + bj * HALF + cw) = w; }
            }
        EPI_ROWS_END
    }
};
struct EpiE1b { static constexpr bool PERM = true, AFTER_DRAIN = false;
    const float* ssq; const bf16_t* U; const bf16_t* S; const float* convw; bf16_t* MIX;
    __device__ __forceinline__ void operator()(const f32x4 (&acc)[2][2][4][2], const Unit& u, int wr, int wc, int fr, int fq) const {
        const int rowb = u.pm * BM + wr * 64 + fr, cw = wc * 32 + 8 * fq;
        if (u.pn < 8) {
            const int ch0 = u.pn * 128 + cw;
            float w0[8], w1[8], w2[8];
#pragma unroll
            for (int j = 0; j < 8; ++j) { w0[j] = convw[ch0 + j]; w1[j] = convw[1024 + ch0 + j]; w2[j] = convw[2048 + ch0 + j]; }
            EPI_ROWS_BEGIN
                const float rs = rstd16(ssq + (size_t)row * 16);
                const int ts = row & (SEQ - 1);
                const bf16_t* up = U + (size_t)row * 1024 + ch0;
                float u0[8], u1[8], u2[8];
                unpack8(*(const u32x4*)up, u2);
                if (ts >= 1) unpack8(*(const u32x4*)(up - 1024), u1); else {
#pragma unroll
                    for (int j = 0; j < 8; ++j) u1[j] = 0.f; }
                if (ts >= 2) unpack8(*(const u32x4*)(up - 2048), u0); else {
#pragma unroll
                    for (int j = 0; j < 8; ++j) u0[j] = 0.f; }
                float o[8];
#pragma unroll
                for (int j = 0; j < 8; ++j) { const float ab = acc[ai][0][m][j >> 2][j & 3] * rs, ag = acc[ai][1][m][j >> 2][j & 3] * rs;
                    o[j] = ab * siluf_(ag) * (w2[j] * u2[j] + w1[j] * u1[j] + w0[j] * u0[j]); }
                *(u32x4*)(MIX + (size_t)row * 2048 + ch0) = pack8(o);
            EPI_ROWS_END
        } else {
            const int ch0 = (u.pn - 8) * 128 + cw;
            EPI_ROWS_BEGIN
                const float rs = rstd16(ssq + (size_t)row * 16);
                float sv[8]; unpack8(*(const u32x4*)(S + (size_t)row * 1024 + ch0), sv);
                float o[8];
#pragma unroll
                for (int j = 0; j < 8; ++j) { const float bu = acc[ai][0][m][j >> 2][j & 3] * rs, bg = acc[ai][1][m][j >> 2][j & 3] * rs; o[j] = bu * siluf_(bg) * sv[j]; }
                *(u32x4*)(MIX + (size_t)row * 2048 + 1024 + ch0) = pack8(o);
            EPI_ROWS_END
        }
    }
};
struct EpiO1a { static constexpr bool PERM = true, AFTER_DRAIN = false;
    const float* ssq; bf16_t* Q; bf16_t* K; bf16_t* V; float* GATE;
    __device__ __forceinline__ void operator()(const f32x4 (&acc)[2][2][4][2], const Unit& u, int wr, int wc, int fr, int fq) const {
        const int rowb = u.pm * BM + wr * 64 + fr, cw = wc * 32 + 8 * fq;
        if (u.pn < 16) {
            bf16_t* base; int ld, c0;
            if (u.pn < 4) { base = Q; ld = 1024; c0 = u.pn * 256; } else if (u.pn < 8) { base = K; ld = 1024; c0 = (u.pn - 4) * 256; } else { base = V; ld = 2048; c0 = (u.pn - 8) * 256; }
            EPI_ROWS_BEGIN
                const float rs = rstd16(ssq + (size_t)row * 16);
#pragma unroll
                for (int bj = 0; bj < 2; ++bj) { const f32x4 v0 = acc[ai][bj][m][0] * rs, v1 = acc[ai][bj][m][1] * rs;
                    u32x4 w; w.x = cvt_pk_bf16(v0[0], v0[1]); w.y = cvt_pk_bf16(v0[2], v0[3]); w.z = cvt_pk_bf16(v1[0], v1[1]); w.w = cvt_pk_bf16(v1[2], v1[3]);
                    *(u32x4*)(base + (size_t)row * ld + c0 + bj * HALF + cw) = w; }
            EPI_ROWS_END
        } else if (wc == 0 && fq < 2) {
            EPI_ROWS_BEGIN
                const float rs = rstd16(ssq + (size_t)row * 16);
                *(f32x4*)(GATE + (size_t)row * 16 + 8 * fq) = acc[ai][0][m][0] * rs;
                *(f32x4*)(GATE + (size_t)row * 16 + 8 * fq + 4) = acc[ai][0][m][1] * rs;
            EPI_ROWS_END
        }
    }
};
struct EpiO1b { static constexpr bool PERM = true, AFTER_DRAIN = false;
    const float* ssq; const bf16_t* HC; bf16_t* MIX;
    __device__ __forceinline__ void operator()(const f32x4 (&acc)[2][2][4][2], const Unit& u, int wr, int wc, int fr, int fq) const {
        const int rowb = u.pm * BM + wr * 64 + fr, ch0 = u.pn * 128 + wc * 32 + 8 * fq;
        EPI_ROWS_BEGIN
            const float rs = rstd16(ssq + (size_t)row * 16);
            float hv[8]; unpack8(*(const u32x4*)(HC + (size_t)row * 2048 + ch0), hv);
            float o[8];
#pragma unroll
            for (int j = 0; j < 8; ++j) { const float oo = acc[ai][0][m][j >> 2][j & 3] * rs, zz = acc[ai][1][m][j >> 2][j & 3] * rs; o[j] = hv[j] * sigmoidf_(oo) * siluf_(zz); }
            *(u32x4*)(MIX + (size_t)row * 2048 + ch0) = pack8(o);
        EPI_ROWS_END
    }
};
struct EpiOut { static constexpr bool PERM = true, AFTER_DRAIN = false;
    bf16_t* Y; float* SSQ;
    __device__ __forceinline__ void operator()(const f32x4 (&acc)[2][2][4][2], const Unit& u, int wr, int wc, int fr, int fq) const {
        const int rowb = u.pm * BM + wr * 64 + fr, cw = wc * 32 + 8 * fq;
        EPI_ROWS_BEGIN
            float s = 0.f;
#pragma unroll
            for (int bj = 0; bj < 2; ++bj) { const f32x4 v0 = acc[ai][bj][m][0], v1 = acc[ai][bj][m][1];
                s += (v0[0] * v0[0] + v0[1] * v0[1]) + (v0[2] * v0[2] + v0[3] * v0[3]) + (v1[0] * v1[0] + v1[1] * v1[1]) + (v1[2] * v1[2] + v1[3] * v1[3]);
                u32x4 w; w.x = cvt_pk_bf16(v0[0], v0[1]); w.y = cvt_pk_bf16(v0[2], v0[3]); w.z = cvt_pk_bf16(v1[0], v1[1]); w.w = cvt_pk_bf16(v1[2], v1[3]);
                *(u32x4*)(Y + (size_t)row * 1024 + u.pn * 256 + bj * HALF + cw) = w; }
            s += __shfl_xor(s, 16); s += __shfl_xor(s, 32);
            if (fq == 0) SSQ[(size_t)row * 16 + u.pn * 4 + wc] = s;
        EPI_ROWS_END
    }
};
struct EpiPw { static constexpr bool PERM = true, AFTER_DRAIN = false;
    bf16_t* PW;
    __device__ __forceinline__ void operator()(const f32x4 (&acc)[2][2][4][2], const Unit& u, int wr, int wc, int fr, int fq) const {
        const int rowb = u.pm * BM + wr * 64 + fr, cw = wc * 32 + 8 * fq;
        EPI_ROWS_BEGIN
#pragma unroll
            for (int bj = 0; bj < 2; ++bj) { const f32x4 v0 = acc[ai][bj][m][0], v1 = acc[ai][bj][m][1];
                u32x4 w; w.x = cvt_pk_bf16(v0[0], v0[1]); w.y = cvt_pk_bf16(v0[2], v0[3]); w.z = cvt_pk_bf16(v1[0], v1[1]); w.w = cvt_pk_bf16(v1[2], v1[3]);
                *(u32x4*)(PW + (size_t)row * 1024 + u.pn * 256 + bj * HALF + cw) = w; }
        EPI_ROWS_END
    }
};
struct EpiGate { static constexpr bool PERM = true, AFTER_DRAIN = false;
    const float* RSTD1; const bf16_t* PW; float* H; bf16_t* HB; float* SSQ;
    __device__ __forceinline__ void operator()(const f32x4 (&acc)[2][2][4][2], const Unit& u, int wr, int wc, int fr, int fq) const {
        const int rowb = u.pm * BM + wr * 64 + fr, cw = wc * 32 + 8 * fq;
        EPI_ROWS_BEGIN
            const float rs = RSTD1[row]; float s = 0.f;
#pragma unroll
            for (int bj = 0; bj < 2; ++bj) { const size_t off = (size_t)row * 1024 + u.pn * 256 + bj * HALF + cw;
                float pw[8]; unpack8(*(const u32x4*)(PW + off), pw);
                const f32x4 h0 = *(const f32x4*)(H + off), h1 = *(const f32x4*)(H + off + 4);
                float o[8];
#pragma unroll
                for (int j = 0; j < 8; ++j) { const float g = sigmoidf_(acc[ai][bj][m][j >> 2][j & 3] * rs); o[j] = (j < 4 ? h0[j & 3] : h1[j & 3]) + g * pw[j]; s += o[j] * o[j]; }
                *(f32x4*)(H + off) = (f32x4){o[0], o[1], o[2], o[3]}; *(f32x4*)(H + off + 4) = (f32x4){o[4], o[5], o[6], o[7]};
                *(u32x4*)(HB + off) = pack8(o); }
            s += __shfl_xor(s, 16); s += __shfl_xor(s, 32);
            if (fq == 0) SSQ[(size_t)row * 16 + u.pn * 4 + wc] = s;
        EPI_ROWS_END
    }
};
}

struct MapE1a { __device__ __forceinline__ int operator()(int np, float& sc) const { sc = 1.f; const int t = np >> 8; if (t < 8) { const int bj = (np >> 7) & 1, c = np & 127; return (bj ? 2048 : 1024) + t * 128 + c; } return 5120 + (np - 2048); } };
struct MapE1b { __device__ __forceinline__ int operator()(int np, float& sc) const { sc = 1.f; const int t = np >> 8, bj = (np >> 7) & 1, c = np & 127; if (t < 8) return (bj ? 3072 : 0) + t * 128 + c; return (bj ? 6144 : 4096) + (t - 8) * 128 + c; } };
struct MapO1a { __device__ __forceinline__ int operator()(int np, float& sc) const { sc = (np < 1024) ? 0.08838834764831845f : 1.f; if (np < 4096) return np; const int c = np - 4096; return c < 16 ? 8192 + c : -1; } };
struct MapO1b { __device__ __forceinline__ int operator()(int np, float& sc) const { sc = 1.f; const int t = np >> 8, bj = (np >> 7) & 1, c = np & 127; return (bj ? 6144 : 4096) + t * 128 + c; } };
struct MapId  { __device__ __forceinline__ int operator()(int np, float& sc) const { sc = 1.f; return np; } };
template <class F> __device__ __forceinline__ void conv_w(bf16_t* dst, const float* src, int K, int Nsrc, int Nrows, const float* gk, F map, int gt, int nth) {
    const int total = Nrows * (K >> 3);
    for (int idx = gt; idx < total; idx += nth) {
        const int np = idx % Nrows, k8 = idx / Nrows; float sc; const int n = map(np, sc);
        float v[8];
#pragma unroll
        for (int j = 0; j < 8; ++j) { const int k = k8 * 8 + j; v[j] = (n >= 0) ? src[(size_t)k * Nsrc + n] * (gk ? gk[k] : 1.f) * sc : 0.f; }
        *(u32x4*)(dst + (size_t)np * K + k8 * 8) = pack8(v);
    }
}

struct Ptrs { float* out; unsigned char* ws; };
template <int I> __device__ __forceinline__ const float* inp_() {
    const unsigned long long ka = (unsigned long long)__builtin_amdgcn_kernarg_segment_ptr(); unsigned long long v;
    asm volatile("s_load_dwordx2 %0, %1, %2\n\ts_waitcnt lgkmcnt(0)" : "=s"(v) : "s"(ka), "n"(I * 8) : "memory");
    return (const float*)v;
}
#define INP(i) (inp_<i>())
#define LAS3 __attribute__((address_space(3)))

__device__ __forceinline__ void prep_layer_weights(const Ptrs& P, int L, int gt, int nth) {
    const int j = L >> 1; bf16_t* WIN = (bf16_t*)(P.ws + WS_WIN); bf16_t* WOUT = (bf16_t*)(P.ws + WS_WOUT);
    const float* pre_g = INP(2) + (size_t)L * DM;
    if ((L & 1) == 0) {
        const float* w = INP(7) + (size_t)j * DM * EVEN_IN;
        conv_w(WIN, w, DM, EVEN_IN, N1A_E, pre_g, MapE1a(), gt, nth);
        conv_w(WIN + (size_t)N1A_E * DM, w, DM, EVEN_IN, N1B_E, pre_g, MapE1b(), gt, nth);
        conv_w(WOUT, INP(13) + (size_t)j * 2048 * DM, 2048, DM, DM, nullptr, MapId(), gt, nth);
    } else {
        const float* w = INP(14) + (size_t)j * DM * ODD_IN;
        conv_w(WIN, w, DM, ODD_IN, N1A_O, pre_g, MapO1a(), gt, nth);
        conv_w(WIN + (size_t)N1A_O * DM, w, DM, ODD_IN, N1B_O, pre_g, MapO1b(), gt, nth);
        conv_w(WOUT, INP(17) + (size_t)j * 2048 * DM, 2048, DM, DM, nullptr, MapId(), gt, nth);
    }
}

__device__ __forceinline__ void phase_prologue(const Ptrs& P, int G, int bid, int tid) {
    const int lane = tid & 63, wid = tid >> 6;
    const float* x = INP(0); bf16_t* HBA = (bf16_t*)(P.ws + WS_HBA); float* SSQA = (float*)(P.ws + WS_SSQA);
    for (int row = bid * 8 + wid; row < M; row += G * 8) {
        float sq = 0.f;
#pragma unroll
        for (int i = 0; i < 2; ++i) { const size_t off = (size_t)row * DM + i * 512 + lane * 8;
            const f32x4 a = *(const f32x4*)(x + off), b = *(const f32x4*)(x + off + 4);
            const float o[8] = {a[0], a[1], a[2], a[3], b[0], b[1], b[2], b[3]};
#pragma unroll
            for (int j = 0; j < 8; ++j) sq += o[j] * o[j];
            *(u32x4*)(HBA + off) = pack8(o); }
        sq = wave_sum(sq);
        if (lane < 16) SSQA[(size_t)row * 16 + lane] = (lane == 0) ? sq : 0.f;
    }
    const int gt = bid * 512 + tid, nth = G * 512;
    for (int L = 0; L < DEPTH; ++L) {
        conv_w((bf16_t*)(P.ws + WS_WG) + (size_t)L * DM * DM, INP(6) + (size_t)L * DM * DM, DM, DM, DM, INP(4) + (size_t)L * DM, MapId(), gt, nth);
        conv_w((bf16_t*)(P.ws + WS_WP) + (size_t)L * DM * PLE, INP(5) + (size_t)L * PLE * DM, PLE, DM, DM, nullptr, MapId(), gt, nth);
    }
    prep_layer_weights(P, 0, gt, nth);
}

__device__ __forceinline__ void phase_p4(const Ptrs& P, int L, int G, int bid, int tid) {
    const int lane = tid & 63, wid = tid >> 6;
    const float* hin = (L == 0) ? INP(0) : P.out; float* H = P.out;
    const bf16_t* Y = (const bf16_t*)(P.ws + WS_R1); const float* SSQY = (const float*)(P.ws + WS_SSQY);
    bf16_t* HBB = (bf16_t*)(P.ws + WS_R3); float* RSTD1 = (float*)(P.ws + WS_RSTD1);
    const float* pg = INP(3) + (size_t)L * DM;
    f32x4 g[2][2];
#pragma unroll
    for (int i = 0; i < 2; ++i) { g[i][0] = *(const f32x4*)(pg + i * 512 + lane * 8); g[i][1] = *(const f32x4*)(pg + i * 512 + lane * 8 + 4); }
    for (int row = bid * 8 + wid; row < M; row += G * 8) {
        float s = (lane < 16) ? SSQY[(size_t)row * 16 + lane] : 0.f;
        s = wave_sum(s);
        const float rsy = rsqrtf(s * (1.0f / 1024.0f) + EPS);
        float sq = 0.f;
#pragma unroll
        for (int i = 0; i < 2; ++i) { const size_t off = (size_t)row * DM + i * 512 + lane * 8;
            float yv[8]; unpack8(*(const u32x4*)(Y + off), yv);
            const f32x4 a = *(const f32x4*)(hin + off), b = *(const f32x4*)(hin + off + 4);
            float o[8];
#pragma unroll
            for (int j = 0; j < 8; ++j) { o[j] = (j < 4 ? a[j & 3] : b[j & 3]) + yv[j] * rsy * g[i][j >> 2][j & 3]; sq += o[j] * o[j]; }
            *(f32x4*)(H + off) = (f32x4){o[0], o[1], o[2], o[3]}; *(f32x4*)(H + off + 4) = (f32x4){o[4], o[5], o[6], o[7]};
            *(u32x4*)(HBB + off) = pack8(o); }
        sq = wave_sum(sq);
        if (lane == 0) RSTD1[row] = rsqrtf(sq * (1.0f / 1024.0f) + EPS);
    }
    const int gt = bid * 512 + tid, nth = G * 512;
    const float* pl = INP(1) + (size_t)L * M * PLE; bf16_t* PB = (bf16_t*)(P.ws + WS_R3 + 64 * MiB);
    for (int i = gt; i < M * PLE / 8; i += nth) { const f32x4 a = *(const f32x4*)(pl + (size_t)i * 8), b = *(const f32x4*)(pl + (size_t)i * 8 + 4);
        const float o[8] = {a[0], a[1], a[2], a[3], b[0], b[1], b[2], b[3]}; *(u32x4*)(PB + (size_t)i * 8) = pack8(o); }
    if (L + 1 < DEPTH) prep_layer_weights(P, L + 1, gt, nth);
}

__device__ __forceinline__ void phase_gm(LAS3 unsigned char* lds, const Ptrs& P, int j, int G, int bid, int tid_in) {
    LAS3 float* Wt = (LAS3 float*)lds; LAS3 float* Vt = (LAS3 float*)(lds + 65536); LAS3 float* mu = (LAS3 float*)(lds + 131072); LAS3 float* rsd = mu + 128;
    const bf16_t* BV = (const bf16_t*)(P.ws + WS_R2); bf16_t* S = (bf16_t*)(P.ws + WS_R3);
    const float* ws_ = INP(11) + (size_t)j * 8 * 128 * 128; const float* bs = INP(12) + (size_t)j * 128 * 8;
    const float* lg = INP(9) + (size_t)j * 1024; const float* lb = INP(10) + (size_t)j * 1024;
    for (int c = bid; c < M / 128; c += G) {
        int tid = tid_in; asm volatile("" : "+v"(tid));
        const int lane = tid & 63, wid = tid >> 6;
        const int r0 = c * 128;
#pragma unroll 2
        for (int rr = 0; rr < 16; ++rr) { const int row = wid * 16 + rr; const bf16_t* p = BV + (size_t)(r0 + row) * 1024;
            float a[8], b[8]; unpack8(*(const u32x4*)(p + lane * 8), a); unpack8(*(const u32x4*)(p + 512 + lane * 8), b);
            float s = 0.f;
#pragma unroll
            for (int q = 0; q < 8; ++q) s += a[q] + b[q];
            s = wave_sum(s); const float mean = s * (1.0f / 1024.0f); float v = 0.f;
#pragma unroll
            for (int q = 0; q < 8; ++q) { const float d0 = a[q] - mean, d1 = b[q] - mean; v += d0 * d0 + d1 * d1; }
            v = wave_sum(v);
            if (lane == 0) { mu[row] = mean; rsd[row] = rsqrtf(v * (1.0f / 1024.0f) + EPS); } }
        __syncthreads();
#pragma unroll 1
        for (int g = 0; g < 8; ++g) {
            asm volatile("" : "+v"(tid));
#pragma unroll 4
            for (int i = 0; i < 32; ++i) { const int e = tid + 512 * i, t = e >> 7, s = e & 127;
                Wt[s * 128 + t] = (s <= t) ? ws_[(size_t)g * 16384 + e] : 0.f; }
#pragma unroll 4
            for (int i = 0; i < 32; ++i) { const int e = tid + 512 * i, s = e >> 7, cc = e & 127;
                Vt[e] = (bf2f(BV[(size_t)(r0 + s) * 1024 + g * 128 + cc]) - mu[s]) * rsd[s] * lg[g * 128 + cc] + lb[g * 128 + cc]; }
            __syncthreads();
            const int cc = tid & 127, tq = tid >> 7;
            float acc[32];
#pragma unroll
            for (int i = 0; i < 32; ++i) acc[i] = 0.f;
            const int smax = tq * 32 + 31;
#pragma unroll 1
            for (int s = 0; s <= smax; ++s) { const float vv = Vt[s * 128 + cc];
#pragma unroll
                for (int i4 = 0; i4 < 8; ++i4) { const f32x4 w4 = *(const LAS3 f32x4*)&Wt[s * 128 + tq * 32 + i4 * 4];
                    acc[i4 * 4 + 0] += w4[0] * vv; acc[i4 * 4 + 1] += w4[1] * vv; acc[i4 * 4 + 2] += w4[2] * vv; acc[i4 * 4 + 3] += w4[3] * vv; } }
#pragma unroll
            for (int i = 0; i < 32; ++i) { const int t = tq * 32 + i; S[(size_t)(r0 + t) * 1024 + g * 128 + cc] = f2bf(acc[i] + bs[t * 8 + g]); }
            __syncthreads();
        }
    }
}

__device__ __forceinline__ void phase_o2(LAS3 unsigned char* lds, const Ptrs& P, int j, int G, int bid, int tid_in) {
    LAS3 float* Kw = (LAS3 float*)lds; LAS3 bf16_t* Vs = (LAS3 bf16_t*)(lds + 65536); LAS3 float* sc = (LAS3 float*)(lds + 131072); LAS3 float* wv = sc + 128;
    const bf16_t* Kb = (const bf16_t*)(P.ws + WS_R2); const bf16_t* Vb = (const bf16_t*)(P.ws + WS_R3);
    const float* GATE = (const float*)(P.ws + WS_GATE); float* GB = (float*)(P.ws + WS_GB); float* CS = (float*)(P.ws + WS_CS);
    bf16_t* UC = (bf16_t*)(P.ws + WS_R4); float* NS = (float*)(P.ws + WS_NS);
    const float* bif = INP(15) + (size_t)j * 16;
    for (int unit = bid; unit < NUNIT_O; unit += G) {
        int tid = tid_in; asm volatile("" : "+v"(tid));
        const int chain = unit >> 7, n = unit & 127, b = chain >> 3, h = chain & 7, r0 = b * SEQ + n * 128;
        float ii = 0.f, a = 0.f;
        if (tid < 128) { const float fi = GATE[(size_t)(r0 + tid) * 16 + 8 + h] + bif[8 + h]; ii = GATE[(size_t)(r0 + tid) * 16 + h] + bif[h]; sc[tid] = logsigmoidf_(fi); }
        __syncthreads();
        for (int off = 1; off < 128; off <<= 1) { float v = 0.f; if (tid < 128) v = sc[tid] + (tid >= off ? sc[tid - off] : 0.f); __syncthreads(); if (tid < 128) sc[tid] = v; __syncthreads(); }
        const float gtot = sc[127];
        if (tid < 128) { a = gtot - sc[tid] + ii; wv[tid] = a; GB[((size_t)(r0 + tid) * 8 + h) * 2] = sc[tid]; GB[((size_t)(r0 + tid) * 8 + h) * 2 + 1] = ii; }
        __syncthreads();
        float amax = -3.0e38f;
        for (int t = 0; t < 128; ++t) amax = fmaxf(amax, wv[t]);
        __syncthreads();
        if (tid < 128) wv[tid] = __expf(a - amax);
        if (tid == 0) { CS[(size_t)unit * 2] = gtot; CS[(size_t)unit * 2 + 1] = amax; }
        __syncthreads();
#pragma unroll
        for (int i = 0; i < 4; ++i) { const int e8 = tid + 512 * i, s = e8 >> 4, k8 = e8 & 15;
            float kv[8]; unpack8(*(const u32x4*)(Kb + (size_t)(r0 + s) * 1024 + h * 128 + k8 * 8), kv); const float w = wv[s];
            *(LAS3 f32x4*)&Kw[s * 128 + k8 * 8] = (f32x4){kv[0] * w, kv[1] * w, kv[2] * w, kv[3] * w}; *(LAS3 f32x4*)&Kw[s * 128 + k8 * 8 + 4] = (f32x4){kv[4] * w, kv[5] * w, kv[6] * w, kv[7] * w}; }
#pragma unroll
        for (int i = 0; i < 8; ++i) { const int e8 = tid + 512 * i, s = e8 >> 5, v8 = e8 & 31;
            *(LAS3 u32x4*)&Vs[s * 256 + v8 * 8] = *(const u32x4*)(Vb + (size_t)(r0 + s) * 2048 + h * 256 + v8 * 8); }
        __syncthreads();
        const int vv = tid & 255, kq = tid >> 8;
        float acc[64];
#pragma unroll
        for (int i = 0; i < 64; ++i) acc[i] = 0.f;
#pragma unroll 1
        for (int s = 0; s < 128; ++s) { const float vval = bf2f(Vs[s * 256 + vv]);
#pragma unroll
            for (int i4 = 0; i4 < 16; ++i4) { const f32x4 k4 = *(const LAS3 f32x4*)&Kw[s * 128 + kq * 64 + i4 * 4];
                acc[i4 * 4 + 0] += k4[0] * vval; acc[i4 * 4 + 1] += k4[1] * vval; acc[i4 * 4 + 2] += k4[2] * vval; acc[i4 * 4 + 3] += k4[3] * vval; } }
#pragma unroll
        for (int i = 0; i < 64; ++i) UC[((size_t)unit * 128 + kq * 64 + i) * 256 + vv] = f2bf(acc[i]);
        if (tid < 128) { float ns = 0.f; for (int s = 0; s < 128; ++s) ns += Kw[s * 128 + tid]; NS[(size_t)unit * 128 + tid] = ns; }
        __syncthreads();
    }
}

__device__ __forceinline__ void phase_o3(LAS3 unsigned char* lds, const Ptrs& P, int G, int bid, int tid) {
    LAS3 float* dec = (LAS3 float*)lds; LAS3 float* scl = dec + 128; LAS3 float* gg = scl + 128; LAS3 float* am = gg + 128;
    const float* CS = (const float*)(P.ws + WS_CS); float* MS = (float*)(P.ws + WS_MS); bf16_t* UC = (bf16_t*)(P.ws + WS_R4); float* NS = (float*)(P.ws + WS_NS);
    for (int task = bid; task < 256; task += G) {
        const int chain = task >> 4, eb = task & 15;
        if (tid < 128) { gg[tid] = CS[((size_t)chain * 128 + tid) * 2]; am[tid] = CS[((size_t)chain * 128 + tid) * 2 + 1]; }
        __syncthreads();
        if (tid == 0) { float m = 0.f;
            for (int n = 0; n < 128; ++n) { const float g = gg[n], a = am[n], mn = fmaxf(g + m, a); dec[n] = __expf(g + m - mn); scl[n] = __expf(a - mn); if (eb == 0) MS[chain * 128 + n] = m; m = mn; } }
        __syncthreads();
        const size_t e = (size_t)eb * 2048 + tid * 4;
        float c0 = 0.f, c1 = 0.f, c2 = 0.f, c3 = 0.f;
        for (int n0 = 0; n0 < 128; n0 += 8) {
            u32x2 u[8];
#pragma unroll
            for (int q = 0; q < 8; ++q) u[q] = *(const u32x2*)(UC + ((size_t)chain * 128 + n0 + q) * 32768 + e);
#pragma unroll
            for (int q = 0; q < 8; ++q) { u32x2 w; w.x = pk2(c0, c1); w.y = pk2(c2, c3); *(u32x2*)(UC + ((size_t)chain * 128 + n0 + q) * 32768 + e) = w;
                const float d = dec[n0 + q], s = scl[n0 + q];
                c0 = d * c0 + s * __uint_as_float(u[q].x << 16); c1 = d * c1 + s * __uint_as_float(u[q].x & 0xffff0000u);
                c2 = d * c2 + s * __uint_as_float(u[q].y << 16); c3 = d * c3 + s * __uint_as_float(u[q].y & 0xffff0000u); }
        }
        if (eb == 0 && tid < 128) { float cn = 0.f;
            for (int n = 0; n < 128; ++n) { const size_t o = ((size_t)chain * 128 + n) * 128 + tid; const float v = NS[o]; NS[o] = cn; cn = dec[n] * cn + scl[n] * v; } }
        __syncthreads();
    }
}


template <int hv> __device__ __forceinline__ void o4_half(float (&acc)[32], LAS3 unsigned char* KV, const LAS3 bf16_t* Qt, const LAS3 float* Pt, const LAS3 float* isc, const bf16_t* UC, const bf16_t* Vb,
                                                         int unit, int r0, int h, int tid, int vv, int th) {
    __syncthreads();
#pragma unroll
    for (int i = 0; i < 4; ++i) { const int e8 = tid + 512 * i, kk = e8 >> 4, v8 = e8 & 15;
        *(LAS3 u32x4*)(KV + (kk * 128 + v8 * 8) * 2) = *(const u32x4*)(UC + ((size_t)unit * 128 + kk) * 256 + hv * 128 + v8 * 8); }
    __syncthreads();
#pragma unroll
    for (int i = 0; i < 32; ++i) acc[i] = 0.f;
    const LAS3 bf16_t* Ch = (const LAS3 bf16_t*)KV;
#pragma unroll 1
    for (int kk = 0; kk < 128; ++kk) { const float cv = bf2f(Ch[kk * 128 + vv]);
#pragma unroll
        for (int i8 = 0; i8 < 4; ++i8) { float qv[8]; unpack8(*(const LAS3 u32x4*)&Qt[kk * 128 + th * 32 + i8 * 8], qv);
#pragma unroll
            for (int q = 0; q < 8; ++q) acc[i8 * 8 + q] += qv[q] * cv; } }
#pragma unroll
    for (int i = 0; i < 32; ++i) acc[i] *= isc[th * 32 + i];
    __syncthreads();
#pragma unroll
    for (int i = 0; i < 4; ++i) { const int e8 = tid + 512 * i, s = e8 >> 4, v8 = e8 & 15;
        *(LAS3 u32x4*)(KV + (s * 128 + v8 * 8) * 2) = *(const u32x4*)(Vb + (size_t)(r0 + s) * 2048 + h * 256 + hv * 128 + v8 * 8); }
    __syncthreads();
#pragma unroll 1
    for (int s = 0; s < 128; ++s) { const float v = bf2f(Ch[s * 128 + vv]);
#pragma unroll
        for (int i4 = 0; i4 < 8; ++i4) { const f32x4 p4 = *(const LAS3 f32x4*)&Pt[s * 128 + th * 32 + i4 * 4];
            acc[i4 * 4 + 0] += p4[0] * v; acc[i4 * 4 + 1] += p4[1] * v; acc[i4 * 4 + 2] += p4[2] * v; acc[i4 * 4 + 3] += p4[3] * v; } }
}
__device__ __forceinline__ void phase_o4(LAS3 unsigned char* lds, const Ptrs& P, int j, int G, int bid, int tid_in) {
    LAS3 float* Pt = (LAS3 float*)lds;
    LAS3 bf16_t* Qt = (LAS3 bf16_t*)(lds + 65536);
    LAS3 unsigned char* KV = lds + 98304;
    LAS3 float* bb = (LAS3 float*)(lds + 131584); LAS3 float* cc = bb + 128; LAS3 float* MM = cc + 128; LAS3 float* isc = MM + 128; LAS3 float* den = isc + 128; LAS3 float* nst = den + 128; LAS3 float* red = nst + 128;
    const bf16_t* Qb = (const bf16_t*)(P.ws + WS_R1); const bf16_t* Kb = (const bf16_t*)(P.ws + WS_R2); bf16_t* Vb = (bf16_t*)(P.ws + WS_R3);
    const bf16_t* UC = (const bf16_t*)(P.ws + WS_R4); const float* NS = (const float*)(P.ws + WS_NS); const float* MS = (const float*)(P.ws + WS_MS); const float* GB = (const float*)(P.ws + WS_GB);
    const float* mhg = INP(16) + (size_t)j * 8 * 256;
    for (int unit = bid; unit < NUNIT_O; unit += G) {
        int tid = tid_in; asm volatile("" : "+v"(tid));
        const int lane = tid & 63, wid = tid >> 6;
        const int chain = unit >> 7, n = unit & 127, b = chain >> 3, h = chain & 7, r0 = b * SEQ + n * 128;
        const float mst = MS[chain * 128 + n];
        if (tid < 128) { const float bv = GB[((size_t)(r0 + tid) * 8 + h) * 2], iv = GB[((size_t)(r0 + tid) * 8 + h) * 2 + 1]; bb[tid] = bv; cc[tid] = iv - bv; nst[tid] = NS[(size_t)unit * 128 + tid]; }
#pragma unroll
        for (int i = 0; i < 4; ++i) { const int e8 = tid + 512 * i, t = e8 >> 4, k8 = e8 & 15;
            const u32x4 qw = *(const u32x4*)(Qb + (size_t)(r0 + t) * 1024 + h * 128 + k8 * 8);
            Qt[(k8 * 8 + 0) * 128 + t] = (bf16_t)(qw.x & 0xffffu); Qt[(k8 * 8 + 1) * 128 + t] = (bf16_t)(qw.x >> 16); Qt[(k8 * 8 + 2) * 128 + t] = (bf16_t)(qw.y & 0xffffu); Qt[(k8 * 8 + 3) * 128 + t] = (bf16_t)(qw.y >> 16);
            Qt[(k8 * 8 + 4) * 128 + t] = (bf16_t)(qw.z & 0xffffu); Qt[(k8 * 8 + 5) * 128 + t] = (bf16_t)(qw.z >> 16); Qt[(k8 * 8 + 6) * 128 + t] = (bf16_t)(qw.w & 0xffffu); Qt[(k8 * 8 + 7) * 128 + t] = (bf16_t)(qw.w >> 16);
            const u32x4 kw = *(const u32x4*)(Kb + (size_t)(r0 + t) * 1024 + h * 128 + k8 * 8);
            LAS3 unsigned* kd = (LAS3 unsigned*)(KV + t * 260 + k8 * 16); kd[0] = kw.x; kd[1] = kw.y; kd[2] = kw.z; kd[3] = kw.w; }
        __syncthreads();
        if (tid < 128) { float mx = mst;
#pragma unroll 1
            for (int s = 0; s <= tid; ++s) mx = fmaxf(mx, cc[s]);
            MM[tid] = mx; isc[tid] = __expf(mst - mx); }
        {
            const int s_ = tid & 127, tq = tid >> 7;
            float acc[32];
#pragma unroll
            for (int i = 0; i < 32; ++i) acc[i] = 0.f;
            const LAS3 bf16_t* Kp = (const LAS3 bf16_t*)KV;
#pragma unroll 1
            for (int kk = 0; kk < 128; ++kk) { const float kval = bf2f(Kp[s_ * 130 + kk]);
#pragma unroll
                for (int i8 = 0; i8 < 4; ++i8) { float qv[8]; unpack8(*(const LAS3 u32x4*)&Qt[kk * 128 + tq * 32 + i8 * 8], qv);
#pragma unroll
                    for (int q = 0; q < 8; ++q) acc[i8 * 8 + q] += qv[q] * kval; } }
            __syncthreads();
            const float cs = cc[s_];
#pragma unroll
            for (int i4 = 0; i4 < 8; ++i4) { f32x4 pv;
#pragma unroll
                for (int q = 0; q < 4; ++q) { const int t = tq * 32 + i4 * 4 + q; pv[q] = (s_ <= t) ? __expf(cs - MM[t]) * acc[i4 * 4 + q] : 0.f; }
                *(LAS3 f32x4*)&Pt[s_ * 128 + tq * 32 + i4 * 4] = pv; }
        }
        __syncthreads();
        if (tid < 128) { float d = 0.f, qn = 0.f;
#pragma unroll 4
            for (int s = 0; s < 128; ++s) d += Pt[s * 128 + tid];
#pragma unroll 4
            for (int kk = 0; kk < 128; ++kk) qn += bf2f(Qt[kk * 128 + tid]) * nst[kk];
            den[tid] = isc[tid] * qn + d; }
        const int vv = tid & 127, th = tid >> 7;
        float o[2][32];
        o4_half<0>(o[0], KV, Qt, Pt, isc, UC, Vb, unit, r0, h, tid, vv, th);
        o4_half<1>(o[1], KV, Qt, Pt, isc, UC, Vb, unit, r0, h, tid, vv, th);
        __syncthreads();
#pragma unroll
        for (int i = 0; i < 32; ++i) { const int t = th * 32 + i; const float dn = fmaxf(fabsf(den[t]), __expf(-(bb[t] + MM[t]))), inv = 1.0f / dn;
            o[0][i] *= inv; o[1][i] *= inv; float sq = o[0][i] * o[0][i] + o[1][i] * o[1][i]; sq = wave_sum(sq); if (lane == 0) red[t * 2 + (wid & 1)] = sq;  asm volatile("" ::: "memory"); }
        __syncthreads();
        const float g0 = mhg[h * 256 + vv], g1 = mhg[h * 256 + 128 + vv];
#pragma unroll
        for (int i = 0; i < 32; ++i) { const int t = th * 32 + i; const float r = rsqrtf((red[t * 2] + red[t * 2 + 1]) * (1.0f / 256.0f) + EPS);
            Vb[(size_t)(r0 + t) * 2048 + h * 256 + vv] = f2bf(o[0][i] * r * g0); Vb[(size_t)(r0 + t) * 2048 + h * 256 + 128 + vv] = f2bf(o[1][i] * r * g1);  asm volatile("" ::: "memory"); }
        __syncthreads();
    }
}

constexpr int NPHASE = 1 + 8 * DEPTH;
__host__ __device__ constexpr bool phase_exists(int ph) { return ph == 0 || !((((ph - 1) >> 3) & 1) == 0 && (((ph - 1) & 7) == 2 || ((ph - 1) & 7) == 3)); }
struct Args { const float* in[18]; float* out; unsigned char* ws; int ph_lo, ph_hi; };

__global__ void __launch_bounds__(512, 2) fwd(Args args) {
    extern __shared__ __attribute__((aligned(16))) unsigned char lds_raw[];
    LAS3 unsigned char* lds = (LAS3 unsigned char*)lds_raw;
    const int tid0 = threadIdx.x, bid = blockIdx.x, G = gridDim.x;
    Ptrs P; P.out = args.out; P.ws = args.ws;
    const int lo0 = args.ph_lo, hi0 = args.ph_hi;
    const bool multi = (hi0 - lo0) > 1;
    XcdBarrier bar; bar.bar = (unsigned*)(P.ws + WS_CTL); bar.x = 0; bar.st = nullptr;
    if (multi) {
        if (tid0 < 4) ((LAS3 unsigned*)(lds + LDS_BAR_OFF))[tid0] = 0u;
        __syncthreads();
        bar = xcd_barrier_post((unsigned*)(P.ws + WS_CTL), (volatile LAS unsigned*)(lds + LDS_BAR_OFF));
    }
#ifndef PHMASK
#define PHMASK 0xFFFF
#endif
#define PHM(k) (((PHMASK) >> (k)) & 1)
#define RUN(ph) (lo <= (ph) && (ph) < hi)
#define SEAM(ph) do { if ((ph) + 1 < hi) xcd_barrier(bar); } while (0)
    bf16_t* const HBA = (bf16_t*)(P.ws + WS_HBA); bf16_t* const WIN = (bf16_t*)(P.ws + WS_WIN); bf16_t* const WOUT = (bf16_t*)(P.ws + WS_WOUT);
    bf16_t* const R1 = (bf16_t*)(P.ws + WS_R1); bf16_t* const R2 = (bf16_t*)(P.ws + WS_R2); bf16_t* const R3 = (bf16_t*)(P.ws + WS_R3); bf16_t* const R4 = (bf16_t*)(P.ws + WS_R4);
    float* const SSQA = (float*)(P.ws + WS_SSQA); float* const SSQY = (float*)(P.ws + WS_SSQY);

    { const int tid = tid0, lo = lo0, hi = hi0; if (PHM(0) && RUN(0)) { phase_prologue(P, G, bid, tid); SEAM(0); } }
#pragma unroll 1
    for (int L = 0; L < DEPTH; ++L) {
        int tid = tid0, lo = lo0, hi = hi0; asm volatile("" : "+v"(tid), "+s"(lo), "+s"(hi));
        const int pb = 1 + 8 * L, j = L >> 1;
        if ((L & 1) == 0) {
            if (PHM(1) && RUN(pb + 0)) { pg8::Gemm g{HBA, WIN, M, N1A_E, DM}; pg8::StaticOrder S; S.init(M, N1A_E, G, bid);
                pg8::EpiE1a E{SSQA, R1, R2}; pg8::gemm_phase<pg8::EpiE1a, pg8::StaticOrder>(lds, g, S, E, nullptr); SEAM(pb + 0); }
            if (PHM(2) && RUN(pb + 1)) { phase_gm(lds, P, j, G, bid, tid); SEAM(pb + 1); }
            if (PHM(3) && RUN(pb + 4)) { pg8::Gemm g{HBA, WIN + (size_t)N1A_E * DM, M, N1B_E, DM}; pg8::StaticOrder S; S.init(M, N1B_E, G, bid);
                pg8::EpiE1b E{SSQA, R1, R3, INP(8) + (size_t)j * 3 * 1024, R4}; pg8::gemm_phase<pg8::EpiE1b, pg8::StaticOrder>(lds, g, S, E, nullptr); SEAM(pb + 4); }
        } else {
            if (PHM(4) && RUN(pb + 0)) { pg8::Gemm g{HBA, WIN, M, N1A_O, DM}; pg8::StaticOrder S; S.init(M, N1A_O, G, bid);
                pg8::EpiO1a E{SSQA, R1, R2, R3, (float*)(P.ws + WS_GATE)}; pg8::gemm_phase<pg8::EpiO1a, pg8::StaticOrder>(lds, g, S, E, nullptr); SEAM(pb + 0); }
            if (PHM(5) && RUN(pb + 1)) { phase_o2(lds, P, j, G, bid, tid); SEAM(pb + 1); }
            if (PHM(6) && RUN(pb + 2)) { phase_o3(lds, P, G, bid, tid); SEAM(pb + 2); }
            if (PHM(7) && RUN(pb + 3)) { phase_o4(lds, P, j, G, bid, tid); SEAM(pb + 3); }
            if (PHM(8) && RUN(pb + 4)) { pg8::Gemm g{HBA, WIN + (size_t)N1A_O * DM, M, N1B_O, DM}; pg8::StaticOrder S; S.init(M, N1B_O, G, bid);
                pg8::EpiO1b E{SSQA, R3, R4}; pg8::gemm_phase<pg8::EpiO1b, pg8::StaticOrder>(lds, g, S, E, nullptr); SEAM(pb + 4); }
        }
        if (PHM(9) && RUN(pb + 5)) { pg8::Gemm g{R4, WOUT, M, DM, 2048}; pg8::StaticOrder S; S.init(M, DM, G, bid);
            pg8::EpiOut E{R1, SSQY}; pg8::gemm_phase<pg8::EpiOut, pg8::StaticOrder>(lds, g, S, E, nullptr); SEAM(pb + 5); }
        if (PHM(10) && RUN(pb + 6)) { phase_p4(P, L, G, bid, tid); SEAM(pb + 6); }
        if (PHM(11) && RUN(pb + 7)) {
            { pg8::Gemm g{R3 + (size_t)32 * MiB, (bf16_t*)(P.ws + WS_WP) + (size_t)L * DM * PLE, M, DM, PLE}; pg8::StaticOrder S; S.init(M, DM, G, bid);
              pg8::EpiPw E{R2}; pg8::gemm_phase<pg8::EpiPw, pg8::StaticOrder>(lds, g, S, E, nullptr); }
            __syncthreads();
            { pg8::Gemm g{R3, (bf16_t*)(P.ws + WS_WG) + (size_t)L * DM * DM, M, DM, DM}; pg8::StaticOrder S; S.init(M, DM, G, bid);
              pg8::EpiGate E{(const float*)(P.ws + WS_RSTD1), R2, P.out, HBA, SSQA}; pg8::gemm_phase<pg8::EpiGate, pg8::StaticOrder>(lds, g, S, E, nullptr); }
            SEAM(pb + 7);
        }
    }
#undef RUN
#undef SEAM
}

#ifndef ONE_LAUNCH
#define ONE_LAUNCH 0
#endif
extern "C" void kernel_launch(void* const* d_in, const int* in_sizes, int n_in, void* d_out, int out_size, void* d_ws, size_t ws_size, hipStream_t stream) {
    static int grid = 0;
    if (grid == 0) {
        if (n_in != 18 || out_size != M * DM || ws_size < WS_END) { fprintf(stderr, "kernel_launch: unexpected shapes (n_in %d out %d ws %zu)\n", n_in, out_size, ws_size); grid = -1; return; }
        int dev = 0, cus = 0, per_cu = 0;
        if (hipGetDevice(&dev) != hipSuccess || hipDeviceGetAttribute(&cus, hipDeviceAttributeMultiprocessorCount, dev) != hipSuccess) { grid = -1; return; }
        if (hipFuncSetAttribute((const void*)fwd, hipFuncAttributeMaxDynamicSharedMemorySize, LDS_BYTES) != hipSuccess) { fprintf(stderr, "kernel_launch: hipFuncSetAttribute failed\n"); grid = -1; return; }
        if (hipOccupancyMaxActiveBlocksPerMultiprocessor(&per_cu, (const void*)fwd, 512, LDS_BYTES) != hipSuccess || per_cu < 1) { fprintf(stderr, "kernel_launch: occupancy query says %d\n", per_cu); }
        (void)hipGetLastError();
        grid = cus;
    }
    if (grid < 0) return;
    (void)hipMemsetAsync((char*)d_ws + WS_CTL, 0, CTL_BYTES, stream);
    Args a{};
    for (int i = 0; i < 18; ++i) a.in[i] = (const float*)d_in[i];
    a.out = (float*)d_out; a.ws = (unsigned char*)d_ws;
#if ONE_LAUNCH
    a.ph_lo = 0; a.ph_hi = NPHASE;
    hipLaunchKernelGGL(fwd, dim3(grid), dim3(512), LDS_BYTES, stream, a);
#else
    for (int ph = 0; ph < NPHASE; ++ph) { if (!phase_exists(ph)) continue; a.ph_lo = ph; a.ph_hi = ph + 1; hipLaunchKernelGGL(fwd, dim3(grid), dim3(512), LDS_BYTES, stream, a); }
#endif
}
```

```cpp
#include <hip/hip_runtime.h>
#include <cstdio>
#include <cstdint>
namespace pg8 {
#define PG8_LAS __attribute__((address_space(3)))
typedef unsigned short bf16_t;
typedef short bf16x8 __attribute__((ext_vector_type(8)));
typedef float f32x4 __attribute__((ext_vector_type(4)));
typedef unsigned u32x4 __attribute__((ext_vector_type(4)));
constexpr int BM = 256, BK = 64, HALF = 128, HTB = HALF * BK * 2  , STAGE_BYTES = 8 * HTB, NXCD = 8, WGM = 8;

__host__ __device__ __forceinline__ int lds_byte(int r, int c) { const int st = (r >> 4) * 2 + (c >> 5), rr = r & 15, cc = c & 31, ob = rr * 64 + cc * 2; return st * 1024 + (ob ^ (((ob >> 9) & 1) << 5)); }
__host__ __device__ __forceinline__ void stage_rc(int b, int& R, int& C) { const int st = b / 1024, sb = b % 1024, swz = sb ^ (((sb >> 9) & 1) << 5); R = (st >> 1) * 16 + swz / 64; C = (st & 1) * 32 + (swz % 64) / 2; }
__host__ __device__ __forceinline__ int perm32(int rho) { const int n = rho >> 4, i = rho & 15; return 8 * (i >> 2) + 4 * n + (i & 3); }

struct Unit { int pm, pn; };
struct Gemm { const bf16_t* A; const bf16_t* Bt; int M, N, K; };

struct StaticOrder {
    int nM, nN, nwg, G, c;
    __host__ __device__ void init(int M, int N, int G_, int c_) { nM = M / BM; nN = N / BM; nwg = nM * nN; G = G_; c = c_; }
    __host__ __device__ bool next(int i, Unit& u) const {
        const long L = (long)i * G + c; if (L >= nwg) return false;
        int wgid = (int)L; { const int q = nwg / NXCD, r = nwg % NXCD, xcd = wgid % NXCD, off = wgid / NXCD; wgid = (xcd < r ? xcd * (q + 1) : r * (q + 1) + (xcd - r) * q) + off; }
        const int nig = WGM * nN, gid = wgid / nig, fm = gid * WGM, gsz = (nM - fm) < WGM ? (nM - fm) : WGM;
        u.pm = fm + ((wgid % nig) % gsz); u.pn = (wgid % nig) / gsz; return true;
    }
    __device__ __forceinline__ void a_ready(const Unit&) const {}
    __device__ __forceinline__ void done(const Unit&) const {}
};
__device__ __forceinline__ unsigned cvt_pk_bf16(float lo, float hi) { unsigned r; asm volatile("v_cvt_pk_bf16_f32 %0, %1, %2" : "=v"(r) : "v"(lo), "v"(hi)); return r; }
typedef float f32x2 __attribute__((ext_vector_type(2)));
template <class Epi, class Sched, bool STAMP = false>
__device__ __forceinline__ void gemm_phase(PG8_LAS unsigned char* lds, const Gemm g, const Sched& S, const Epi& E, unsigned long long* stamps) {
    int tid_l_ = threadIdx.x; asm volatile("" : "+v"(tid_l_));
    const int tid = tid_l_, wid = __builtin_amdgcn_readfirstlane(tid >> 6), lane = tid & 63, wr = wid >> 2, wc = wid & 3, fr = lane & 15, fq = lane >> 4;
    const int K = g.K, nt = K / BK;
    int ts_lo = 0, ts_hi = 0, nts = 0; const unsigned long long rt_entry = STAMP ? (unsigned long long)wall_clock64() : 0ull;
#define PG8_STAMP() do { if (STAMP && wid == 0 && nts < 64) { const unsigned long long _c = (unsigned long long)clock64(); \
        ts_lo = (lane == nts) ? (int)(unsigned)_c : ts_lo; ts_hi = (lane == nts) ? (int)(unsigned)(_c >> 32) : ts_hi; ++nts; } } while (0)
    PG8_STAMP();
    unsigned voffA[2], voffB[2];
#pragma unroll
    for (int i = 0; i < 2; ++i) { int R, C; stage_rc(tid * 16 + i * 8192, R, C); const int Rb = Epi::PERM ? ((R & ~31) + perm32(R & 31)) : R;
        voffA[i] = (unsigned)(R * K + C) * 2u; voffB[i] = (unsigned)(Rb * K + C) * 2u; }
    const size_t kstep = (size_t)(BK * 2);
    const size_t hstep = (size_t)HALF * K * 2;
    const size_t tstep = 2 * hstep;
    const unsigned ldsw = (unsigned)wid * 1024u;
    const int aoff = lds_byte(wr * 64 + fr, fq * 8), boff = lds_byte(wc * 32 + fr, fq * 8);
#define PG8_SA(b, h) (((b) * 2 + (h)) * HTB)
#define PG8_SB(b, h) ((4 + (b) * 2 + (h)) * HTB)
#define PG8_STAGE(bufoff, gbase, voff) do { _Pragma("unroll") for (int _i = 0; _i < 2; ++_i) \
        __builtin_amdgcn_global_load_lds((const unsigned*)((const char*)(gbase) + (voff)[_i]), (PG8_LAS unsigned*)(lds + (bufoff) + ldsw + _i * 8192), 16, 0, 0); } while (0)
#define PG8_LDA(dst, b, h) do { _Pragma("unroll") for (int m = 0; m < 4; ++m) _Pragma("unroll") for (int k = 0; k < 2; ++k) dst[m][k] = *(const PG8_LAS bf16x8*)(lds + PG8_SA(b, h) + aoff + m * 2048 + k * 1024); } while (0)
#define PG8_LDB(dst, b, h) do { _Pragma("unroll") for (int n = 0; n < 2; ++n) _Pragma("unroll") for (int k = 0; k < 2; ++k) dst[n][k] = *(const PG8_LAS bf16x8*)(lds + PG8_SB(b, h) + boff + n * 2048 + k * 1024); } while (0)
#define PG8_MMA(ai, bj, At, Bt) do { __builtin_amdgcn_s_setprio(1); _Pragma("unroll") for (int m = 0; m < 4; ++m) _Pragma("unroll") for (int n = 0; n < 2; ++n) _Pragma("unroll") for (int k = 0; k < 2; ++k) \
        acc[ai][bj][m][n] = __builtin_amdgcn_mfma_f32_16x16x32_bf16(Bt[n][k], At[m][k], acc[ai][bj][m][n], 0, 0, 0); __builtin_amdgcn_s_setprio(0); } while (0)
#define PG8_WAIT_V(n) asm volatile("s_waitcnt vmcnt(" #n ")" ::: "memory")
#define PG8_WAIT_L(n) asm volatile("s_waitcnt lgkmcnt(" #n ")" ::: "memory")
#define PG8_BAR __builtin_amdgcn_s_barrier()
#define PG8_SCHED __builtin_amdgcn_sched_barrier(0)
    Unit cur, nxt; int ui = 0;
    if (!S.next(0, cur)) return;
    f32x4 acc[2][2][4][2];
#pragma unroll
    for (int a = 0; a < 2; ++a)
#pragma unroll
        for (int b = 0; b < 2; ++b)
#pragma unroll
            for (int m = 0; m < 4; ++m)
#pragma unroll
                for (int n = 0; n < 2; ++n) acc[a][b][m][n] = (f32x4){0.f, 0.f, 0.f, 0.f};
    bf16x8 At[4][2], B0[2][2], B1[2][2];
    const char* cA = (const char*)g.A + (size_t)cur.pm * tstep; const char* cB = (const char*)g.Bt + (size_t)cur.pn * tstep;
    S.a_ready(cur);
    PG8_STAGE(PG8_SB(0, 0), cB, voffB); PG8_STAGE(PG8_SA(0, 0), cA, voffA); PG8_STAGE(PG8_SB(0, 1), cB + hstep, voffB); PG8_STAGE(PG8_SA(0, 1), cA + hstep, voffA);
    if (wr == 1) PG8_BAR;
    PG8_WAIT_V(4); PG8_BAR;
    PG8_STAGE(PG8_SB(1, 0), cB + kstep, voffB); PG8_STAGE(PG8_SA(1, 0), cA + kstep, voffA); PG8_STAGE(PG8_SB(1, 1), cB + hstep + kstep, voffB);
    PG8_WAIT_V(6); PG8_BAR;
    PG8_STAMP();
    for (;;) {
        const bool has_next = S.next(ui + 1, nxt);
        const char* nA = has_next ? (const char*)g.A + (size_t)nxt.pm * tstep : cA; const char* nB = has_next ? (const char*)g.Bt + (size_t)nxt.pn * tstep : cB;
        for (int t = 0; t < nt; t += 2) {
            const bool last = (t == nt - 2);
            const char* a1 = cA + (size_t)(t + 1) * kstep;
            const char* a2 = last ? nA : cA + (size_t)(t + 2) * kstep; const char* b2 = last ? nB : cB + (size_t)(t + 2) * kstep;
            const char* a3 = a2 + kstep; const char* b3 = b2 + kstep;
            if (last && has_next) S.a_ready(nxt);
            PG8_LDB(B0, 0, 0); PG8_SCHED; PG8_LDA(At, 0, 0); PG8_STAGE(PG8_SA(1, 1), a1 + hstep, voffA);
            PG8_WAIT_L(8); PG8_BAR; PG8_WAIT_L(0); PG8_MMA(0, 0, At, B0); PG8_BAR; PG8_SCHED;
            PG8_LDB(B1, 0, 1); PG8_STAGE(PG8_SB(0, 0), b2, voffB);
            PG8_BAR; PG8_WAIT_L(0); PG8_MMA(0, 1, At, B1); PG8_BAR;
            PG8_LDA(At, 0, 1); PG8_STAGE(PG8_SA(0, 0), a2, voffA);
            PG8_BAR; PG8_WAIT_L(0); PG8_MMA(1, 0, At, B0); PG8_BAR; PG8_SCHED;
            PG8_STAGE(PG8_SB(0, 1), b2 + hstep, voffB);
            PG8_WAIT_V(6); PG8_BAR; PG8_MMA(1, 1, At, B1); PG8_BAR;
            PG8_LDB(B0, 1, 0); PG8_SCHED; PG8_LDA(At, 1, 0); PG8_STAGE(PG8_SA(0, 1), a2 + hstep, voffA);
            PG8_WAIT_L(8); PG8_BAR; PG8_WAIT_L(0); PG8_MMA(0, 0, At, B0); PG8_BAR; PG8_SCHED;
            PG8_LDB(B1, 1, 1); PG8_STAGE(PG8_SB(1, 0), b3, voffB);
            PG8_BAR; PG8_WAIT_L(0); PG8_MMA(0, 1, At, B1); PG8_BAR;
            PG8_LDA(At, 1, 1); PG8_STAGE(PG8_SA(1, 0), a3, voffA);
            PG8_BAR; PG8_WAIT_L(0); PG8_MMA(1, 0, At, B0); PG8_BAR; PG8_SCHED;
            PG8_STAGE(PG8_SB(1, 1), b3 + hstep, voffB);
            PG8_WAIT_V(6); PG8_BAR; PG8_MMA(1, 1, At, B1); PG8_BAR;
        }
        PG8_STAMP();
        if constexpr (!Epi::AFTER_DRAIN) { E(acc, cur, wr, wc, fr, fq); S.done(cur); }
        PG8_STAMP();
        if (!has_next) break;
#pragma unroll
        for (int a = 0; a < 2; ++a)
#pragma unroll
            for (int b = 0; b < 2; ++b)
#pragma unroll
                for (int m = 0; m < 4; ++m)
#pragma unroll
                    for (int n = 0; n < 2; ++n) acc[a][b][m][n] = (f32x4){0.f, 0.f, 0.f, 0.f};
        cur = nxt; cA = nA; cB = nB; ++ui;
    }
    PG8_WAIT_V(0);
    if (wr == 0) PG8_BAR;
    PG8_BAR;
    if constexpr (Epi::AFTER_DRAIN) { E.fused(acc, cur, wr, wc, fr, fq, lds, wid, lane); S.done(cur); }
    PG8_STAMP();
    if (STAMP && wid == 0) { stamps[lane] = lane < nts ? (((unsigned long long)(unsigned)ts_hi << 32) | (unsigned)ts_lo) : 0ull;
        if (lane == 62) stamps[62] = rt_entry; if (lane == 63) stamps[63] = (unsigned long long)wall_clock64(); }
#undef PG8_STAMP
#undef PG8_SA
#undef PG8_SB
#undef PG8_STAGE
#undef PG8_LDA
#undef PG8_LDB
#undef PG8_MMA
#undef PG8_WAIT_V
#undef PG8_WAIT_L
#undef PG8_BAR
#undef PG8_SCHED
}
}
#define XB_TMO      128
#define XB_XCNT(j)  (256  + 64 * (j))
#define XB_XSUB(j)  (1280 + 64 * (j))
#define XB_XGEN(j)  (2304 + 64 * (j))
#define XB_TOP      3328
#define XB_TOPGEN   3392
#define XCD_BAR_WORDS 3456
#define XB_SPIN_CAP (1u << 18)
#define LAS __attribute__((address_space(3)))

__device__ __forceinline__ unsigned xb_ld(unsigned* p)              { return __hip_atomic_load(p, __ATOMIC_RELAXED, __HIP_MEMORY_SCOPE_AGENT); }
__device__ __forceinline__ unsigned xb_add(unsigned* p, unsigned v) { return __hip_atomic_fetch_add(p, v, __ATOMIC_RELAXED, __HIP_MEMORY_SCOPE_AGENT); }
__device__ __forceinline__ unsigned xb_xcc_id() { return (unsigned)__builtin_amdgcn_s_getreg((3 << 11) | 20) & 0xFu; }
#define XB_SPIN(cond, bar) do { unsigned _sp = 0; while (cond) { __builtin_amdgcn_s_sleep(1); \
    if ((++_sp & 255u) == 0u) { if (xb_ld(&(bar)[XB_TMO])) break; if (_sp > XB_SPIN_CAP) { atomicAdd(&(bar)[XB_TMO], 1u); break; } } } } while (0)

struct XcdBarrier {
    unsigned* bar; unsigned x;
    volatile LAS unsigned* st;
};

__device__ __forceinline__ XcdBarrier xcd_barrier_post(unsigned* bar, volatile LAS unsigned* st) {
    XcdBarrier b; b.bar = bar; b.x = xb_xcc_id(); b.st = st;
    if (threadIdx.x == 0) (void)xb_add(&bar[XB_XCNT(b.x)], 1u);
    return b;
}
__device__ __forceinline__ void xcd_barrier_complete(unsigned* bar, unsigned x, unsigned& nloc, unsigned& nx) {
    const unsigned G = gridDim.x * gridDim.y * gridDim.z;
    unsigned sum, cnt, mine, sp = 0u;
    for (;;) {
        sum = 0u; cnt = 0u; mine = 0u;
#pragma unroll
        for (unsigned j = 0; j < 16; ++j) { const unsigned c = xb_ld(&bar[XB_XCNT(j)]); sum += c; cnt += (c > 0u) ? 1u : 0u; mine = (j == x) ? c : mine; }
        if (sum == G) break;
        __builtin_amdgcn_s_sleep(1);
        if ((++sp & 255u) == 0u) { if (xb_ld(&bar[XB_TMO])) break; if (sp > XB_SPIN_CAP) { atomicAdd(&bar[XB_TMO], 1u); break; } }
    }
    nloc = mine > 0u ? mine : 1u; nx = cnt > 0u ? cnt : 1u;
}

__device__ __forceinline__ void xcd_barrier(const XcdBarrier& b) {
    asm volatile("s_waitcnt vmcnt(0)" ::: "memory");
    __syncthreads();
    if (threadIdx.x == 0) {
        unsigned* bar = b.bar;
        __builtin_amdgcn_s_waitcnt(0);
        unsigned nloc = b.st[0], nx = b.st[1];
        if (nloc == 0u) { xcd_barrier_complete(bar, b.x, nloc, nx); b.st[0] = nloc; b.st[1] = nx; }
        const unsigned old = xb_add(&bar[XB_XSUB(b.x)], 1u);
        const unsigned gen = old / nloc;
        if (old + 1u == (gen + 1u) * nloc) {
            __builtin_amdgcn_fence(__ATOMIC_RELEASE, "agent");
            asm volatile("s_waitcnt vmcnt(0)" ::: "memory");
            const unsigned og = xb_add(&bar[XB_TOP], 1u);
            const unsigned tg = og / nx;
            if (og + 1u == (tg + 1u) * nx) xb_add(&bar[XB_TOPGEN], 1u);
            else XB_SPIN(xb_ld(&bar[XB_TOPGEN]) == tg, bar);
            __builtin_amdgcn_fence(__ATOMIC_ACQUIRE, "agent");
            xb_add(&bar[XB_XGEN(b.x)], 1u);
            asm volatile("s_waitcnt vmcnt(0)" ::: "memory");
        } else {
            XB_SPIN(xb_ld(&bar[XB_XGEN(b.x)]) == gen, bar);
            __builtin_amdgcn_fence(__ATOMIC_ACQUIRE, "agent");
            asm volatile("s_waitcnt vmcnt(0)" ::: "memory");
        }
    }
    __syncthreads();
}


typedef unsigned short bf16_t;
typedef float f32x4 __attribute__((ext_vector_type(4)));
typedef unsigned u32x4 __attribute__((ext_vector_type(4)));
typedef unsigned u32x2 __attribute__((ext_vector_type(2)));
constexpr int DM = 1024, NBATCH = 2, SEQ = 16384, M = NBATCH * SEQ, DEPTH = 4, PLE = 256;
constexpr float EPS = 1e-6f;
constexpr int EVEN_IN = 7168, ODD_IN = 8208;
constexpr int N1A_E = 3072, N1B_E = 4096, N1A_O = 4352, N1B_O = 4096;
constexpr int NUNIT_O = 2048;
constexpr int LDS_BYTES = 147456;
constexpr int LDS_BAR_OFF = LDS_BYTES - 16;

constexpr size_t MiB = 1u << 20;
constexpr size_t WS_CTL = 0, CTL_BYTES = 64 * 1024;
constexpr size_t WS_SSQA = 1 * MiB, WS_SSQY = 3 * MiB, WS_RSTD1 = 5 * MiB, WS_GATE = 6 * MiB, WS_GB = 8 * MiB, WS_CS = 10 * MiB, WS_MS = 10 * MiB + 65536, WS_NS = 11 * MiB;
constexpr size_t WS_WG = 12 * MiB, WS_WP = 20 * MiB, WS_WIN = 22 * MiB, WS_WOUT = 39 * MiB;
constexpr size_t WS_HBA = 44 * MiB, WS_R1 = 108 * MiB, WS_R2 = 172 * MiB, WS_R3 = 236 * MiB, WS_R4 = 364 * MiB, WS_END = 492 * MiB;

__device__ __forceinline__ float bf2f(bf16_t b) { return __uint_as_float(((unsigned)b) << 16); }
__device__ __forceinline__ bf16_t f2bf(float f) { unsigned u = __float_as_uint(f); u += 0x7FFFu + ((u >> 16) & 1u); return (bf16_t)(u >> 16); }
__device__ __forceinline__ unsigned pk2(float lo, float hi) { return pg8::cvt_pk_bf16(lo, hi); }
__device__ __forceinline__ void unpack8(const u32x4 w, float (&f)[8]) {
    f[0] = __uint_as_float(w.x << 16); f[1] = __uint_as_float(w.x & 0xffff0000u); f[2] = __uint_as_float(w.y << 16); f[3] = __uint_as_float(w.y & 0xffff0000u);
    f[4] = __uint_as_float(w.z << 16); f[5] = __uint_as_float(w.z & 0xffff0000u); f[6] = __uint_as_float(w.w << 16); f[7] = __uint_as_float(w.w & 0xffff0000u);
}
__device__ __forceinline__ u32x4 pack8(const float (&f)[8]) { u32x4 w; w.x = pk2(f[0], f[1]); w.y = pk2(f[2], f[3]); w.z = pk2(f[4], f[5]); w.w = pk2(f[6], f[7]); return w; }
__device__ __forceinline__ float sigmoidf_(float x) { return __builtin_amdgcn_rcpf(1.0f + __expf(-x)); }
__device__ __forceinline__ float siluf_(float x) { return x * sigmoidf_(x); }
__device__ __forceinline__ float logsigmoidf_(float x) { return fminf(x, 0.f) - log1pf(__expf(-fabsf(x))); }
__device__ __forceinline__ float wave_sum(float s) { s += __shfl_xor(s, 1); s += __shfl_xor(s, 2); s += __shfl_xor(s, 4); s += __shfl_xor(s, 8); s += __shfl_xor(s, 16); s += __shfl_xor(s, 32); return s; }
__device__ __forceinline__ float rstd16(const float* p) {
    const f32x4 a = *(const f32x4*)p, b = *(const f32x4*)(p + 4), c = *(const f32x4*)(p + 8), d = *(const f32x4*)(p + 12);
    const float s = ((a[0] + a[1]) + (a[2] + a[3])) + ((b[0] + b[1]) + (b[2] + b[3])) + ((c[0] + c[1]) + (c[2] + c[3])) + ((d[0] + d[1]) + (d[2] + d[3]));
    return rsqrtf(s * (1.0f / 1024.0f) + EPS);
}

namespace pg8 {
#define EPI_ROWS_BEGIN  _Pragma("unroll") for (int ai = 0; ai < 2; ++ai) _Pragma("unroll") for (int m = 0; m < 4; ++m) { const int row = rowb + ai * HALF + m * 16;
#define EPI_ROWS_END    asm volatile("" ::: "memory"); }
struct EpiE1a { static constexpr bool PERM = true, AFTER_DRAIN = false;
    const float* ssq; bf16_t* U; bf16_t* BV;
    __device__ __forceinline__ void operator()(const f32x4 (&acc)[2][2][4][2], const Unit& u, int wr, int wc, int fr, int fq) const {
        const int rowb = u.pm * BM + wr * 64 + fr, cw = wc * 32 + 8 * fq;
        EPI_ROWS_BEGIN
            const float rs = rstd16(ssq + (size_t)row * 16);
            if (u.pn < 8) {
                const f32x4 p0 = (acc[ai][0][m][0] * rs) * (acc[ai][1][m][0] * rs), p1 = (acc[ai][0][m][1] * rs) * (acc[ai][1][m][1] * rs);
                u32x4 w; w.x = cvt_pk_bf16(p0[0], p0[1]); w.y = cvt_pk_bf16(p0[2], p0[3]); w.z = cvt_pk_bf16(p1[0], p1[1]); w.w = cvt_pk_bf16(p1[2], p1[3]);
                *(u32x4*)(U + (size_t)row * 1024 + u.pn * 128 + cw) = w;
            } else {
#pragma unroll
                for (int bj = 0; bj < 2; ++bj) { const f32x4 v0 = acc[ai][bj][m][0] * rs, v1 = acc[ai][bj][m][1] * rs;
                    u32x4 w; w.x = cvt_pk_bf16(v0[0], v0[1]); w.y = cvt_pk_bf16(v0[2], v0[3]); w.z = cvt_pk_bf16(v1[0], v1[1]); w.w = cvt_pk_bf16(v1[2], v1[3]);
                    *(u32x4*)(BV + (size_t)row * 1024 + (u.pn - 8) * 256 + bj * HALF + cw) = w; }
            }
        EPI_ROWS_END
    }
};
struct EpiE1b { static constexpr bool PERM = true, AFTER_DRAIN = false;
    const float* ssq; const bf16_t* U; const bf16_t* S; const float* convw; bf16_t* MIX;
    __device__ __forceinline__ void operator()(const f32x4 (&acc)[2][2][4][2], const Unit& u, int wr, int wc, int fr, int fq) const {
        const int rowb = u.pm * BM + wr * 64 + fr, cw = wc * 32 + 8 * fq;
        if (u.pn < 8) {
            const int ch0 = u.pn * 128 + cw;
            float w0[8], w1[8], w2[8];
#pragma unroll
            for (int j = 0; j < 8; ++j) { w0[j] = convw[ch0 + j]; w1[j] = convw[1024 + ch0 + j]; w2[j] = convw[2048 + ch0 + j]; }
            EPI_ROWS_BEGIN
                const float rs = rstd16(ssq + (size_t)row * 16);
                const int ts = row & (SEQ - 1);
                const bf16_t* up = U + (size_t)row * 1024 + ch0;
                float u0[8], u1[8], u2[8];
                unpack8(*(const u32x4*)up, u2);
                if (ts >= 1) unpack8(*(const u32x4*)(up - 1024), u1); else {
#pragma unroll
                    for (int j = 0; j < 8; ++j) u1[j] = 0.f; }
                if (ts >= 2) unpack8(*(const u32x4*)(up - 2048), u0); else {
#pragma unroll
                    for (int j = 0; j < 8; ++j) u0[j] = 0.f; }
                float o[8];
#pragma unroll
                for (int j = 0; j < 8; ++j) { const float ab = acc[ai][0][m][j >> 2][j & 3] * rs, ag = acc[ai][1][m][j >> 2][j & 3] * rs;
                    o[j] = ab * siluf_(ag) * (w2[j] * u2[j] + w1[j] * u1[j] + w0[j] * u0[j]); }
                *(u32x4*)(MIX + (size_t)row * 2048 + ch0) = pack8(o);
            EPI_ROWS_END
        } else {
            const int ch0 = (u.pn - 8) * 128 + cw;
            EPI_ROWS_BEGIN
                const float rs = rstd16(ssq + (size_t)row * 16);
                float sv[8]; unpack8(*(const u32x4*)(S + (size_t)row * 1024 + ch0), sv);
                float o[8];
#pragma unroll
                for (int j = 0; j < 8; ++j) { const float bu = acc[ai][0][m][j >> 2][j & 3] * rs, bg = acc[ai][1][m][j >> 2][j & 3] * rs; o[j] = bu * siluf_(bg) * sv[j]; }
                *(u32x4*)(MIX + (size_t)row * 2048 + 1024 + ch0) = pack8(o);
            EPI_ROWS_END
        }
    }
};
struct EpiO1a { static constexpr bool PERM = true, AFTER_DRAIN = false;
    const float* ssq; bf16_t* Q; bf16_t* K; bf16_t* V; float* GATE;
    __device__ __forceinline__ void operator()(const f32x4 (&acc)[2][2][4][2], const Unit& u, int wr, int wc, int fr, int fq) const {
        const int rowb = u.pm * BM + wr * 64 + fr, cw = wc * 32 + 8 * fq;
        if (u.pn < 16) {
            bf16_t* base; int ld, c0;
            if (u.pn < 4) { base = Q; ld = 1024; c0 = u.pn * 256; } else if (u.pn < 8) { base = K; ld = 1024; c0 = (u.pn - 4) * 256; } else { base = V; ld = 2048; c0 = (u.pn - 8) * 256; }
            EPI_ROWS_BEGIN
                const float rs = rstd16(ssq + (size_t)row * 16);
#pragma unroll
                for (int bj = 0; bj < 2; ++bj) { const f32x4 v0 = acc[ai][bj][m][0] * rs, v1 = acc[ai][bj][m][1] * rs;
                    u32x4 w; w.x = cvt_pk_bf16(v0[0], v0[1]); w.y = cvt_pk_bf16(v0[2], v0[3]); w.z = cvt_pk_bf16(v1[0], v1[1]); w.w = cvt_pk_bf16(v1[2], v1[3]);
                    *(u32x4*)(base + (size_t)row * ld + c0 + bj * HALF + cw) = w; }
            EPI_ROWS_END
        } else if (wc == 0 && fq < 2) {
            EPI_ROWS_BEGIN
                const float rs = rstd16(ssq + (size_t)row * 16);
                *(f32x4*)(GATE + (size_t)row * 16 + 8 * fq) = acc[ai][0][m][0] * rs;
                *(f32x4*)(GATE + (size_t)row * 16 + 8 * fq + 4) = acc[ai][0][m][1] * rs;
            EPI_ROWS_END
        }
    }
};
struct EpiO1b { static constexpr bool PERM = true, AFTER_DRAIN = false;
    const float* ssq; const bf16_t* HC; bf16_t* MIX;
    __device__ __forceinline__ void operator()(const f32x4 (&acc)[2][2][4][2], const Unit& u, int wr, int wc, int fr, int fq) const {
        const int rowb = u.pm * BM + wr * 64 + fr, ch0 = u.pn * 128 + wc * 32 + 8 * fq;
        EPI_ROWS_BEGIN
            const float rs = rstd16(ssq + (size_t)row * 16);
            float hv[8]; unpack8(*(const u32x4*)(HC + (size_t)row * 2048 + ch0), hv);
            float o[8];
#pragma unroll
            for (int j = 0; j < 8; ++j) { const float oo = acc[ai][0][m][j >> 2][j & 3] * rs, zz = acc[ai][1][m][j >> 2][j & 3] * rs; o[j] = hv[j] * sigmoidf_(oo) * siluf_(zz); }
            *(u32x4*)(MIX + (size_t)row * 2048 + ch0) = pack8(o);
        EPI_ROWS_END
    }
};
struct EpiOut { static constexpr bool PERM = true, AFTER_DRAIN = false;
    bf16_t* Y; float* SSQ;
    __device__ __forceinline__ void operator()(const f32x4 (&acc)[2][2][4][2], const Unit& u, int wr, int wc, int fr, int fq) const {
        const int rowb = u.pm * BM + wr * 64 + fr, cw = wc * 32 + 8 * fq;
        EPI_ROWS_BEGIN
            float s = 0.f;
#pragma unroll
            for (int bj = 0; bj < 2; ++bj) { const f32x4 v0 = acc[ai][bj][m][0], v1 = acc[ai][bj][m][1];
                s += (v0[0] * v0[0] + v0[1] * v0[1]) + (v0[2] * v0[2] + v0[3] * v0[3]) + (v1[0] * v1[0] + v1[1] * v1[1]) + (v1[2] * v1[2] + v1[3] * v1[3]);
                u32x4 w; w.x = cvt_pk_bf16(v0[0], v0[1]); w.y = cvt_pk_bf16(v0[2], v0[3]); w.z = cvt_pk_bf16(v1[0], v1[1]); w.w = cvt_pk_bf16(v1[2], v1[3]);
                *(u32x4*)(Y + (size_t)row * 1024 + u.pn * 256 + bj * HALF + cw) = w; }
            s += __shfl_xor(s, 16); s += __shfl_xor(s, 32);
            if (fq == 0) SSQ[(size_t)row * 16 + u.pn * 4 + wc] = s;
        EPI_ROWS_END
    }
};
struct EpiPw { static constexpr bool PERM = true, AFTER_DRAIN = false;
    bf16_t* PW;
    __device__ __forceinline__ void operator()(const f32x4 (&acc)[2][2][4][2], const Unit& u, int wr, int wc, int fr, int fq) const {
        const int rowb = u.pm * BM + wr * 64 + fr, cw = wc * 32 + 8 * fq;
        EPI_ROWS_BEGIN
#pragma unroll
            for (int bj = 0; bj < 2; ++bj) { const f32x4 v0 = acc[ai][bj][m][0], v1 = acc[ai][bj][m][1];
                u32x4 w; w.x = cvt_pk_bf16(v0[0], v0[1]); w.y = cvt_pk_bf16(v0[2], v0[3]); w.z = cvt_pk_bf16(v1[0], v1[1]); w.w = cvt_pk_bf16(v1[2], v1[3]);
                *(u32x4*)(PW + (size_t)row * 1024 + u.pn * 256 + bj * HALF + cw) = w; }
        EPI_ROWS_END
    }
};
struct EpiGate { static constexpr bool PERM = true, AFTER_DRAIN = false;
    const float* RSTD1; const bf16_t* PW; float* H; bf16_t* HB; float* SSQ;
    __device__ __forceinline__ void operator()(const f32x4 (&acc)[2][2][4][2], const Unit& u, int wr, int wc, int fr, int fq) const {
        const int rowb = u.pm * BM + wr * 64 + fr, cw = wc * 32 + 8 * fq;
        EPI_ROWS_BEGIN
            const float rs = RSTD1[row]; float s = 0.f;
#pragma unroll
            for (int bj = 0; bj < 2; ++bj) { const size_t off = (size_t)row * 1024 + u.pn * 256 + bj * HALF + cw;
                float pw[8]; unpack8(*(const u32x4*)(PW + off), pw);
                const f32x4 h0 = *(const f32x4*)(H + off), h1 = *(const f32x4*)(H + off + 4);
                float o[8];
#pragma unroll
                for (int j = 0; j < 8; ++j) { const float g = sigmoidf_(acc[ai][bj][m][j >> 2][j & 3] * rs); o[j] = (j < 4 ? h0[j & 3] : h1[j & 3]) + g * pw[j]; s += o[j] * o[j]; }
                *(f32x4*)(H + off) = (f32x4){o[0], o[1], o[2], o[3]}; *(f32x4*)(H + off + 4) = (f32x4){o[4], o[5], o[6], o[7]};
                *(u32x4*)(HB + off) = pack8(o); }
            s += __shfl_xor(s, 16); s += __shfl_xor(s, 32);
            if (fq == 0) SSQ[(size_t)row * 16 + u.pn * 4 + wc] = s;
        EPI_ROWS_END
    }
};
}

struct MapE1a { __device__ __forceinline__ int operator()(int np, float& sc) const { sc = 1.f; const int t = np >> 8; if (t < 8) { const int bj = (np >> 7) & 1, c = np & 127; return (bj ? 2048 : 1024) + t * 128 + c; } return 5120 + (np - 2048); } };
struct MapE1b { __device__ __forceinline__ int operator()(int np, float& sc) const { sc = 1.f; const int t = np >> 8, bj = (np >> 7) & 1, c = np & 127; if (t < 8) return (bj ? 3072 : 0) + t * 128 + c; return (bj ? 6144 : 4096) + (t - 8) * 128 + c; } };
struct MapO1a { __device__ __forceinline__ int operator()(int np, float& sc) const { sc = (np < 1024) ? 0.08838834764831845f : 1.f; if (np < 4096) return np; const int c = np - 4096; return c < 16 ? 8192 + c : -1; } };
struct MapO1b { __device__ __forceinline__ int operator()(int np, float& sc) const { sc = 1.f; const int t = np >> 8, bj = (np >> 7) & 1, c = np & 127; return (bj ? 6144 : 4096) + t * 128 + c; } };
struct MapId  { __device__ __forceinline__ int operator()(int np, float& sc) const { sc = 1.f; return np; } };
template <class F> __device__ __forceinline__ void conv_w(bf16_t* dst, const float* src, int K, int Nsrc, int Nrows, const float* gk, F map, int gt, int nth) {
    const int total = Nrows * (K >> 3);
    for (int idx = gt; idx < total; idx += nth) {
        const int np = idx % Nrows, k8 = idx / Nrows; float sc; const int n = map(np, sc);
        float v[8];
#pragma unroll
        for (int j = 0; j < 8; ++j) { const int k = k8 * 8 + j; v[j] = (n >= 0) ? src[(size_t)k * Nsrc + n] * (gk ? gk[k] : 1.f) * sc : 0.f; }
        *(u32x4*)(dst + (size_t)np * K + k8 * 8) = pack8(v);
    }
}

struct Ptrs { float* out; unsigned char* ws; };
template <int I> __device__ __forceinline__ const float* inp_() {
    const unsigned long long ka = (unsigned long long)__builtin_amdgcn_kernarg_segment_ptr(); unsigned long long v;
    asm volatile("s_load_dwordx2 %0, %1, %2\n\ts_waitcnt lgkmcnt(0)" : "=s"(v) : "s"(ka), "n"(I * 8) : "memory");
    return (const float*)v;
}
#define INP(i) (inp_<i>())
#define LAS3 __attribute__((address_space(3)))

__device__ __forceinline__ void prep_layer_weights(const Ptrs& P, int L, int gt, int nth) {
    const int j = L >> 1; bf16_t* WIN = (bf16_t*)(P.ws + WS_WIN); bf16_t* WOUT = (bf16_t*)(P.ws + WS_WOUT);
    const float* pre_g = INP(2) + (size_t)L * DM;
    if ((L & 1) == 0) {
        const float* w = INP(7) + (size_t)j * DM * EVEN_IN;
        conv_w(WIN, w, DM, EVEN_IN, N1A_E, pre_g, MapE1a(), gt, nth);
        conv_w(WIN + (size_t)N1A_E * DM, w, DM, EVEN_IN, N1B_E, pre_g, MapE1b(), gt, nth);
        conv_w(WOUT, INP(13) + (size_t)j * 2048 * DM, 2048, DM, DM, nullptr, MapId(), gt, nth);
    } else {
        const float* w = INP(14) + (size_t)j * DM * ODD_IN;
        conv_w(WIN, w, DM, ODD_IN, N1A_O, pre_g, MapO1a(), gt, nth);
        conv_w(WIN + (size_t)N1A_O * DM, w, DM, ODD_IN, N1B_O, pre_g, MapO1b(), gt, nth);
        conv_w(WOUT, INP(17) + (size_t)j * 2048 * DM, 2048, DM, DM, nullptr, MapId(), gt, nth);
    }
}

__device__ __forceinline__ void phase_prologue(const Ptrs& P, int G, int bid, int tid) {
    const int lane = tid & 63, wid = tid >> 6;
    const float* x = INP(0); bf16_t* HBA = (bf16_t*)(P.ws + WS_HBA); float* SSQA = (float*)(P.ws + WS_SSQA);
    for (int row = bid * 8 + wid; row < M; row += G * 8) {
        float sq = 0.f;
#pragma unroll
        for (int i = 0; i < 2; ++i) { const size_t off = (size_t)row * DM + i * 512 + lane * 8;
            const f32x4 a = *(const f32x4*)(x + off), b = *(const f32x4*)(x + off + 4);
            const float o[8] = {a[0], a[1], a[2], a[3], b[0], b[1], b[2], b[3]};
#pragma unroll
            for (int j = 0; j < 8; ++j) sq += o[j] * o[j];
            *(u32x4*)(HBA + off) = pack8(o); }
        sq = wave_sum(sq);
        if (lane < 16) SSQA[(size_t)row * 16 + lane] = (lane == 0) ? sq : 0.f;
    }
    const int gt = bid * 512 + tid, nth = G * 512;
    for (int L = 0; L < DEPTH; ++L) {
        conv_w((bf16_t*)(P.ws + WS_WG) + (size_t)L * DM * DM, INP(6) + (size_t)L * DM * DM, DM, DM, DM, INP(4) + (size_t)L * DM, MapId(), gt, nth);
        conv_w((bf16_t*)(P.ws + WS_WP) + (size_t)L * DM * PLE, INP(5) + (size_t)L * PLE * DM, PLE, DM, DM, nullptr, MapId(), gt, nth);
    }
    prep_layer_weights(P, 0, gt, nth);
}

__device__ __forceinline__ void phase_p4(const Ptrs& P, int L, int G, int bid, int tid) {
    const int lane = tid & 63, wid = tid >> 6;
    const float* hin = (L == 0) ? INP(0) : P.out; float* H = P.out;
    const bf16_t* Y = (const bf16_t*)(P.ws + WS_R1); const float* SSQY = (const float*)(P.ws + WS_SSQY);
    bf16_t* HBB = (bf16_t*)(P.ws + WS_R3); float* RSTD1 = (float*)(P.ws + WS_RSTD1);
    const float* pg = INP(3) + (size_t)L * DM;
    f32x4 g[2][2];
#pragma unroll
    for (int i = 0; i < 2; ++i) { g[i][0] = *(const f32x4*)(pg + i * 512 + lane * 8); g[i][1] = *(const f32x4*)(pg + i * 512 + lane * 8 + 4); }
    for (int row = bid * 8 + wid; row < M; row += G * 8) {
        float s = (lane < 16) ? SSQY[(size_t)row * 16 + lane] : 0.f;
        s = wave_sum(s);
        const float rsy = rsqrtf(s * (1.0f / 1024.0f) + EPS);
        float sq = 0.f;
#pragma unroll
        for (int i = 0; i < 2; ++i) { const size_t off = (size_t)row * DM + i * 512 + lane * 8;
            float yv[8]; unpack8(*(const u32x4*)(Y + off), yv);
            const f32x4 a = *(const f32x4*)(hin + off), b = *(const f32x4*)(hin + off + 4);
            float o[8];
#pragma unroll
            for (int j = 0; j < 8; ++j) { o[j] = (j < 4 ? a[j & 3] : b[j & 3]) + yv[j] * rsy * g[i][j >> 2][j & 3]; sq += o[j] * o[j]; }
            *(f32x4*)(H + off) = (f32x4){o[0], o[1], o[2], o[3]}; *(f32x4*)(H + off + 4) = (f32x4){o[4], o[5], o[6], o[7]};
            *(u32x4*)(HBB + off) = pack8(o); }
        sq = wave_sum(sq);
        if (lane == 0) RSTD1[row] = rsqrtf(sq * (1.0f / 1024.0f) + EPS);
    }
    const int gt = bid * 512 + tid, nth = G * 512;
    const float* pl = INP(1) + (size_t)L * M * PLE; bf16_t* PB = (bf16_t*)(P.ws + WS_R3 + 64 * MiB);
    for (int i = gt; i < M * PLE / 8; i += nth) { const f32x4 a = *(const f32x4*)(pl + (size_t)i * 8), b = *(const f32x4*)(pl + (size_t)i * 8 + 4);
        const float o[8] = {a[0], a[1], a[2], a[3], b[0], b[1], b[2], b[3]}; *(u32x4*)(PB + (size_t)i * 8) = pack8(o); }
    if (L + 1 < DEPTH) prep_layer_weights(P, L + 1, gt, nth);
}

__device__ __forceinline__ void phase_gm(LAS3 unsigned char* lds, const Ptrs& P, int j, int G, int bid, int tid_in) {
    LAS3 float* Wt = (LAS3 float*)lds; LAS3 float* Vt = (LAS3 float*)(lds + 65536); LAS3 float* mu = (LAS3 float*)(lds + 131072); LAS3 float* rsd = mu + 128;
    const bf16_t* BV = (const bf16_t*)(P.ws + WS_R2); bf16_t* S = (bf16_t*)(P.ws + WS_R3);
    const float* ws_ = INP(11) + (size_t)j * 8 * 128 * 128; const float* bs = INP(12) + (size_t)j * 128 * 8;
    const float* lg = INP(9) + (size_t)j * 1024; const float* lb = INP(10) + (size_t)j * 1024;
    for (int c = bid; c < M / 128; c += G) {
        int tid = tid_in; asm volatile("" : "+v"(tid));
        const int lane = tid & 63, wid = tid >> 6;
        const int r0 = c * 128;
#pragma unroll 2
        for (int rr = 0; rr < 16; ++rr) { const int row = wid * 16 + rr; const bf16_t* p = BV + (size_t)(r0 + row) * 1024;
            float a[8], b[8]; unpack8(*(const u32x4*)(p + lane * 8), a); unpack8(*(const u32x4*)(p + 512 + lane * 8), b);
            float s = 0.f;
#pragma unroll
            for (int q = 0; q < 8; ++q) s += a[q] + b[q];
            s = wave_sum(s); const float mean = s * (1.0f / 1024.0f); float v = 0.f;
#pragma unroll
            for (int q = 0; q < 8; ++q) { const float d0 = a[q] - mean, d1 = b[q] - mean; v += d0 * d0 + d1 * d1; }
            v = wave_sum(v);
            if (lane == 0) { mu[row] = mean; rsd[row] = rsqrtf(v * (1.0f / 1024.0f) + EPS); } }
        __syncthreads();
#pragma unroll 1
        for (int g = 0; g < 8; ++g) {
            asm volatile("" : "+v"(tid));
#pragma unroll 4
            for (int i = 0; i < 32; ++i) { const int e = tid + 512 * i, t = e >> 7, s = e & 127;
                Wt[s * 128 + t] = (s <= t) ? ws_[(size_t)g * 16384 + e] : 0.f; }
#pragma unroll 4
            for (int i = 0; i < 32; ++i) { const int e = tid + 512 * i, s = e >> 7, cc = e & 127;
                Vt[e] = (bf2f(BV[(size_t)(r0 + s) * 1024 + g * 128 + cc]) - mu[s]) * rsd[s] * lg[g * 128 + cc] + lb[g * 128 + cc]; }
            __syncthreads();
            const int cc = tid & 127, tq = tid >> 7;
            float acc[32];
#pragma unroll
            for (int i = 0; i < 32; ++i) acc[i] = 0.f;
            const int smax = tq * 32 + 31;
#pragma unroll 1
            for (int s = 0; s <= smax; ++s) { const float vv = Vt[s * 128 + cc];
#pragma unroll
                for (int i4 = 0; i4 < 8; ++i4) { const f32x4 w4 = *(const LAS3 f32x4*)&Wt[s * 128 + tq * 32 + i4 * 4];
                    acc[i4 * 4 + 0] += w4[0] * vv; acc[i4 * 4 + 1] += w4[1] * vv; acc[i4 * 4 + 2] += w4[2] * vv; acc[i4 * 4 + 3] += w4[3] * vv; } }
#pragma unroll
            for (int i = 0; i < 32; ++i) { const int t = tq * 32 + i; S[(size_t)(r0 + t) * 1024 + g * 128 + cc] = f2bf(acc[i] + bs[t * 8 + g]); }
            __syncthreads();
        }
    }
}

__device__ __forceinline__ void phase_o2(LAS3 unsigned char* lds, const Ptrs& P, int j, int G, int bid, int tid_in) {
    LAS3 float* Kw = (LAS3 float*)lds; LAS3 bf16_t* Vs = (LAS3 bf16_t*)(lds + 65536); LAS3 float* sc = (LAS3 float*)(lds + 131072); LAS3 float* wv = sc + 128;
    const bf16_t* Kb = (const bf16_t*)(P.ws + WS_R2); const bf16_t* Vb = (const bf16_t*)(P.ws + WS_R3);
    const float* GATE = (const float*)(P.ws + WS_GATE); float* GB = (float*)(P.ws + WS_GB); float* CS = (float*)(P.ws + WS_CS);
    bf16_t* UC = (bf16_t*)(P.ws + WS_R4); float* NS = (float*)(P.ws + WS_NS);
    const float* bif = INP(15) + (size_t)j * 16;
    for (int unit = bid; unit < NUNIT_O; unit += G) {
        int tid = tid_in; asm volatile("" : "+v"(tid));
        const int chain = unit >> 7, n = unit & 127, b = chain >> 3, h = chain & 7, r0 = b * SEQ + n * 128;
        float ii = 0.f, a = 0.f;
        if (tid < 128) { const float fi = GATE[(size_t)(r0 + tid) * 16 + 8 + h] + bif[8 + h]; ii = GATE[(size_t)(r0 + tid) * 16 + h] + bif[h]; sc[tid] = logsigmoidf_(fi); }
        __syncthreads();
        for (int off = 1; off < 128; off <<= 1) { float v = 0.f; if (tid < 128) v = sc[tid] + (tid >= off ? sc[tid - off] : 0.f); __syncthreads(); if (tid < 128) sc[tid] = v; __syncthreads(); }
        const float gtot = sc[127];
        if (tid < 128) { a = gtot - sc[tid] + ii; wv[tid] = a; GB[((size_t)(r0 + tid) * 8 + h) * 2] = sc[tid]; GB[((size_t)(r0 + tid) * 8 + h) * 2 + 1] = ii; }
        __syncthreads();
        float amax = -3.0e38f;
        for (int t = 0; t < 128; ++t) amax = fmaxf(amax, wv[t]);
        __syncthreads();
        if (tid < 128) wv[tid] = __expf(a - amax);
        if (tid == 0) { CS[(size_t)unit * 2] = gtot; CS[(size_t)unit * 2 + 1] = amax; }
        __syncthreads();
#pragma unroll
        for (int i = 0; i < 4; ++i) { const int e8 = tid + 512 * i, s = e8 >> 4, k8 = e8 & 15;
            float kv[8]; unpack8(*(const u32x4*)(Kb + (size_t)(r0 + s) * 1024 + h * 128 + k8 * 8), kv); const float w = wv[s];
            *(LAS3 f32x4*)&Kw[s * 128 + k8 * 8] = (f32x4){kv[0] * w, kv[1] * w, kv[2] * w, kv[3] * w}; *(LAS3 f32x4*)&Kw[s * 128 + k8 * 8 + 4] = (f32x4){kv[4] * w, kv[5] * w, kv[6] * w, kv[7] * w}; }
#pragma unroll
        for (int i = 0; i < 8; ++i) { const int e8 = tid + 512 * i, s = e8 >> 5, v8 = e8 & 31;
            *(LAS3 u32x4*)&Vs[s * 256 + v8 * 8] = *(const u32x4*)(Vb + (size_t)(r0 + s) * 2048 + h * 256 + v8 * 8); }
        __syncthreads();
        const int vv = tid & 255, kq = tid >> 8;
        float acc[64];
#pragma unroll
        for (int i = 0; i < 64; ++i) acc[i] = 0.f;
#pragma unroll 1
        for (int s = 0; s < 128; ++s) { const float vval = bf2f(Vs[s * 256 + vv]);
#pragma unroll
            for (int i4 = 0; i4 < 16; ++i4) { const f32x4 k4 = *(const LAS3 f32x4*)&Kw[s * 128 + kq * 64 + i4 * 4];
                acc[i4 * 4 + 0] += k4[0] * vval; acc[i4 * 4 + 1] += k4[1] * vval; acc[i4 * 4 + 2] += k4[2] * vval; acc[i4 * 4 + 3] += k4[3] * vval; } }
#pragma unroll
        for (int i = 0; i < 64; ++i) UC[((size_t)unit * 128 + kq * 64 + i) * 256 + vv] = f2bf(acc[i]);
        if (tid < 128) { float ns = 0.f; for (int s = 0; s < 128; ++s) ns += Kw[s * 128 + tid]; NS[(size_t)unit * 128 + tid] = ns; }
        __syncthreads();
    }
}

__device__ __forceinline__ void phase_o3(LAS3 unsigned char* lds, const Ptrs& P, int G, int bid, int tid) {
    LAS3 float* dec = (LAS3 float*)lds; LAS3 float* scl = dec + 128; LAS3 float* gg = scl + 128; LAS3 float* am = gg + 128;
    const float* CS = (const float*)(P.ws + WS_CS); float* MS = (float*)(P.ws + WS_MS); bf16_t* UC = (bf16_t*)(P.ws + WS_R4); float* NS = (float*)(P.ws + WS_NS);
    for (int task = bid; task < 256; task += G) {
        const int chain = task >> 4, eb = task & 15;
        if (tid < 128) { gg[tid] = CS[((size_t)chain * 128 + tid) * 2]; am[tid] = CS[((size_t)chain * 128 + tid) * 2 + 1]; }
        __syncthreads();
        if (tid == 0) { float m = 0.f;
            for (int n = 0; n < 128; ++n) { const float g = gg[n], a = am[n], mn = fmaxf(g + m, a); dec[n] = __expf(g + m - mn); scl[n] = __expf(a - mn); if (eb == 0) MS[chain * 128 + n] = m; m = mn; } }
        __syncthreads();
        const size_t e = (size_t)eb * 2048 + tid * 4;
        float c0 = 0.f, c1 = 0.f, c2 = 0.f, c3 = 0.f;
        for (int n0 = 0; n0 < 128; n0 += 8) {
            u32x2 u[8];
#pragma unroll
            for (int q = 0; q < 8; ++q) u[q] = *(const u32x2*)(UC + ((size_t)chain * 128 + n0 + q) * 32768 + e);
#pragma unroll
            for (int q = 0; q < 8; ++q) { u32x2 w; w.x = pk2(c0, c1); w.y = pk2(c2, c3); *(u32x2*)(UC + ((size_t)chain * 128 + n0 + q) * 32768 + e) = w;
                const float d = dec[n0 + q], s = scl[n0 + q];
                c0 = d * c0 + s * __uint_as_float(u[q].x << 16); c1 = d * c1 + s * __uint_as_float(u[q].x & 0xffff0000u);
                c2 = d * c2 + s * __uint_as_float(u[q].y << 16); c3 = d * c3 + s * __uint_as_float(u[q].y & 0xffff0000u); }
        }
        if (eb == 0 && tid < 128) { float cn = 0.f;
            for (int n = 0; n < 128; ++n) { const size_t o = ((size_t)chain * 128 + n) * 128 + tid; const float v = NS[o]; NS[o] = cn; cn = dec[n] * cn + scl[n] * v; } }
        __syncthreads();
    }
}


template <int hv> __device__ __forceinline__ void o4_half(float (&acc)[32], LAS3 unsigned char* KV, const LAS3 bf16_t* Qt, const LAS3 float* Pt, const LAS3 float* isc, const bf16_t* UC, const bf16_t* Vb,
                                                         int unit, int r0, int h, int tid, int vv, int th) {
    __syncthreads();
#pragma unroll
    for (int i = 0; i < 4; ++i) { const int e8 = tid + 512 * i, kk = e8 >> 4, v8 = e8 & 15;
        *(LAS3 u32x4*)(KV + (kk * 128 + v8 * 8) * 2) = *(const u32x4*)(UC + ((size_t)unit * 128 + kk) * 256 + hv * 128 + v8 * 8); }
    __syncthreads();
#pragma unroll
    for (int i = 0; i < 32; ++i) acc[i] = 0.f;
    const LAS3 bf16_t* Ch = (const LAS3 bf16_t*)KV;
#pragma unroll 1
    for (int kk = 0; kk < 128; ++kk) { const float cv = bf2f(Ch[kk * 128 + vv]);
#pragma unroll
        for (int i8 = 0; i8 < 4; ++i8) { float qv[8]; unpack8(*(const LAS3 u32x4*)&Qt[kk * 128 + th * 32 + i8 * 8], qv);
#pragma unroll
            for (int q = 0; q < 8; ++q) acc[i8 * 8 + q] += qv[q] * cv; } }
#pragma unroll
    for (int i = 0; i < 32; ++i) acc[i] *= isc[th * 32 + i];
    __syncthreads();
#pragma unroll
    for (int i = 0; i < 4; ++i) { const int e8 = tid + 512 * i, s = e8 >> 4, v8 = e8 & 15;
        *(LAS3 u32x4*)(KV + (s * 128 + v8 * 8) * 2) = *(const u32x4*)(Vb + (size_t)(r0 + s) * 2048 + h * 256 + hv * 128 + v8 * 8); }
    __syncthreads();
#pragma unroll 1
    for (int s = 0; s < 128; ++s) { const float v = bf2f(Ch[s * 128 + vv]);
#pragma unroll
        for (int i4 = 0; i4 < 8; ++i4) { const f32x4 p4 = *(const LAS3 f32x4*)&Pt[s * 128 + th * 32 + i4 * 4];
            acc[i4 * 4 + 0] += p4[0] * v; acc[i4 * 4 + 1] += p4[1] * v; acc[i4 * 4 + 2] += p4[2] * v; acc[i4 * 4 + 3] += p4[3] * v; } }
}
__device__ __forceinline__ void phase_o4(LAS3 unsigned char* lds, const Ptrs& P, int j, int G, int bid, int tid_in) {
    LAS3 float* Pt = (LAS3 float*)lds;
    LAS3 bf16_t* Qt = (LAS3 bf16_t*)(lds + 65536);
    LAS3 unsigned char* KV = lds + 98304;
    LAS3 float* bb = (LAS3 float*)(lds + 131584); LAS3 float* cc = bb + 128; LAS3 float* MM = cc + 128; LAS3 float* isc = MM + 128; LAS3 float* den = isc + 128; LAS3 float* nst = den + 128; LAS3 float* red = nst + 128;
    const bf16_t* Qb = (const bf16_t*)(P.ws + WS_R1); const bf16_t* Kb = (const bf16_t*)(P.ws + WS_R2); bf16_t* Vb = (bf16_t*)(P.ws + WS_R3);
    const bf16_t* UC = (const bf16_t*)(P.ws + WS_R4); const float* NS = (const float*)(P.ws + WS_NS); const float* MS = (const float*)(P.ws + WS_MS); const float* GB = (const float*)(P.ws + WS_GB);
    const float* mhg = INP(16) + (size_t)j * 8 * 256;
    for (int unit = bid; unit < NUNIT_O; unit += G) {
        int tid = tid_in; asm volatile("" : "+v"(tid));
        const int lane = tid & 63, wid = tid >> 6;
        const int chain = unit >> 7, n = unit & 127, b = chain >> 3, h = chain & 7, r0 = b * SEQ + n * 128;
        const float mst = MS[chain * 128 + n];
        if (tid < 128) { const float bv = GB[((size_t)(r0 + tid) * 8 + h) * 2], iv = GB[((size_t)(r0 + tid) * 8 + h) * 2 + 1]; bb[tid] = bv; cc[tid] = iv - bv; nst[tid] = NS[(size_t)unit * 128 + tid]; }
#pragma unroll
        for (int i = 0; i < 4; ++i) { const int e8 = tid + 512 * i, t = e8 >> 4, k8 = e8 & 15;
            const u32x4 qw = *(const u32x4*)(Qb + (size_t)(r0 + t) * 1024 + h * 128 + k8 * 8);
            Qt[(k8 * 8 + 0) * 128 + t] = (bf16_t)(qw.x & 0xffffu); Qt[(k8 * 8 + 1) * 128 + t] = (bf16_t)(qw.x >> 16); Qt[(k8 * 8 + 2) * 128 + t] = (bf16_t)(qw.y & 0xffffu); Qt[(k8 * 8 + 3) * 128 + t] = (bf16_t)(qw.y >> 16);
            Qt[(k8 * 8 + 4) * 128 + t] = (bf16_t)(qw.z & 0xffffu); Qt[(k8 * 8 + 5) * 128 + t] = (bf16_t)(qw.z >> 16); Qt[(k8 * 8 + 6) * 128 + t] = (bf16_t)(qw.w & 0xffffu); Qt[(k8 * 8 + 7) * 128 + t] = (bf16_t)(qw.w >> 16);
            const u32x4 kw = *(const u32x4*)(Kb + (size_t)(r0 + t) * 1024 + h * 128 + k8 * 8);
            LAS3 unsigned* kd = (LAS3 unsigned*)(KV + t * 260 + k8 * 16); kd[0] = kw.x; kd[1] = kw.y; kd[2] = kw.z; kd[3] = kw.w; }
        __syncthreads();
        if (tid < 128) { float mx = mst;
#pragma unroll 1
            for (int s = 0; s <= tid; ++s) mx = fmaxf(mx, cc[s]);
            MM[tid] = mx; isc[tid] = __expf(mst - mx); }
        {
            const int s_ = tid & 127, tq = tid >> 7;
            float acc[32];
#pragma unroll
            for (int i = 0; i < 32; ++i) acc[i] = 0.f;
            const LAS3 bf16_t* Kp = (const LAS3 bf16_t*)KV;
#pragma unroll 1
            for (int kk = 0; kk < 128; ++kk) { const float kval = bf2f(Kp[s_ * 130 + kk]);
#pragma unroll
                for (int i8 = 0; i8 < 4; ++i8) { float qv[8]; unpack8(*(const LAS3 u32x4*)&Qt[kk * 128 + tq * 32 + i8 * 8], qv);
#pragma unroll
                    for (int q = 0; q < 8; ++q) acc[i8 * 8 + q] += qv[q] * kval; } }
            __syncthreads();
            const float cs = cc[s_];
#pragma unroll
            for (int i4 = 0; i4 < 8; ++i4) { f32x4 pv;
#pragma unroll
                for (int q = 0; q < 4; ++q) { const int t = tq * 32 + i4 * 4 + q; pv[q] = (s_ <= t) ? __expf(cs - MM[t]) * acc[i4 * 4 + q] : 0.f; }
                *(LAS3 f32x4*)&Pt[s_ * 128 + tq * 32 + i4 * 4] = pv; }
        }
        __syncthreads();
        if (tid < 128) { float d = 0.f, qn = 0.f;
#pragma unroll 4
            for (int s = 0; s < 128; ++s) d += Pt[s * 128 + tid];
#pragma unroll 4
            for (int kk = 0; kk < 128; ++kk) qn += bf2f(Qt[kk * 128 + tid]) * nst[kk];
            den[tid] = isc[tid] * qn + d; }
        const int vv = tid & 127, th = tid >> 7;
        float o[2][32];
        o4_half<0>(o[0], KV, Qt, Pt, isc, UC, Vb, unit, r0, h, tid, vv, th);
        o4_half<1>(o[1], KV, Qt, Pt, isc, UC, Vb, unit, r0, h, tid, vv, th);
        __syncthreads();
#pragma unroll
        for (int i = 0; i < 32; ++i) { const int t = th * 32 + i; const float dn = fmaxf(fabsf(den[t]), __expf(-(bb[t] + MM[t]))), inv = 1.0f / dn;
            o[0][i] *= inv; o[1][i] *= inv; float sq = o[0][i] * o[0][i] + o[1][i] * o[1][i]; sq = wave_sum(sq); if (lane == 0) red[t * 2 + (wid & 1)] = sq;  asm volatile("" ::: "memory"); }
        __syncthreads();
        const float g0 = mhg[h * 256 + vv], g1 = mhg[h * 256 + 128 + vv];
#pragma unroll
        for (int i = 0; i < 32; ++i) { const int t = th * 32 + i; const float r = rsqrtf((red[t * 2] + red[t * 2 + 1]) * (1.0f / 256.0f) + EPS);
            Vb[(size_t)(r0 + t) * 2048 + h * 256 + vv] = f2bf(o[0][i] * r * g0); Vb[(size_t)(r0 + t) * 2048 + h * 256 + 128 + vv] = f2bf(o[1][i] * r * g1);  asm volatile("" ::: "memory"); }
        __syncthreads();
    }
}

constexpr int NPHASE = 1 + 8 * DEPTH;
__host__ __device__ constexpr bool phase_exists(int ph) { return ph == 0 || !((((ph - 1) >> 3) & 1) == 0 && (((ph - 1) & 7) == 2 || ((ph - 1) & 7) == 3)); }
struct Args { const float* in[18]; float* out; unsigned char* ws; int ph_lo, ph_hi; };

__global__ void __launch_bounds__(512, 2) fwd(Args args) {
    extern __shared__ __attribute__((aligned(16))) unsigned char lds_raw[];
    LAS3 unsigned char* lds = (LAS3 unsigned char*)lds_raw;
    const int tid0 = threadIdx.x, bid = blockIdx.x, G = gridDim.x;
    Ptrs P; P.out = args.out; P.ws = args.ws;
    const int lo0 = args.ph_lo, hi0 = args.ph_hi;
    const bool multi = (hi0 - lo0) > 1;
    XcdBarrier bar; bar.bar = (unsigned*)(P.ws + WS_CTL); bar.x = 0; bar.st = nullptr;
    if (multi) {
        if (tid0 < 4) ((LAS3 unsigned*)(lds + LDS_BAR_OFF))[tid0] = 0u;
        __syncthreads();
        bar = xcd_barrier_post((unsigned*)(P.ws + WS_CTL), (volatile LAS unsigned*)(lds + LDS_BAR_OFF));
    }
#ifndef PHMASK
#define PHMASK 0xFFFF
#endif
#define PHM(k) (((PHMASK) >> (k)) & 1)
#define RUN(ph) (lo <= (ph) && (ph) < hi)
#define SEAM(ph) do { if ((ph) + 1 < hi) xcd_barrier(bar); } while (0)
    bf16_t* const HBA = (bf16_t*)(P.ws + WS_HBA); bf16_t* const WIN = (bf16_t*)(P.ws + WS_WIN); bf16_t* const WOUT = (bf16_t*)(P.ws + WS_WOUT);
    bf16_t* const R1 = (bf16_t*)(P.ws + WS_R1); bf16_t* const R2 = (bf16_t*)(P.ws + WS_R2); bf16_t* const R3 = (bf16_t*)(P.ws + WS_R3); bf16_t* const R4 = (bf16_t*)(P.ws + WS_R4);
    float* const SSQA = (float*)(P.ws + WS_SSQA); float* const SSQY = (float*)(P.ws + WS_SSQY);

    { const int tid = tid0, lo = lo0, hi = hi0; if (PHM(0) && RUN(0)) { phase_prologue(P, G, bid, tid); SEAM(0); } }
#pragma unroll 1
    for (int L = 0; L < DEPTH; ++L) {
        int tid = tid0, lo = lo0, hi = hi0; asm volatile("" : "+v"(tid), "+s"(lo), "+s"(hi));
        const int pb = 1 + 8 * L, j = L >> 1;
        if ((L & 1) == 0) {
            if (PHM(1) && RUN(pb + 0)) { pg8::Gemm g{HBA, WIN, M, N1A_E, DM}; pg8::StaticOrder S; S.init(M, N1A_E, G, bid);
                pg8::EpiE1a E{SSQA, R1, R2}; pg8::gemm_phase<pg8::EpiE1a, pg8::StaticOrder>(lds, g, S, E, nullptr); SEAM(pb + 0); }
            if (PHM(2) && RUN(pb + 1)) { phase_gm(lds, P, j, G, bid, tid); SEAM(pb + 1); }
            if (PHM(3) && RUN(pb + 4)) { pg8::Gemm g{HBA, WIN + (size_t)N1A_E * DM, M, N1B_E, DM}; pg8::StaticOrder S; S.init(M, N1B_E, G, bid);
                pg8::EpiE1b E{SSQA, R1, R3, INP(8) + (size_t)j * 3 * 1024, R4}; pg8::gemm_phase<pg8::EpiE1b, pg8::StaticOrder>(lds, g, S, E, nullptr); SEAM(pb + 4); }
        } else {
            if (PHM(4) && RUN(pb + 0)) { pg8::Gemm g{HBA, WIN, M, N1A_O, DM}; pg8::StaticOrder S; S.init(M, N1A_O, G, bid);
                pg8::EpiO1a E{SSQA, R1, R2, R3, (float*)(P.ws + WS_GATE)}; pg8::gemm_phase<pg8::EpiO1a, pg8::StaticOrder>(lds, g, S, E, nullptr); SEAM(pb + 0); }
            if (PHM(5) && RUN(pb + 1)) { phase_o2(lds, P, j, G, bid, tid); SEAM(pb + 1); }
            if (PHM(6) && RUN(pb + 2)) { phase_o3(lds, P, G, bid, tid); SEAM(pb + 2); }
            if (PHM(7) && RUN(pb + 3)) { phase_o4(lds, P, j, G, bid, tid); SEAM(pb + 3); }
            if (PHM(8) && RUN(pb + 4)) { pg8::Gemm g{HBA, WIN + (size_t)N1A_O * DM, M, N1B_O, DM}; pg8::StaticOrder S; S.init(M, N1B_O, G, bid);
                pg8::EpiO1b E{SSQA, R3, R4}; pg8::gemm_phase<pg8::EpiO1b, pg8::StaticOrder>(lds, g, S, E, nullptr); SEAM(pb + 4); }
        }
        if (PHM(9) && RUN(pb + 5)) { pg8::Gemm g{R4, WOUT, M, DM, 2048}; pg8::StaticOrder S; S.init(M, DM, G, bid);
            pg8::EpiOut E{R1, SSQY}; pg8::gemm_phase<pg8::EpiOut, pg8::StaticOrder>(lds, g, S, E, nullptr); SEAM(pb + 5); }
        if (PHM(10) && RUN(pb + 6)) { phase_p4(P, L, G, bid, tid); SEAM(pb + 6); }
        if (PHM(11) && RUN(pb + 7)) {
            { pg8::Gemm g{R3 + (size_t)32 * MiB, (bf16_t*)(P.ws + WS_WP) + (size_t)L * DM * PLE, M, DM, PLE}; pg8::StaticOrder S; S.init(M, DM, G, bid);
              pg8::EpiPw E{R2}; pg8::gemm_phase<pg8::EpiPw, pg8::StaticOrder>(lds, g, S, E, nullptr); }
            __syncthreads();
            { pg8::Gemm g{R3, (bf16_t*)(P.ws + WS_WG) + (size_t)L * DM * DM, M, DM, DM}; pg8::StaticOrder S; S.init(M, DM, G, bid);
              pg8::EpiGate E{(const float*)(P.ws + WS_RSTD1), R2, P.out, HBA, SSQA}; pg8::gemm_phase<pg8::EpiGate, pg8::StaticOrder>(lds, g, S, E, nullptr); }
            SEAM(pb + 7);
        }
    }
#undef RUN
#undef SEAM
}

#ifndef ONE_LAUNCH
#define ONE_LAUNCH 1
#endif
extern "C" void kernel_launch(void* const* d_in, const int* in_sizes, int n_in, void* d_out, int out_size, void* d_ws, size_t ws_size, hipStream_t stream) {
    static int grid = 0;
    if (grid == 0) {
        if (n_in != 18 || out_size != M * DM || ws_size < WS_END) { fprintf(stderr, "kernel_launch: unexpected shapes (n_in %d out %d ws %zu)\n", n_in, out_size, ws_size); grid = -1; return; }
        int dev = 0, cus = 0, per_cu = 0;
        if (hipGetDevice(&dev) != hipSuccess || hipDeviceGetAttribute(&cus, hipDeviceAttributeMultiprocessorCount, dev) != hipSuccess) { grid = -1; return; }
        if (hipFuncSetAttribute((const void*)fwd, hipFuncAttributeMaxDynamicSharedMemorySize, LDS_BYTES) != hipSuccess) { fprintf(stderr, "kernel_launch: hipFuncSetAttribute failed\n"); grid = -1; return; }
        if (hipOccupancyMaxActiveBlocksPerMultiprocessor(&per_cu, (const void*)fwd, 512, LDS_BYTES) != hipSuccess || per_cu < 1) { fprintf(stderr, "kernel_launch: occupancy query says %d\n", per_cu); }
        (void)hipGetLastError();
        grid = cus;
    }
    if (grid < 0) return;
    (void)hipMemsetAsync((char*)d_ws + WS_CTL, 0, CTL_BYTES, stream);
    Args a{};
    for (int i = 0; i < 18; ++i) a.in[i] = (const float*)d_in[i];
    a.out = (float*)d_out; a.ws = (unsigned char*)d_ws;
#if ONE_LAUNCH
    a.ph_lo = 0; a.ph_hi = NPHASE;
    hipLaunchKernelGGL(fwd, dim3(grid), dim3(512), LDS_BYTES, stream, a);
#else
    for (int ph = 0; ph < NPHASE; ++ph) { if (!phase_exists(ph)) continue; a.ph_lo = ph; a.ph_hi = ph + 1; hipLaunchKernelGGL(fwd, dim3(grid), dim3(512), LDS_BYTES, stream, a); }
#endif
}
```

```cpp
#include <hip/hip_runtime.h>
#include <cstdio>
#include <cstdint>
namespace pg8 {
#define PG8_LAS __attribute__((address_space(3)))
typedef unsigned short bf16_t;
typedef short bf16x8 __attribute__((ext_vector_type(8)));
typedef float f32x4 __attribute__((ext_vector_type(4)));
typedef unsigned u32x4 __attribute__((ext_vector_type(4)));
constexpr int BM = 256, BK = 64, HALF = 128, HTB = HALF * BK * 2  , STAGE_BYTES = 8 * HTB, NXCD = 8, WGM = 8;

__host__ __device__ __forceinline__ int lds_byte(int r, int c) { const int st = (r >> 4) * 2 + (c >> 5), rr = r & 15, cc = c & 31, ob = rr * 64 + cc * 2; return st * 1024 + (ob ^ (((ob >> 9) & 1) << 5)); }
__host__ __device__ __forceinline__ void stage_rc(int b, int& R, int& C) { const int st = b / 1024, sb = b % 1024, swz = sb ^ (((sb >> 9) & 1) << 5); R = (st >> 1) * 16 + swz / 64; C = (st & 1) * 32 + (swz % 64) / 2; }
__host__ __device__ __forceinline__ int perm32(int rho) { const int n = rho >> 4, i = rho & 15; return 8 * (i >> 2) + 4 * n + (i & 3); }

struct Unit { int pm, pn; };
struct Gemm { const bf16_t* A; const bf16_t* Bt; int M, N, K; };

struct StaticOrder {
    int nM, nN, nwg, G, c;
    __host__ __device__ void init(int M, int N, int G_, int c_) { nM = M / BM; nN = N / BM; nwg = nM * nN; G = G_; c = c_; }
    __host__ __device__ bool next(int i, Unit& u) const {
        const long L = (long)i * G + c; if (L >= nwg) return false;
        int wgid = (int)L; { const int q = nwg / NXCD, r = nwg % NXCD, xcd = wgid % NXCD, off = wgid / NXCD; wgid = (xcd < r ? xcd * (q + 1) : r * (q + 1) + (xcd - r) * q) + off; }
        const int nig = WGM * nN, gid = wgid / nig, fm = gid * WGM, gsz = (nM - fm) < WGM ? (nM - fm) : WGM;
        u.pm = fm + ((wgid % nig) % gsz); u.pn = (wgid % nig) / gsz; return true;
    }
    __device__ __forceinline__ void a_ready(const Unit&) const {}
    __device__ __forceinline__ void done(const Unit&) const {}
};
__device__ __forceinline__ unsigned cvt_pk_bf16(float lo, float hi) { unsigned r; asm volatile("v_cvt_pk_bf16_f32 %0, %1, %2" : "=v"(r) : "v"(lo), "v"(hi)); return r; }
typedef float f32x2 __attribute__((ext_vector_type(2)));
template <class Epi, class Sched, bool STAMP = false>
__device__ __forceinline__ void gemm_phase(PG8_LAS unsigned char* lds, const Gemm g, const Sched& S, const Epi& E, unsigned long long* stamps) {
    int tid_l_ = threadIdx.x; asm volatile("" : "+v"(tid_l_));
    const int tid = tid_l_, wid = __builtin_amdgcn_readfirstlane(tid >> 6), lane = tid & 63, wr = wid >> 2, wc = wid & 3, fr = lane & 15, fq = lane >> 4;
    const int K = g.K, nt = K / BK;
    int ts_lo = 0, ts_hi = 0, nts = 0; const unsigned long long rt_entry = STAMP ? (unsigned long long)wall_clock64() : 0ull;
#define PG8_STAMP() do { if (STAMP && wid == 0 && nts < 64) { const unsigned long long _c = (unsigned long long)clock64(); \
        ts_lo = (lane == nts) ? (int)(unsigned)_c : ts_lo; ts_hi = (lane == nts) ? (int)(unsigned)(_c >> 32) : ts_hi; ++nts; } } while (0)
    PG8_STAMP();
    unsigned voffA[2], voffB[2];
#pragma unroll
    for (int i = 0; i < 2; ++i) { int R, C; stage_rc(tid * 16 + i * 8192, R, C); const int Rb = Epi::PERM ? ((R & ~31) + perm32(R & 31)) : R;
        voffA[i] = (unsigned)(R * K + C) * 2u; voffB[i] = (unsigned)(Rb * K + C) * 2u; }
    const size_t kstep = (size_t)(BK * 2);
    const size_t hstep = (size_t)HALF * K * 2;
    const size_t tstep = 2 * hstep;
    const unsigned ldsw = (unsigned)wid * 1024u;
    const int aoff = lds_byte(wr * 64 + fr, fq * 8), boff = lds_byte(wc * 32 + fr, fq * 8);
#define PG8_SA(b, h) (((b) * 2 + (h)) * HTB)
#define PG8_SB(b, h) ((4 + (b) * 2 + (h)) * HTB)
#define PG8_STAGE(bufoff, gbase, voff) do { _Pragma("unroll") for (int _i = 0; _i < 2; ++_i) \
        __builtin_amdgcn_global_load_lds((const unsigned*)((const char*)(gbase) + (voff)[_i]), (PG8_LAS unsigned*)(lds + (bufoff) + ldsw + _i * 8192), 16, 0, 0); } while (0)
#define PG8_LDA(dst, b, h) do { _Pragma("unroll") for (int m = 0; m < 4; ++m) _Pragma("unroll") for (int k = 0; k < 2; ++k) dst[m][k] = *(const PG8_LAS bf16x8*)(lds + PG8_SA(b, h) + aoff + m * 2048 + k * 1024); } while (0)
#define PG8_LDB(dst, b, h) do { _Pragma("unroll") for (int n = 0; n < 2; ++n) _Pragma("unroll") for (int k = 0; k < 2; ++k) dst[n][k] = *(const PG8_LAS bf16x8*)(lds + PG8_SB(b, h) + boff + n * 2048 + k * 1024); } while (0)
#define PG8_MMA(ai, bj, At, Bt) do { __builtin_amdgcn_s_setprio(1); _Pragma("unroll") for (int m = 0; m < 4; ++m) _Pragma("unroll") for (int n = 0; n < 2; ++n) _Pragma("unroll") for (int k = 0; k < 2; ++k) \
        acc[ai][bj][m][n] = __builtin_amdgcn_mfma_f32_16x16x32_bf16(Bt[n][k], At[m][k], acc[ai][bj][m][n], 0, 0, 0); __builtin_amdgcn_s_setprio(0); } while (0)
#define PG8_WAIT_V(n) asm volatile("s_waitcnt vmcnt(" #n ")" ::: "memory")
#define PG8_WAIT_L(n) asm volatile("s_waitcnt lgkmcnt(" #n ")" ::: "memory")
#define PG8_BAR __builtin_amdgcn_s_barrier()
#define PG8_SCHED __builtin_amdgcn_sched_barrier(0)
    Unit cur, nxt; int ui = 0;
    if (!S.next(0, cur)) return;
    f32x4 acc[2][2][4][2];
#pragma unroll
    for (int a = 0; a < 2; ++a)
#pragma unroll
        for (int b = 0; b < 2; ++b)
#pragma unroll
            for (int m = 0; m < 4; ++m)
#pragma unroll
                for (int n = 0; n < 2; ++n) acc[a][b][m][n] = (f32x4){0.f, 0.f, 0.f, 0.f};
    bf16x8 At[4][2], B0[2][2], B1[2][2];
    const char* cA = (const char*)g.A + (size_t)cur.pm * tstep; const char* cB = (const char*)g.Bt + (size_t)cur.pn * tstep;
    S.a_ready(cur);
    PG8_STAGE(PG8_SB(0, 0), cB, voffB); PG8_STAGE(PG8_SA(0, 0), cA, voffA); PG8_STAGE(PG8_SB(0, 1), cB + hstep, voffB); PG8_STAGE(PG8_SA(0, 1), cA + hstep, voffA);
    if (wr == 1) PG8_BAR;
    PG8_WAIT_V(4); PG8_BAR;
    PG8_STAGE(PG8_SB(1, 0), cB + kstep, voffB); PG8_STAGE(PG8_SA(1, 0), cA + kstep, voffA); PG8_STAGE(PG8_SB(1, 1), cB + hstep + kstep, voffB);
    PG8_WAIT_V(6); PG8_BAR;
    PG8_STAMP();
    for (;;) {
        const bool has_next = S.next(ui + 1, nxt);
        const char* nA = has_next ? (const char*)g.A + (size_t)nxt.pm * tstep : cA; const char* nB = has_next ? (const char*)g.Bt + (size_t)nxt.pn * tstep : cB;
        for (int t = 0; t < nt; t += 2) {
            const bool last = (t == nt - 2);
            const char* a1 = cA + (size_t)(t + 1) * kstep;
            const char* a2 = last ? nA : cA + (size_t)(t + 2) * kstep; const char* b2 = last ? nB : cB + (size_t)(t + 2) * kstep;
            const char* a3 = a2 + kstep; const char* b3 = b2 + kstep;
            if (last && has_next) S.a_ready(nxt);
            PG8_LDB(B0, 0, 0); PG8_SCHED; PG8_LDA(At, 0, 0); PG8_STAGE(PG8_SA(1, 1), a1 + hstep, voffA);
            PG8_WAIT_L(8); PG8_BAR; PG8_WAIT_L(0); PG8_MMA(0, 0, At, B0); PG8_BAR; PG8_SCHED;
            PG8_LDB(B1, 0, 1); PG8_STAGE(PG8_SB(0, 0), b2, voffB);
            PG8_BAR; PG8_WAIT_L(0); PG8_MMA(0, 1, At, B1); PG8_BAR;
            PG8_LDA(At, 0, 1); PG8_STAGE(PG8_SA(0, 0), a2, voffA);
            PG8_BAR; PG8_WAIT_L(0); PG8_MMA(1, 0, At, B0); PG8_BAR; PG8_SCHED;
            PG8_STAGE(PG8_SB(0, 1), b2 + hstep, voffB);
            PG8_WAIT_V(6); PG8_BAR; PG8_MMA(1, 1, At, B1); PG8_BAR;
            PG8_LDB(B0, 1, 0); PG8_SCHED; PG8_LDA(At, 1, 0); PG8_STAGE(PG8_SA(0, 1), a2 + hstep, voffA);
            PG8_WAIT_L(8); PG8_BAR; PG8_WAIT_L(0); PG8_MMA(0, 0, At, B0); PG8_BAR; PG8_SCHED;
            PG8_LDB(B1, 1, 1); PG8_STAGE(PG8_SB(1, 0), b3, voffB);
            PG8_BAR; PG8_WAIT_L(0); PG8_MMA(0, 1, At, B1); PG8_BAR;
            PG8_LDA(At, 1, 1); PG8_STAGE(PG8_SA(1, 0), a3, voffA);
            PG8_BAR; PG8_WAIT_L(0); PG8_MMA(1, 0, At, B0); PG8_BAR; PG8_SCHED;
            PG8_STAGE(PG8_SB(1, 1), b3 + hstep, voffB);
            PG8_WAIT_V(6); PG8_BAR; PG8_MMA(1, 1, At, B1); PG8_BAR;
        }
        PG8_STAMP();
        if constexpr (!Epi::AFTER_DRAIN) { E(acc, cur, wr, wc, fr, fq); S.done(cur); }
        PG8_STAMP();
        if (!has_next) break;
#pragma unroll
        for (int a = 0; a < 2; ++a)
#pragma unroll
            for (int b = 0; b < 2; ++b)
#pragma unroll
                for (int m = 0; m < 4; ++m)
#pragma unroll
                    for (int n = 0; n < 2; ++n) acc[a][b][m][n] = (f32x4){0.f, 0.f, 0.f, 0.f};
        cur = nxt; cA = nA; cB = nB; ++ui;
    }
    PG8_WAIT_V(0);
    if (wr == 0) PG8_BAR;
    PG8_BAR;
    if constexpr (Epi::AFTER_DRAIN) { E.fused(acc, cur, wr, wc, fr, fq, lds, wid, lane); S.done(cur); }
    PG8_STAMP();
    if (STAMP && wid == 0) { stamps[lane] = lane < nts ? (((unsigned long long)(unsigned)ts_hi << 32) | (unsigned)ts_lo) : 0ull;
        if (lane == 62) stamps[62] = rt_entry; if (lane == 63) stamps[63] = (unsigned long long)wall_clock64(); }
#undef PG8_STAMP
#undef PG8_SA
#undef PG8_SB
#undef PG8_STAGE
#undef PG8_LDA
#undef PG8_LDB
#undef PG8_MMA
#undef PG8_WAIT_V
#undef PG8_WAIT_L
#undef PG8_BAR
#undef PG8_SCHED
}
}
#define XB_TMO      128
#define XB_XCNT(j)  (256  + 64 * (j))
#define XB_XSUB(j)  (1280 + 64 * (j))
#define XB_XGEN(j)  (2304 + 64 * (j))
#define XB_TOP      3328
#define XB_TOPGEN   3392
#define XCD_BAR_WORDS 3456
#define XB_SPIN_CAP (1u << 18)
#define LAS __attribute__((address_space(3)))

__device__ __forceinline__ unsigned xb_ld(unsigned* p)              { return __hip_atomic_load(p, __ATOMIC_RELAXED, __HIP_MEMORY_SCOPE_AGENT); }
__device__ __forceinline__ unsigned xb_add(unsigned* p, unsigned v) { return __hip_atomic_fetch_add(p, v, __ATOMIC_RELAXED, __HIP_MEMORY_SCOPE_AGENT); }
__device__ __forceinline__ unsigned xb_xcc_id() { return (unsigned)__builtin_amdgcn_s_getreg((3 << 11) | 20) & 0xFu; }
#define XB_SPIN(cond, bar) do { unsigned _sp = 0; while (cond) { __builtin_amdgcn_s_sleep(1); \
    if ((++_sp & 255u) == 0u) { if (xb_ld(&(bar)[XB_TMO])) break; if (_sp > XB_SPIN_CAP) { atomicAdd(&(bar)[XB_TMO], 1u); break; } } } } while (0)

struct XcdBarrier {
    unsigned* bar; unsigned x;
    volatile LAS unsigned* st;
};

__device__ __forceinline__ XcdBarrier xcd_barrier_post(unsigned* bar, volatile LAS unsigned* st) {
    XcdBarrier b; b.bar = bar; b.x = xb_xcc_id(); b.st = st;
    if (threadIdx.x == 0) (void)xb_add(&bar[XB_XCNT(b.x)], 1u);
    return b;
}
__device__ __forceinline__ void xcd_barrier_complete(unsigned* bar, unsigned x, unsigned& nloc, unsigned& nx) {
    const unsigned G = gridDim.x * gridDim.y * gridDim.z;
    unsigned sum, cnt, mine, sp = 0u;
    for (;;) {
        sum = 0u; cnt = 0u; mine = 0u;
#pragma unroll
        for (unsigned j = 0; j < 16; ++j) { const unsigned c = xb_ld(&bar[XB_XCNT(j)]); sum += c; cnt += (c > 0u) ? 1u : 0u; mine = (j == x) ? c : mine; }
        if (sum == G) break;
        __builtin_amdgcn_s_sleep(1);
        if ((++sp & 255u) == 0u) { if (xb_ld(&bar[XB_TMO])) break; if (sp > XB_SPIN_CAP) { atomicAdd(&bar[XB_TMO], 1u); break; } }
    }
    nloc = mine > 0u ? mine : 1u; nx = cnt > 0u ? cnt : 1u;
}

__device__ __forceinline__ void xcd_barrier(const XcdBarrier& b) {
    asm volatile("s_waitcnt vmcnt(0)" ::: "memory");
    __syncthreads();
    if (threadIdx.x == 0) {
        unsigned* bar = b.bar;
        __builtin_amdgcn_s_waitcnt(0);
        unsigned nloc = b.st[0], nx = b.st[1];
        if (nloc == 0u) { xcd_barrier_complete(bar, b.x, nloc, nx); b.st[0] = nloc; b.st[1] = nx; }
        const unsigned old = xb_add(&bar[XB_XSUB(b.x)], 1u);
        const unsigned gen = old / nloc;
        if (old + 1u == (gen + 1u) * nloc) {
            __builtin_amdgcn_fence(__ATOMIC_RELEASE, "agent");
            asm volatile("s_waitcnt vmcnt(0)" ::: "memory");
            const unsigned og = xb_add(&bar[XB_TOP], 1u);
            const unsigned tg = og / nx;
            if (og + 1u == (tg + 1u) * nx) xb_add(&bar[XB_TOPGEN], 1u);
            else XB_SPIN(xb_ld(&bar[XB_TOPGEN]) == tg, bar);
            __builtin_amdgcn_fence(__ATOMIC_ACQUIRE, "agent");
            xb_add(&bar[XB_XGEN(b.x)], 1u);
            asm volatile("s_waitcnt vmcnt(0)" ::: "memory");
        } else {
            XB_SPIN(xb_ld(&bar[XB_XGEN(b.x)]) == gen, bar);
            __builtin_amdgcn_fence(__ATOMIC_ACQUIRE, "agent");
            asm volatile("s_waitcnt vmcnt(0)" ::: "memory");
        }
    }
    __syncthreads();
}


typedef unsigned short bf16_t;
typedef float f32x4 __attribute__((ext_vector_type(4)));
typedef unsigned u32x4 __attribute__((ext_vector_type(4)));
typedef unsigned u32x2 __attribute__((ext_vector_type(2)));
constexpr int DM = 1024, NBATCH = 2, SEQ = 16384, M = NBATCH * SEQ, DEPTH = 4, PLE = 256;
constexpr float EPS = 1e-6f;
constexpr int EVEN_IN = 7168, ODD_IN = 8208;
constexpr int N1A_E = 3072, N1B_E = 4096, N1A_O = 4352, N1B_O = 4096;
constexpr int NUNIT_O = 2048;
constexpr int LDS_BYTES = 147456;
constexpr int LDS_BAR_OFF = LDS_BYTES - 16;

constexpr size_t MiB = 1u << 20;
constexpr size_t WS_CTL = 0, CTL_BYTES = 64 * 1024;
constexpr size_t WS_SSQA = 1 * MiB, WS_SSQY = 3 * MiB, WS_RSTD1 = 5 * MiB, WS_GATE = 6 * MiB, WS_GB = 8 * MiB, WS_CS = 10 * MiB, WS_MS = 10 * MiB + 65536, WS_NS = 11 * MiB;
constexpr size_t WS_WG = 12 * MiB, WS_WP = 20 * MiB, WS_WIN = 22 * MiB, WS_WOUT = 39 * MiB;
constexpr size_t WS_HBA = 44 * MiB, WS_R1 = 108 * MiB, WS_R2 = 172 * MiB, WS_R3 = 236 * MiB, WS_R4 = 364 * MiB, WS_END = 492 * MiB;

__device__ __forceinline__ float bf2f(bf16_t b) { return __uint_as_float(((unsigned)b) << 16); }
__device__ __forceinline__ bf16_t f2bf(float f) { unsigned u = __float_as_uint(f); u += 0x7FFFu + ((u >> 16) & 1u); return (bf16_t)(u >> 16); }
__device__ __forceinline__ unsigned pk2(float lo, float hi) { return pg8::cvt_pk_bf16(lo, hi); }
__device__ __forceinline__ void unpack8(const u32x4 w, float (&f)[8]) {
    f[0] = __uint_as_float(w.x << 16); f[1] = __uint_as_float(w.x & 0xffff0000u); f[2] = __uint_as_float(w.y << 16); f[3] = __uint_as_float(w.y & 0xffff0000u);
    f[4] = __uint_as_float(w.z << 16); f[5] = __uint_as_float(w.z & 0xffff0000u); f[6] = __uint_as_float(w.w << 16); f[7] = __uint_as_float(w.w & 0xffff0000u);
}
__device__ __forceinline__ u32x4 pack8(const float (&f)[8]) { u32x4 w; w.x = pk2(f[0], f[1]); w.y = pk2(f[2], f[3]); w.z = pk2(f[4], f[5]); w.w = pk2(f[6], f[7]); return w; }
__device__ __forceinline__ float sigmoidf_(float x) { return __builtin_amdgcn_rcpf(1.0f + __expf(-x)); }
__device__ __forceinline__ float siluf_(float x) { return x * sigmoidf_(x); }
__device__ __forceinline__ float logsigmoidf_(float x) { return fminf(x, 0.f) - log1pf(__expf(-fabsf(x))); }
__device__ __forceinline__ float wave_sum(float s) { s += __shfl_xor(s, 1); s += __shfl_xor(s, 2); s += __shfl_xor(s, 4); s += __shfl_xor(s, 8); s += __shfl_xor(s, 16); s += __shfl_xor(s, 32); return s; }
__device__ __forceinline__ float rstd16(const float* p) {
    const f32x4 a = *(const f32x4*)p, b = *(const f32x4*)(p + 4), c = *(const f32x4*)(p + 8), d = *(const f32x4*)(p + 12);
    const float s = ((a[0] + a[1]) + (a[2] + a[3])) + ((b[0] + b[1]) + (b[2] + b[3])) + ((c[0] + c[1]) + (c[2] + c[3])) + ((d[0] + d[1]) + (d[2] + d[3]));
    return rsqrtf(s * (1.0f / 1024.0f) + EPS);
}

namespace pg8 {
#define EPI_ROWS_BEGIN  _Pragma("unroll") for (int ai = 0; ai < 2; ++ai) _Pragma("unroll") for (int m = 0; m < 4; ++m) { const int row = rowb + ai * HALF + m * 16;
#define EPI_ROWS_END    asm volatile("" ::: "memory"); }
struct EpiE1a { static constexpr bool PERM = true, AFTER_DRAIN = false;
    const float* ssq; bf16_t* U; bf16_t* BV;
    __device__ __forceinline__ void operator()(const f32x4 (&acc)[2][2][4][2], const Unit& u, int wr, int wc, int fr, int fq) const {
        const int rowb = u.pm * BM + wr * 64 + fr, cw = wc * 32 + 8 * fq;
        EPI_ROWS_BEGIN
            const float rs = rstd16(ssq + (size_t)row * 16);
            if (u.pn < 8) {
                const f32x4 p0 = (acc[ai][0][m][0] * rs) * (acc[ai][1][m][0] * rs), p1 = (acc[ai][0][m][1] * rs) * (acc[ai][1][m][1] * rs);
                u32x4 w; w.x = cvt_pk_bf16(p0[0], p0[1]); w.y = cvt_pk_bf16(p0[2], p0[3]); w.z = cvt_pk_bf16(p1[0], p1[1]); w.w = cvt_pk_bf16(p1[2], p1[3]);
                *(u32x4*)(U + (size_t)row * 1024 + u.pn * 128 + cw) = w;
            } else {
#pragma unroll
                for (int bj = 0; bj < 2; ++bj) { const f32x4 v0 = acc[ai][bj][m][0] * rs, v1 = acc[ai][bj][m][1] * rs;
                    u32x4 w; w.x = cvt_pk_bf16(v0[0], v0[1]); w.y = cvt_pk_bf16(v0[2], v0[3]); w.z = cvt_pk_bf16(v1[0], v1[1]); w.w = cvt_pk_bf16(v1[2], v1[3]);
                    *(u32x4*)(BV + (size_t)row * 1024 + (u.pn - 8) * 256 + bj * HALF + cw) = w; }
            }
        EPI_ROWS_END
    }
};
struct EpiE1b { static constexpr bool PERM = true, AFTER_DRAIN = false;
    const float* ssq; const bf16_t* U; const bf16_t* S; const float* convw; bf16_t* MIX;
    __device__ __forceinline__ void operator()(const f32x4 (&acc)[2][2][4][2], const Unit& u, int wr, int wc, int fr, int fq) const {
        const int rowb = u.pm * BM + wr * 64 + fr, cw = wc * 32 + 8 * fq;
        if (u.pn < 8) {
            const int ch0 = u.pn * 128 + cw;
            float w0[8], w1[8], w2[8];
#pragma unroll
            for (int j = 0; j < 8; ++j) { w0[j] = convw[ch0 + j]; w1[j] = convw[1024 + ch0 + j]; w2[j] = convw[2048 + ch0 + j]; }
            EPI_ROWS_BEGIN
                const float rs = rstd16(ssq + (size_t)row * 16);
                const int ts = row & (SEQ - 1);
                const bf16_t* up = U + (size_t)row * 1024 + ch0;
                float u0[8], u1[8], u2[8];
                unpack8(*(const u32x4*)up, u2);
                if (ts >= 1) unpack8(*(const u32x4*)(up - 1024), u1); else {
#pragma unroll
                    for (int j = 0; j < 8; ++j) u1[j] = 0.f; }
                if (ts >= 2) unpack8(*(const u32x4*)(up - 2048), u0); else {
#pragma unroll
                    for (int j = 0; j < 8; ++j) u0[j] = 0.f; }
                float o[8];
#pragma unroll
                for (int j = 0; j < 8; ++j) { const float ab = acc[ai][0][m][j >> 2][j & 3] * rs, ag = acc[ai][1][m][j >> 2][j & 3] * rs;
                    o[j] = ab * siluf_(ag) * (w2[j] * u2[j] + w1[j] * u1[j] + w0[j] * u0[j]); }
                *(u32x4*)(MIX + (size_t)row * 2048 + ch0) = pack8(o);
            EPI_ROWS_END
        } else {
            const int ch0 = (u.pn - 8) * 128 + cw;
            EPI_ROWS_BEGIN
                const float rs = rstd16(ssq + (size_t)row * 16);
                float sv[8]; unpack8(*(const u32x4*)(S + (size_t)row * 1024 + ch0), sv);
                float o[8];
#pragma unroll
                for (int j = 0; j < 8; ++j) { const float bu = acc[ai][0][m][j >> 2][j & 3] * rs, bg = acc[ai][1][m][j >> 2][j & 3] * rs; o[j] = bu * siluf_(bg) * sv[j]; }
                *(u32x4*)(MIX + (size_t)row * 2048 + 1024 + ch0) = pack8(o);
            EPI_ROWS_END
        }
    }
};
struct EpiO1a { static constexpr bool PERM = true, AFTER_DRAIN = false;
    const float* ssq; bf16_t* Q; bf16_t* K; bf16_t* V; float* GATE;
    __device__ __forceinline__ void operator()(const f32x4 (&acc)[2][2][4][2], const Unit& u, int wr, int wc, int fr, int fq) const {
        const int rowb = u.pm * BM + wr * 64 + fr, cw = wc * 32 + 8 * fq;
        if (u.pn < 16) {
            bf16_t* base; int ld, c0;
            if (u.pn < 4) { base = Q; ld = 1024; c0 = u.pn * 256; } else if (u.pn < 8) { base = K; ld = 1024; c0 = (u.pn - 4) * 256; } else { base = V; ld = 2048; c0 = (u.pn - 8) * 256; }
            EPI_ROWS_BEGIN
                const float rs = rstd16(ssq + (size_t)row * 16);
#pragma unroll
                for (int bj = 0; bj < 2; ++bj) { const f32x4 v0 = acc[ai][bj][m][0] * rs, v1 = acc[ai][bj][m][1] * rs;
                    u32x4 w; w.x = cvt_pk_bf16(v0[0], v0[1]); w.y = cvt_pk_bf16(v0[2], v0[3]); w.z = cvt_pk_bf16(v1[0], v1[1]); w.w = cvt_pk_bf16(v1[2], v1[3]);
                    *(u32x4*)(base + (size_t)row * ld + c0 + bj * HALF + cw) = w; }
            EPI_ROWS_END
        } else if (wc == 0 && fq < 2) {
            EPI_ROWS_BEGIN
                const float rs = rstd16(ssq + (size_t)row * 16);
                *(f32x4*)(GATE + (size_t)row * 16 + 8 * fq) = acc[ai][0][m][0] * rs;
                *(f32x4*)(GATE + (size_t)row * 16 + 8 * fq + 4) = acc[ai][0][m][1] * rs;
            EPI_ROWS_END
        }
    }
};
struct EpiO1b { static constexpr bool PERM = true, AFTER_DRAIN = false;
    const float* ssq; const bf16_t* HC; bf16_t* MIX;
    __device__ __forceinline__ void operator()(const f32x4 (&acc)[2][2][4][2], const Unit& u, int wr, int wc, int fr, int fq) const {
        const int rowb = u.pm * BM + wr * 64 + fr, ch0 = u.pn * 128 + wc * 32 + 8 * fq;
        EPI_ROWS_BEGIN
            const float rs = rstd16(ssq + (size_t)row * 16);
            float hv[8]; unpack8(*(const u32x4*)(HC + (size_t)row * 2048 + ch0), hv);
            float o[8];
#pragma unroll
            for (int j = 0; j < 8; ++j) { const float oo = acc[ai][0][m][j >> 2][j & 3] * rs, zz = acc[ai][1][m][j >> 2][j & 3] * rs; o[j] = hv[j] * sigmoidf_(oo) * siluf_(zz); }
            *(u32x4*)(MIX + (size_t)row * 2048 + ch0) = pack8(o);
        EPI_ROWS_END
    }
};
struct EpiOut { static constexpr bool PERM = true, AFTER_DRAIN = false;
    bf16_t* Y; float* SSQ;
    __device__ __forceinline__ void operator()(const f32x4 (&acc)[2][2][4][2], const Unit& u, int wr, int wc, int fr, int fq) const {
        const int rowb = u.pm * BM + wr * 64 + fr, cw = wc * 32 + 8 * fq;
        EPI_ROWS_BEGIN
            float s = 0.f;
#pragma unroll
            for (int bj = 0; bj < 2; ++bj) { const f32x4 v0 = acc[ai][bj][m][0], v1 = acc[ai][bj][m][1];
                s += (v0[0] * v0[0] + v0[1] * v0[1]) + (v0[2] * v0[2] + v0[3] * v0[3]) + (v1[0] * v1[0] + v1[1] * v1[1]) + (v1[2] * v1[2] + v1[3] * v1[3]);
                u32x4 w; w.x = cvt_pk_bf16(v0[0], v0[1]); w.y = cvt_pk_bf16(v0[2], v0[3]); w.z = cvt_pk_bf16(v1[0], v1[1]); w.w = cvt_pk_bf16(v1[2], v1[3]);
                *(u32x4*)(Y + (size_t)row * 1024 + u.pn * 256 + bj * HALF + cw) = w; }
            s += __shfl_xor(s, 16); s += __shfl_xor(s, 32);
            if (fq == 0) SSQ[(size_t)row * 16 + u.pn * 4 + wc] = s;
        EPI_ROWS_END
    }
};
struct EpiPw { static constexpr bool PERM = true, AFTER_DRAIN = false;
    bf16_t* PW;
    __device__ __forceinline__ void operator()(const f32x4 (&acc)[2][2][4][2], const Unit& u, int wr, int wc, int fr, int fq) const {
        const int rowb = u.pm * BM + wr * 64 + fr, cw = wc * 32 + 8 * fq;
        EPI_ROWS_BEGIN
#pragma unroll
            for (int bj = 0; bj < 2; ++bj) { const f32x4 v0 = acc[ai][bj][m][0], v1 = acc[ai][bj][m][1];
                u32x4 w; w.x = cvt_pk_bf16(v0[0], v0[1]); w.y = cvt_pk_bf16(v0[2], v0[3]); w.z = cvt_pk_bf16(v1[0], v1[1]); w.w = cvt_pk_bf16(v1[2], v1[3]);
                *(u32x4*)(PW + (size_t)row * 1024 + u.pn * 256 + bj * HALF + cw) = w; }
        EPI_ROWS_END
    }
};
struct EpiGate { static constexpr bool PERM = true, AFTER_DRAIN = false;
    const float* RSTD1; const bf16_t* PW; float* H; bf16_t* HB; float* SSQ;
    __device__ __forceinline__ void operator()(const f32x4 (&acc)[2][2][4][2], const Unit& u, int wr, int wc, int fr, int fq) const {
        const int rowb = u.pm * BM + wr * 64 + fr, cw = wc * 32 + 8 * fq;
        EPI_ROWS_BEGIN
            const float rs = RSTD1[row]; float s = 0.f;
#pragma unroll
            for (int bj = 0; bj < 2; ++bj) { const size_t off = (size_t)row * 1024 + u.pn * 256 + bj * HALF + cw;
                float pw[8]; unpack8(*(const u32x4*)(PW + off), pw);
                const f32x4 h0 = *(const f32x4*)(H + off), h1 = *(const f32x4*)(H + off + 4);
                float o[8];
#pragma unroll
                for (int j = 0; j < 8; ++j) { const float g = sigmoidf_(acc[ai][bj][m][j >> 2][j & 3] * rs); o[j] = (j < 4 ? h0[j & 3] : h1[j & 3]) + g * pw[j]; s += o[j] * o[j]; }
                *(f32x4*)(H + off) = (f32x4){o[0], o[1], o[2], o[3]}; *(f32x4*)(H + off + 4) = (f32x4){o[4], o[5], o[6], o[7]};
                *(u32x4*)(HB + off) = pack8(o); }
            s += __shfl_xor(s, 16); s += __shfl_xor(s, 32);
            if (fq == 0) SSQ[(size_t)row * 16 + u.pn * 4 + wc] = s;
        EPI_ROWS_END
    }
};
}

struct MapE1a { __device__ __forceinline__ int operator()(int np, float& sc) const { sc = 1.f; const int t = np >> 8; if (t < 8) { const int bj = (np >> 7) & 1, c = np & 127; return (bj ? 2048 : 1024) + t * 128 + c; } return 5120 + (np - 2048); } };
struct MapE1b { __device__ __forceinline__ int operator()(int np, float& sc) const { sc = 1.f; const int t = np >> 8, bj = (np >> 7) & 1, c = np & 127; if (t < 8) return (bj ? 3072 : 0) + t * 128 + c; return (bj ? 6144 : 4096) + (t - 8) * 128 + c; } };
struct MapO1a { __device__ __forceinline__ int operator()(int np, float& sc) const { sc = (np < 1024) ? 0.08838834764831845f : 1.f; if (np < 4096) return np; const int c = np - 4096; return c < 16 ? 8192 + c : -1; } };
struct MapO1b { __device__ __forceinline__ int operator()(int np, float& sc) const { sc = 1.f; const int t = np >> 8, bj = (np >> 7) & 1, c = np & 127; return (bj ? 6144 : 4096) + t * 128 + c; } };
struct MapId  { __device__ __forceinline__ int operator()(int np, float& sc) const { sc = 1.f; return np; } };
template <class F> __device__ __forceinline__ void conv_w(bf16_t* dst, const float* src, int K, int Nsrc, int Nrows, const float* gk, F map, int gt, int nth) {
    const int total = Nrows * (K >> 3);
    for (int idx = gt; idx < total; idx += nth) {
        const int np = idx % Nrows, k8 = idx / Nrows; float sc; const int n = map(np, sc);
        float v[8];
#pragma unroll
        for (int j = 0; j < 8; ++j) { const int k = k8 * 8 + j; v[j] = (n >= 0) ? src[(size_t)k * Nsrc + n] * (gk ? gk[k] : 1.f) * sc : 0.f; }
        *(u32x4*)(dst + (size_t)np * K + k8 * 8) = pack8(v);
    }
}

struct Ptrs { float* out; unsigned char* ws; };
template <int I> __device__ __forceinline__ const float* inp_() {
    const unsigned long long ka = (unsigned long long)__builtin_amdgcn_kernarg_segment_ptr(); unsigned long long v;
    asm volatile("s_load_dwordx2 %0, %1, %2\n\ts_waitcnt lgkmcnt(0)" : "=s"(v) : "s"(ka), "n"(I * 8) : "memory");
    return (const float*)v;
}
#define INP(i) (inp_<i>())
#define LAS3 __attribute__((address_space(3)))

__device__ __forceinline__ void prep_layer_weights(const Ptrs& P, int L, int gt, int nth) {
    const int j = L >> 1; bf16_t* WIN = (bf16_t*)(P.ws + WS_WIN); bf16_t* WOUT = (bf16_t*)(P.ws + WS_WOUT);
    const float* pre_g = INP(2) + (size_t)L * DM;
    if ((L & 1) == 0) {
        const float* w = INP(7) + (size_t)j * DM * EVEN_IN;
        conv_w(WIN, w, DM, EVEN_IN, N1A_E, pre_g, MapE1a(), gt, nth);
        conv_w(WIN + (size_t)N1A_E * DM, w, DM, EVEN_IN, N1B_E, pre_g, MapE1b(), gt, nth);
        conv_w(WOUT, INP(13) + (size_t)j * 2048 * DM, 2048, DM, DM, nullptr, MapId(), gt, nth);
    } else {
        const float* w = INP(14) + (size_t)j * DM * ODD_IN;
        conv_w(WIN, w, DM, ODD_IN, N1A_O, pre_g, MapO1a(), gt, nth);
        conv_w(WIN + (size_t)N1A_O * DM, w, DM, ODD_IN, N1B_O, pre_g, MapO1b(), gt, nth);
        conv_w(WOUT, INP(17) + (size_t)j * 2048 * DM, 2048, DM, DM, nullptr, MapId(), gt, nth);
    }
}

__device__ __forceinline__ void phase_prologue(const Ptrs& P, int G, int bid, int tid) {
    const int lane = tid & 63, wid = tid >> 6;
    const float* x = INP(0); bf16_t* HBA = (bf16_t*)(P.ws + WS_HBA); float* SSQA = (float*)(P.ws + WS_SSQA);
    for (int row = bid * 8 + wid; row < M; row += G * 8) {
        float sq = 0.f;
#pragma unroll
        for (int i = 0; i < 2; ++i) { const size_t off = (size_t)row * DM + i * 512 + lane * 8;
            const f32x4 a = *(const f32x4*)(x + off), b = *(const f32x4*)(x + off + 4);
            const float o[8] = {a[0], a[1], a[2], a[3], b[0], b[1], b[2], b[3]};
#pragma unroll
            for (int j = 0; j < 8; ++j) sq += o[j] * o[j];
            *(u32x4*)(HBA + off) = pack8(o); }
        sq = wave_sum(sq);
        if (lane < 16) SSQA[(size_t)row * 16 + lane] = (lane == 0) ? sq : 0.f;
    }
    const int gt = bid * 512 + tid, nth = G * 512;
    for (int L = 0; L < DEPTH; ++L) {
        conv_w((bf16_t*)(P.ws + WS_WG) + (size_t)L * DM * DM, INP(6) + (size_t)L * DM * DM, DM, DM, DM, INP(4) + (size_t)L * DM, MapId(), gt, nth);
        conv_w((bf16_t*)(P.ws + WS_WP) + (size_t)L * DM * PLE, INP(5) + (size_t)L * PLE * DM, PLE, DM, DM, nullptr, MapId(), gt, nth);
    }
    prep_layer_weights(P, 0, gt, nth);
}

__device__ __forceinline__ void phase_p4(const Ptrs& P, int L, int G, int bid, int tid) {
    const int lane = tid & 63, wid = tid >> 6;
    const float* hin = (L == 0) ? INP(0) : P.out; float* H = P.out;
    const bf16_t* Y = (const bf16_t*)(P.ws + WS_R1); const float* SSQY = (const float*)(P.ws + WS_SSQY);
    bf16_t* HBB = (bf16_t*)(P.ws + WS_R3); float* RSTD1 = (float*)(P.ws + WS_RSTD1);
    const float* pg = INP(3) + (size_t)L * DM;
    f32x4 g[2][2];
#pragma unroll
    for (int i = 0; i < 2; ++i) { g[i][0] = *(const f32x4*)(pg + i * 512 + lane * 8); g[i][1] = *(const f32x4*)(pg + i * 512 + lane * 8 + 4); }
    for (int row = bid * 8 + wid; row < M; row += G * 8) {
        float s = (lane < 16) ? SSQY[(size_t)row * 16 + lane] : 0.f;
        s = wave_sum(s);
        const float rsy = rsqrtf(s * (1.0f / 1024.0f) + EPS);
        float sq = 0.f;
#pragma unroll
        for (int i = 0; i < 2; ++i) { const size_t off = (size_t)row * DM + i * 512 + lane * 8;
            float yv[8]; unpack8(*(const u32x4*)(Y + off), yv);
            const f32x4 a = *(const f32x4*)(hin + off), b = *(const f32x4*)(hin + off + 4);
            float o[8];
#pragma unroll
            for (int j = 0; j < 8; ++j) { o[j] = (j < 4 ? a[j & 3] : b[j & 3]) + yv[j] * rsy * g[i][j >> 2][j & 3]; sq += o[j] * o[j]; }
            *(f32x4*)(H + off) = (f32x4){o[0], o[1], o[2], o[3]}; *(f32x4*)(H + off + 4) = (f32x4){o[4], o[5], o[6], o[7]};
            *(u32x4*)(HBB + off) = pack8(o); }
        sq = wave_sum(sq);
        if (lane == 0) RSTD1[row] = rsqrtf(sq * (1.0f / 1024.0f) + EPS);
    }
    const int gt = bid * 512 + tid, nth = G * 512;
    const float* pl = INP(1) + (size_t)L * M * PLE; bf16_t* PB = (bf16_t*)(P.ws + WS_R3 + 64 * MiB);
    for (int i = gt; i < M * PLE / 8; i += nth) { const f32x4 a = *(const f32x4*)(pl + (size_t)i * 8), b = *(const f32x4*)(pl + (size_t)i * 8 + 4);
        const float o[8] = {a[0], a[1], a[2], a[3], b[0], b[1], b[2], b[3]}; *(u32x4*)(PB + (size_t)i * 8) = pack8(o); }
    if (L + 1 < DEPTH) prep_layer_weights(P, L + 1, gt, nth);
}

__device__ __forceinline__ void phase_gm(LAS3 unsigned char* lds, const Ptrs& P, int j, int G, int bid, int tid_in) {
    LAS3 float* Wt = (LAS3 float*)lds; LAS3 float* Vt = (LAS3 float*)(lds + 65536); LAS3 float* mu = (LAS3 float*)(lds + 131072); LAS3 float* rsd = mu + 128;
    const bf16_t* BV = (const bf16_t*)(P.ws + WS_R2); bf16_t* S = (bf16_t*)(P.ws + WS_R3);
    const float* ws_ = INP(11) + (size_t)j * 8 * 128 * 128; const float* bs = INP(12) + (size_t)j * 128 * 8;
    const float* lg = INP(9) + (size_t)j * 1024; const float* lb = INP(10) + (size_t)j * 1024;
    for (int c = bid; c < M / 128; c += G) {
        int tid = tid_in; asm volatile("" : "+v"(tid));
        const int lane = tid & 63, wid = tid >> 6;
        const int r0 = c * 128;
#pragma unroll 2
        for (int rr = 0; rr < 16; ++rr) { const int row = wid * 16 + rr; const bf16_t* p = BV + (size_t)(r0 + row) * 1024;
            float a[8], b[8]; unpack8(*(const u32x4*)(p + lane * 8), a); unpack8(*(const u32x4*)(p + 512 + lane * 8), b);
            float s = 0.f;
#pragma unroll
            for (int q = 0; q < 8; ++q) s += a[q] + b[q];
            s = wave_sum(s); const float mean = s * (1.0f / 1024.0f); float v = 0.f;
#pragma unroll
            for (int q = 0; q < 8; ++q) { const float d0 = a[q] - mean, d1 = b[q] - mean; v += d0 * d0 + d1 * d1; }
            v = wave_sum(v);
            if (lane == 0) { mu[row] = mean; rsd[row] = rsqrtf(v * (1.0f / 1024.0f) + EPS); } }
        __syncthreads();
#pragma unroll 1
        for (int g = 0; g < 8; ++g) {
            asm volatile("" : "+v"(tid));
#pragma unroll 4
            for (int i = 0; i < 32; ++i) { const int e = tid + 512 * i, t = e >> 7, s = e & 127;
                Wt[s * 128 + t] = (s <= t) ? ws_[(size_t)g * 16384 + e] : 0.f; }
#pragma unroll 4
            for (int i = 0; i < 32; ++i) { const int e = tid + 512 * i, s = e >> 7, cc = e & 127;
                Vt[e] = (bf2f(BV[(size_t)(r0 + s) * 1024 + g * 128 + cc]) - mu[s]) * rsd[s] * lg[g * 128 + cc] + lb[g * 128 + cc]; }
            __syncthreads();
            const int cc = tid & 127, tq = tid >> 7;
            float acc[32];
#pragma unroll
            for (int i = 0; i < 32; ++i) acc[i] = 0.f;
            const int smax = tq * 32 + 31;
#pragma unroll 1
            for (int s = 0; s <= smax; ++s) { const float vv = Vt[s * 128 + cc];
#pragma unroll
                for (int i4 = 0; i4 < 8; ++i4) { const f32x4 w4 = *(const LAS3 f32x4*)&Wt[s * 128 + tq * 32 + i4 * 4];
                    acc[i4 * 4 + 0] += w4[0] * vv; acc[i4 * 4 + 1] += w4[1] * vv; acc[i4 * 4 + 2] += w4[2] * vv; acc[i4 * 4 + 3] += w4[3] * vv; } }
#pragma unroll
            for (int i = 0; i < 32; ++i) { const int t = tq * 32 + i; S[(size_t)(r0 + t) * 1024 + g * 128 + cc] = f2bf(acc[i] + bs[t * 8 + g]); }
            __syncthreads();
        }
    }
}


typedef short bf16x8 __attribute__((ext_vector_type(8)));
typedef short s16x4 __attribute__((ext_vector_type(4)));
typedef float f32x16 __attribute__((ext_vector_type(16)));
__device__ __forceinline__ bf16x8 tr_frag(const LAS3 unsigned char* img, int a0, int a1) {
    const s16x4 x = __builtin_amdgcn_ds_read_tr16_b64_v4i16((LAS3 s16x4*)(img + a0)), y = __builtin_amdgcn_ds_read_tr16_b64_v4i16((LAS3 s16x4*)(img + a1));
    return (bf16x8){x[0], x[1], x[2], x[3], y[0], y[1], y[2], y[3]};
}
constexpr int RS_K = 272, RS_V = 576, RS_KW = 320;

__device__ __forceinline__ void phase_o2(LAS3 unsigned char* lds, const Ptrs& P, int j, int G, int bid, int tid_in) {
    LAS3 unsigned char* KW = lds; LAS3 unsigned char* VI = lds + 40960; LAS3 float* sc = (LAS3 float*)(lds + 40960 + 73728); LAS3 float* wv = sc + 128;
    const bf16_t* Kb = (const bf16_t*)(P.ws + WS_R2); const bf16_t* Vb = (const bf16_t*)(P.ws + WS_R3);
    const float* GATE = (const float*)(P.ws + WS_GATE); float* GB = (float*)(P.ws + WS_GB); float* CS = (float*)(P.ws + WS_CS);
    bf16_t* UC = (bf16_t*)(P.ws + WS_R4); float* NS = (float*)(P.ws + WS_NS);
    const float* bif = INP(15) + (size_t)j * 16;
    for (int unit = bid; unit < NUNIT_O; unit += G) {
        int tid = tid_in; asm volatile("" : "+v"(tid));
        const int lane = tid & 63, wid = __builtin_amdgcn_readfirstlane(tid >> 6), hh = lane >> 5, l31 = lane & 31;
        const int chain = unit >> 7, n = unit & 127, b = chain >> 3, h = chain & 7, r0 = b * SEQ + n * 128;
        u32x4 kq[4], vq[8];
#pragma unroll
        for (int i = 0; i < 4; ++i) { const int e8 = tid + 512 * i, s = e8 >> 4, k8 = e8 & 15; kq[i] = *(const u32x4*)(Kb + (size_t)(r0 + s) * 1024 + h * 128 + k8 * 8); }
#pragma unroll
        for (int i = 0; i < 8; ++i) { const int e8 = tid + 512 * i, s = e8 >> 5, v8 = e8 & 31; vq[i] = *(const u32x4*)(Vb + (size_t)(r0 + s) * 2048 + h * 256 + v8 * 8); }
        float ii = 0.f, a = 0.f;
        if (tid < 128) { const float fi = GATE[(size_t)(r0 + tid) * 16 + 8 + h] + bif[8 + h]; ii = GATE[(size_t)(r0 + tid) * 16 + h] + bif[h]; sc[tid] = logsigmoidf_(fi); }
        __syncthreads();
        for (int off = 1; off < 128; off <<= 1) { float v = 0.f; if (tid < 128) v = sc[tid] + (tid >= off ? sc[tid - off] : 0.f); __syncthreads(); if (tid < 128) sc[tid] = v; __syncthreads(); }
        const float gtot = sc[127];
        if (tid < 128) { a = gtot - sc[tid] + ii; wv[tid] = a; GB[((size_t)(r0 + tid) * 8 + h) * 2] = sc[tid]; GB[((size_t)(r0 + tid) * 8 + h) * 2 + 1] = ii; }
        __syncthreads();
        float amax = -3.0e38f;
#pragma unroll 8
        for (int t = 0; t < 128; ++t) amax = fmaxf(amax, wv[t]);
        __syncthreads();
        if (tid < 128) wv[tid] = __expf(a - amax);
        if (tid == 0) { CS[(size_t)unit * 2] = gtot; CS[(size_t)unit * 2 + 1] = amax; }
        __syncthreads();
#pragma unroll
        for (int i = 0; i < 4; ++i) { const int e8 = tid + 512 * i, s = e8 >> 4, k8 = e8 & 15;
            float kv[8]; unpack8(kq[i], kv); const float w = wv[s];
#pragma unroll
            for (int q = 0; q < 8; ++q) kv[q] *= w;
            *(LAS3 u32x4*)(KW + s * RS_KW + k8 * 16) = pack8(kv); }
#pragma unroll
        for (int i = 0; i < 8; ++i) { const int e8 = tid + 512 * i, s = e8 >> 5, v8 = e8 & 31; *(LAS3 u32x4*)(VI + s * RS_V + v8 * 16) = vq[i]; }
        __syncthreads();
        {
            const int blk = (lane >> 4) & 1, q = (lane & 15) >> 2, p = lane & 3;
            const int trv = (q + 8 * hh) * RS_V + (wid * 32 + 16 * blk + 4 * p) * 2, trk = (q + 8 * hh) * RS_KW + (16 * blk + 4 * p) * 2;
            f32x16 acc[4];
#pragma unroll
            for (int db = 0; db < 4; ++db)
#pragma unroll
                for (int r = 0; r < 16; ++r) acc[db][r] = 0.f;
#pragma unroll
            for (int ks = 0; ks < 8; ++ks) {
                const bf16x8 af = tr_frag(VI, trv + 16 * ks * RS_V, trv + (16 * ks + 4) * RS_V);
#pragma unroll
                for (int db = 0; db < 4; ++db) { const bf16x8 bfr = tr_frag(KW, trk + 16 * ks * RS_KW + db * 64, trk + (16 * ks + 4) * RS_KW + db * 64);
                    acc[db] = __builtin_amdgcn_mfma_f32_32x32x16_bf16(af, bfr, acc[db], 0, 0, 0); }
            }
            bf16_t* up = UC + (size_t)unit * 32768;
#pragma unroll
            for (int db = 0; db < 4; ++db)
#pragma unroll
                for (int r = 0; r < 16; ++r) { const int v = wid * 32 + (r & 3) + 8 * (r >> 2) + 4 * hh; up[v * 128 + db * 32 + l31] = f2bf(acc[db][r]); }
        }
        if (tid < 128) { float ns = 0.f;
#pragma unroll 8
            for (int s = 0; s < 128; ++s) ns += bf2f(*(const LAS3 bf16_t*)(KW + s * RS_KW + tid * 2));
            NS[(size_t)unit * 128 + tid] = ns; }
        __syncthreads();
    }
}

__device__ __forceinline__ void phase_o3(LAS3 unsigned char* lds, const Ptrs& P, int G, int bid, int tid) {
    LAS3 float* dec = (LAS3 float*)lds; LAS3 float* scl = dec + 128; LAS3 float* gg = scl + 128; LAS3 float* am = gg + 128;
    const float* CS = (const float*)(P.ws + WS_CS); float* MS = (float*)(P.ws + WS_MS); bf16_t* UC = (bf16_t*)(P.ws + WS_R4); float* NS = (float*)(P.ws + WS_NS);
    for (int task = bid; task < 256; task += G) {
        const int chain = task >> 4, eb = task & 15;
        if (tid < 128) { gg[tid] = CS[((size_t)chain * 128 + tid) * 2]; am[tid] = CS[((size_t)chain * 128 + tid) * 2 + 1]; }
        __syncthreads();
        if (tid == 0) { float m = 0.f;
            for (int n = 0; n < 128; ++n) { const float g = gg[n], a = am[n], mn = fmaxf(g + m, a); dec[n] = __expf(g + m - mn); scl[n] = __expf(a - mn); if (eb == 0) MS[chain * 128 + n] = m; m = mn; } }
        __syncthreads();
        const size_t e = (size_t)eb * 2048 + tid * 4;
        float c0 = 0.f, c1 = 0.f, c2 = 0.f, c3 = 0.f;
        for (int n0 = 0; n0 < 128; n0 += 8) {
            u32x2 u[8];
#pragma unroll
            for (int q = 0; q < 8; ++q) u[q] = *(const u32x2*)(UC + ((size_t)chain * 128 + n0 + q) * 32768 + e);
#pragma unroll
            for (int q = 0; q < 8; ++q) { u32x2 w; w.x = pk2(c0, c1); w.y = pk2(c2, c3); *(u32x2*)(UC + ((size_t)chain * 128 + n0 + q) * 32768 + e) = w;
                const float d = dec[n0 + q], s = scl[n0 + q];
                c0 = d * c0 + s * __uint_as_float(u[q].x << 16); c1 = d * c1 + s * __uint_as_float(u[q].x & 0xffff0000u);
                c2 = d * c2 + s * __uint_as_float(u[q].y << 16); c3 = d * c3 + s * __uint_as_float(u[q].y & 0xffff0000u); }
        }
        if (eb == 0 && tid < 128) { float cn = 0.f;
            for (int n = 0; n < 128; ++n) { const size_t o = ((size_t)chain * 128 + n) * 128 + tid; const float v = NS[o]; NS[o] = cn; cn = dec[n] * cn + scl[n] * v; } }
        __syncthreads();
    }
}


__device__ __forceinline__ void phase_o4(LAS3 unsigned char* lds, const Ptrs& P, int j, int G, int bid, int tid_in) {
    LAS3 unsigned char* RA = lds;
    LAS3 unsigned char* RB = lds + 73728;
    LAS3 float* bb = (LAS3 float*)(lds + 143360); LAS3 float* cc = bb + 128; LAS3 float* MM = cc + 128; LAS3 float* isc = MM + 128; LAS3 float* nst = isc + 128; LAS3 float* red = nst + 128;
    const bf16_t* Qb = (const bf16_t*)(P.ws + WS_R1); const bf16_t* Kb = (const bf16_t*)(P.ws + WS_R2); bf16_t* Vb = (bf16_t*)(P.ws + WS_R3);
    const bf16_t* UC = (const bf16_t*)(P.ws + WS_R4); const float* NS = (const float*)(P.ws + WS_NS); const float* MS = (const float*)(P.ws + WS_MS); const float* GB = (const float*)(P.ws + WS_GB);
    const float* mhg = INP(16) + (size_t)j * 8 * 256;
    for (int unit = bid; unit < NUNIT_O; unit += G) {
        int tid = tid_in; asm volatile("" : "+v"(tid));
        const int lane = tid & 63, wid = __builtin_amdgcn_readfirstlane(tid >> 6), hh = lane >> 5, l31 = lane & 31, tb = wid & 3, vh = wid >> 2;
        const int chain = unit >> 7, n = unit & 127, b = chain >> 3, h = chain & 7, r0 = b * SEQ + n * 128;
        const float mst = MS[chain * 128 + n];
        const int t = tb * 32 + l31;
        {
            u32x4 kq[4], cq[8];
#pragma unroll
            for (int i = 0; i < 4; ++i) { const int e8 = tid + 512 * i, s = e8 >> 4, k8 = e8 & 15; kq[i] = *(const u32x4*)(Kb + (size_t)(r0 + s) * 1024 + h * 128 + k8 * 8); }
#pragma unroll
            for (int i = 0; i < 8; ++i) { const int e8 = tid + 512 * i; cq[i] = *(const u32x4*)(UC + (size_t)unit * 32768 + (size_t)e8 * 8); }
            if (tid < 128) { const float bv = GB[((size_t)(r0 + tid) * 8 + h) * 2], iv = GB[((size_t)(r0 + tid) * 8 + h) * 2 + 1]; bb[tid] = bv; cc[tid] = iv - bv; nst[tid] = NS[(size_t)unit * 128 + tid]; }
#pragma unroll
            for (int i = 0; i < 4; ++i) { const int e8 = tid + 512 * i, s = e8 >> 4, k8 = e8 & 15; *(LAS3 u32x4*)(RA + s * RS_K + k8 * 16) = kq[i]; }
#pragma unroll
            for (int i = 0; i < 8; ++i) { const int e8 = tid + 512 * i, v = e8 >> 4, k8 = e8 & 15; *(LAS3 u32x4*)(RB + v * RS_K + k8 * 16) = cq[i]; }
        }
        bf16x8 qf[8];
#pragma unroll
        for (int ks = 0; ks < 8; ++ks) qf[ks] = *(const bf16x8*)(Qb + (size_t)(r0 + t) * 1024 + h * 128 + 16 * ks + 8 * hh);
        __syncthreads();
        if (tid < 128) { float mx = mst;
#pragma unroll 1
            for (int s = 0; s <= tid; ++s) mx = fmaxf(mx, cc[s]);
            MM[tid] = mx; isc[tid] = __expf(mst - mx); }
        f32x16 accS[4], acc[4];
#pragma unroll
        for (int sb = 0; sb < 4; ++sb) {
#pragma unroll
            for (int r = 0; r < 16; ++r) accS[sb][r] = 0.f;
            if (sb <= tb) {
#pragma unroll
                for (int ks = 0; ks < 8; ++ks) { const bf16x8 af = *(const LAS3 bf16x8*)(RA + (sb * 32 + l31) * RS_K + (16 * ks + 8 * hh) * 2); accS[sb] = __builtin_amdgcn_mfma_f32_32x32x16_bf16(af, qf[ks], accS[sb], 0, 0, 0); }
            }
        }
#pragma unroll
        for (int vb = 0; vb < 4; ++vb) {
#pragma unroll
            for (int r = 0; r < 16; ++r) acc[vb][r] = 0.f;
#pragma unroll
            for (int ks = 0; ks < 8; ++ks) { const bf16x8 af = *(const LAS3 bf16x8*)(RB + ((vh * 4 + vb) * 32 + l31) * RS_K + (16 * ks + 8 * hh) * 2); acc[vb] = __builtin_amdgcn_mfma_f32_32x32x16_bf16(af, qf[ks], acc[vb], 0, 0, 0); }
        }
        float qn = 0.f;
#pragma unroll
        for (int ks = 0; ks < 8; ++ks) { const f32x4 n0 = *(const LAS3 f32x4*)&nst[16 * ks + 8 * hh], n1 = *(const LAS3 f32x4*)&nst[16 * ks + 8 * hh + 4];
            float qv[8]; unpack8(__builtin_bit_cast(u32x4, qf[ks]), qv);
            qn += (qv[0] * n0[0] + qv[1] * n0[1]) + (qv[2] * n0[2] + qv[3] * n0[3]) + (qv[4] * n1[0] + qv[5] * n1[1]) + (qv[6] * n1[2] + qv[7] * n1[3]); }
        qn += __shfl_xor(qn, 32);
        __syncthreads();
        u32x4 vq[8];
#pragma unroll
        for (int i = 0; i < 8; ++i) { const int e8 = tid + 512 * i, s = e8 >> 5, v8 = e8 & 31; vq[i] = *(const u32x4*)(Vb + (size_t)(r0 + s) * 2048 + h * 256 + v8 * 8); }
        const float MMt = MM[t], isct = isc[t];
        bf16x8 pf[8]; float dsum = 0.f;
#pragma unroll
        for (int sb = 0; sb < 4; ++sb) {
            u32x4 w0 = (u32x4){0u, 0u, 0u, 0u}, w1 = (u32x4){0u, 0u, 0u, 0u};
            if (sb <= tb) {
                float pv[16];
#pragma unroll
                for (int rg = 0; rg < 4; ++rg) { const f32x4 c4 = *(const LAS3 f32x4*)&cc[sb * 32 + 8 * rg + 4 * hh];
#pragma unroll
                    for (int e = 0; e < 4; ++e) { const int s = sb * 32 + 8 * rg + 4 * hh + e; const float pvv = (s <= t) ? __expf(c4[e] - MMt) * accS[sb][rg * 4 + e] : 0.f; pv[rg * 4 + e] = pvv; dsum += pvv; } }
                w0.x = pk2(pv[0], pv[1]); w0.y = pk2(pv[2], pv[3]); w0.z = pk2(pv[4], pv[5]); w0.w = pk2(pv[6], pv[7]);
                w1.x = pk2(pv[8], pv[9]); w1.y = pk2(pv[10], pv[11]); w1.z = pk2(pv[12], pv[13]); w1.w = pk2(pv[14], pv[15]);
            }
            pf[2 * sb] = __builtin_bit_cast(bf16x8, w0); pf[2 * sb + 1] = __builtin_bit_cast(bf16x8, w1);
        }
#pragma unroll
        for (int vb = 0; vb < 4; ++vb)
#pragma unroll
            for (int r = 0; r < 16; ++r) acc[vb][r] *= isct;
#pragma unroll
        for (int i = 0; i < 8; ++i) { const int e8 = tid + 512 * i, s = e8 >> 5, v8 = e8 & 31; *(LAS3 u32x4*)(RA + s * RS_V + v8 * 16) = vq[i]; }
        __syncthreads();
        {
            const int blk = (lane >> 4) & 1, q = (lane & 15) >> 2, p = lane & 3;
            const int trv = (q + 4 * hh) * RS_V + (vh * 128 + 16 * blk + 4 * p) * 2;
#pragma unroll
            for (int sp = 0; sp < 8; ++sp) {
                if (sp <= 2 * tb + 1) {
#pragma unroll
                    for (int vb = 0; vb < 4; ++vb) { const bf16x8 af = tr_frag(RA, trv + 16 * sp * RS_V + vb * 64, trv + (16 * sp + 8) * RS_V + vb * 64);
                        acc[vb] = __builtin_amdgcn_mfma_f32_32x32x16_bf16(af, pf[sp], acc[vb], 0, 0, 0); }
                }
            }
        }
        dsum += __shfl_xor(dsum, 32);
        const float den = isct * qn + dsum, dn = fmaxf(fabsf(den), __expf(-(bb[t] + MMt))), inv = 1.0f / dn;
        float ssq = 0.f;
#pragma unroll
        for (int vb = 0; vb < 4; ++vb)
#pragma unroll
            for (int r = 0; r < 16; ++r) { acc[vb][r] *= inv; ssq += acc[vb][r] * acc[vb][r]; }
        ssq += __shfl_xor(ssq, 32);
        if (hh == 0) red[t * 2 + vh] = ssq;
        __syncthreads();
        const float rn = rsqrtf((red[t * 2] + red[t * 2 + 1]) * (1.0f / 256.0f) + EPS);
#pragma unroll
        for (int vb = 0; vb < 4; ++vb)
#pragma unroll
            for (int rg = 0; rg < 4; ++rg) { const int v0 = (vh * 4 + vb) * 32 + 8 * rg + 4 * hh; const f32x4 g4 = *(const f32x4*)(mhg + h * 256 + v0);
                u32x2 w; w.x = pk2(acc[vb][rg * 4 + 0] * rn * g4[0], acc[vb][rg * 4 + 1] * rn * g4[1]); w.y = pk2(acc[vb][rg * 4 + 2] * rn * g4[2], acc[vb][rg * 4 + 3] * rn * g4[3]);
                *(u32x2*)(Vb + (size_t)(r0 + t) * 2048 + h * 256 + v0) = w; }
        __syncthreads();
    }
}

constexpr int NPHASE = 1 + 8 * DEPTH;
__host__ __device__ constexpr bool phase_exists(int ph) { return ph == 0 || !((((ph - 1) >> 3) & 1) == 0 && (((ph - 1) & 7) == 2 || ((ph - 1) & 7) == 3)); }
struct Args { const float* in[18]; float* out; unsigned char* ws; int ph_lo, ph_hi; };

__global__ void __launch_bounds__(512, 2) fwd(Args args) {
    extern __shared__ __attribute__((aligned(16))) unsigned char lds_raw[];
    LAS3 unsigned char* lds = (LAS3 unsigned char*)lds_raw;
    const int tid0 = threadIdx.x, bid = blockIdx.x, G = gridDim.x;
    Ptrs P; P.out = args.out; P.ws = args.ws;
    const int lo0 = args.ph_lo, hi0 = args.ph_hi;
    const bool multi = (hi0 - lo0) > 1;
    XcdBarrier bar; bar.bar = (unsigned*)(P.ws + WS_CTL); bar.x = 0; bar.st = nullptr;
    if (multi) {
        if (tid0 < 4) ((LAS3 unsigned*)(lds + LDS_BAR_OFF))[tid0] = 0u;
        __syncthreads();
        bar = xcd_barrier_post((unsigned*)(P.ws + WS_CTL), (volatile LAS unsigned*)(lds + LDS_BAR_OFF));
    }
#ifndef PHMASK
#define PHMASK 0xFFFF
#endif
#define PHM(k) (((PHMASK) >> (k)) & 1)
#define RUN(ph) (lo <= (ph) && (ph) < hi)
#define SEAM(ph) do { if ((ph) + 1 < hi) xcd_barrier(bar); } while (0)
    bf16_t* const HBA = (bf16_t*)(P.ws + WS_HBA); bf16_t* const WIN = (bf16_t*)(P.ws + WS_WIN); bf16_t* const WOUT = (bf16_t*)(P.ws + WS_WOUT);
    bf16_t* const R1 = (bf16_t*)(P.ws + WS_R1); bf16_t* const R2 = (bf16_t*)(P.ws + WS_R2); bf16_t* const R3 = (bf16_t*)(P.ws + WS_R3); bf16_t* const R4 = (bf16_t*)(P.ws + WS_R4);
    float* const SSQA = (float*)(P.ws + WS_SSQA); float* const SSQY = (float*)(P.ws + WS_SSQY);

    { const int tid = tid0, lo = lo0, hi = hi0; if (PHM(0) && RUN(0)) { phase_prologue(P, G, bid, tid); SEAM(0); } }
#pragma unroll 1
    for (int L = 0; L < DEPTH; ++L) {
        int tid = tid0, lo = lo0, hi = hi0; asm volatile("" : "+v"(tid), "+s"(lo), "+s"(hi));
        const int pb = 1 + 8 * L, j = L >> 1;
        if ((L & 1) == 0) {
            if (PHM(1) && RUN(pb + 0)) { pg8::Gemm g{HBA, WIN, M, N1A_E, DM}; pg8::StaticOrder S; S.init(M, N1A_E, G, bid);
                pg8::EpiE1a E{SSQA, R1, R2}; pg8::gemm_phase<pg8::EpiE1a, pg8::StaticOrder>(lds, g, S, E, nullptr); SEAM(pb + 0); }
            if (PHM(2) && RUN(pb + 1)) { phase_gm(lds, P, j, G, bid, tid); SEAM(pb + 1); }
            if (PHM(3) && RUN(pb + 4)) { pg8::Gemm g{HBA, WIN + (size_t)N1A_E * DM, M, N1B_E, DM}; pg8::StaticOrder S; S.init(M, N1B_E, G, bid);
                pg8::EpiE1b E{SSQA, R1, R3, INP(8) + (size_t)j * 3 * 1024, R4}; pg8::gemm_phase<pg8::EpiE1b, pg8::StaticOrder>(lds, g, S, E, nullptr); SEAM(pb + 4); }
        } else {
            if (PHM(4) && RUN(pb + 0)) { pg8::Gemm g{HBA, WIN, M, N1A_O, DM}; pg8::StaticOrder S; S.init(M, N1A_O, G, bid);
                pg8::EpiO1a E{SSQA, R1, R2, R3, (float*)(P.ws + WS_GATE)}; pg8::gemm_phase<pg8::EpiO1a, pg8::StaticOrder>(lds, g, S, E, nullptr); SEAM(pb + 0); }
            if (PHM(5) && RUN(pb + 1)) { phase_o2(lds, P, j, G, bid, tid); SEAM(pb + 1); }
            if (PHM(6) && RUN(pb + 2)) { phase_o3(lds, P, G, bid, tid); SEAM(pb + 2); }
            if (PHM(7) && RUN(pb + 3)) { phase_o4(lds, P, j, G, bid, tid); SEAM(pb + 3); }
            if (PHM(8) && RUN(pb + 4)) { pg8::Gemm g{HBA, WIN + (size_t)N1A_O * DM, M, N1B_O, DM}; pg8::StaticOrder S; S.init(M, N1B_O, G, bid);
                pg8::EpiO1b E{SSQA, R3, R4}; pg8::gemm_phase<pg8::EpiO1b, pg8::StaticOrder>(lds, g, S, E, nullptr); SEAM(pb + 4); }
        }
        if (PHM(9) && RUN(pb + 5)) { pg8::Gemm g{R4, WOUT, M, DM, 2048}; pg8::StaticOrder S; S.init(M, DM, G, bid);
            pg8::EpiOut E{R1, SSQY}; pg8::gemm_phase<pg8::EpiOut, pg8::StaticOrder>(lds, g, S, E, nullptr); SEAM(pb + 5); }
        if (PHM(10) && RUN(pb + 6)) { phase_p4(P, L, G, bid, tid); SEAM(pb + 6); }
        if (PHM(11) && RUN(pb + 7)) {
            { pg8::Gemm g{R3 + (size_t)32 * MiB, (bf16_t*)(P.ws + WS_WP) + (size_t)L * DM * PLE, M, DM, PLE}; pg8::StaticOrder S; S.init(M, DM, G, bid);
              pg8::EpiPw E{R2}; pg8::gemm_phase<pg8::EpiPw, pg8::StaticOrder>(lds, g, S, E, nullptr); }
            __syncthreads();
            { pg8::Gemm g{R3, (bf16_t*)(P.ws + WS_WG) + (size_t)L * DM * DM, M, DM, DM}; pg8::StaticOrder S; S.init(M, DM, G, bid);
              pg8::EpiGate E{(const float*)(P.ws + WS_RSTD1), R2, P.out, HBA, SSQA}; pg8::gemm_phase<pg8::EpiGate, pg8::StaticOrder>(lds, g, S, E, nullptr); }
            SEAM(pb + 7);
        }
    }
#undef RUN
#undef SEAM
}

#ifndef ONE_LAUNCH
#define ONE_LAUNCH 1
#endif
extern "C" void kernel_launch(void* const* d_in, const int* in_sizes, int n_in, void* d_out, int out_size, void* d_ws, size_t ws_size, hipStream_t stream) {
    static int grid = 0;
    if (grid == 0) {
        if (n_in != 18 || out_size != M * DM || ws_size < WS_END) { fprintf(stderr, "kernel_launch: unexpected shapes (n_in %d out %d ws %zu)\n", n_in, out_size, ws_size); grid = -1; return; }
        int dev = 0, cus = 0, per_cu = 0;
        if (hipGetDevice(&dev) != hipSuccess || hipDeviceGetAttribute(&cus, hipDeviceAttributeMultiprocessorCount, dev) != hipSuccess) { grid = -1; return; }
        if (hipFuncSetAttribute((const void*)fwd, hipFuncAttributeMaxDynamicSharedMemorySize, LDS_BYTES) != hipSuccess) { fprintf(stderr, "kernel_launch: hipFuncSetAttribute failed\n"); grid = -1; return; }
        if (hipOccupancyMaxActiveBlocksPerMultiprocessor(&per_cu, (const void*)fwd, 512, LDS_BYTES) != hipSuccess || per_cu < 1) { fprintf(stderr, "kernel_launch: occupancy query says %d\n", per_cu); }
        (void)hipGetLastError();
        grid = cus;
    }
    if (grid < 0) return;
    (void)hipMemsetAsync((char*)d_ws + WS_CTL, 0, CTL_BYTES, stream);
    Args a{};
    for (int i = 0; i < 18; ++i) a.in[i] = (const float*)d_in[i];
    a.out = (float*)d_out; a.ws = (unsigned char*)d_ws;
#if ONE_LAUNCH
    a.ph_lo = 0; a.ph_hi = NPHASE;
    hipLaunchKernelGGL(fwd, dim3(grid), dim3(512), LDS_BYTES, stream, a);
#else
    for (int ph = 0; ph < NPHASE; ++ph) { if (!phase_exists(ph)) continue; a.ph_lo = ph; a.ph_hi = ph + 1; hipLaunchKernelGGL(fwd, dim3(grid), dim3(512), LDS_BYTES, stream, a); }
#endif
}
```

```cpp
#include <hip/hip_runtime.h>
#include <cstdio>
#include <cstdint>
namespace pg8 {
#define PG8_LAS __attribute__((address_space(3)))
typedef unsigned short bf16_t;
typedef short bf16x8 __attribute__((ext_vector_type(8)));
typedef float f32x4 __attribute__((ext_vector_type(4)));
typedef unsigned u32x4 __attribute__((ext_vector_type(4)));
constexpr int BM = 256, BK = 64, HALF = 128, HTB = HALF * BK * 2  , STAGE_BYTES = 8 * HTB, NXCD = 8, WGM = 8;

__host__ __device__ __forceinline__ int lds_byte(int r, int c) { const int st = (r >> 4) * 2 + (c >> 5), rr = r & 15, cc = c & 31, ob = rr * 64 + cc * 2; return st * 1024 + (ob ^ (((ob >> 9) & 1) << 5)); }
__host__ __device__ __forceinline__ void stage_rc(int b, int& R, int& C) { const int st = b / 1024, sb = b % 1024, swz = sb ^ (((sb >> 9) & 1) << 5); R = (st >> 1) * 16 + swz / 64; C = (st & 1) * 32 + (swz % 64) / 2; }
__host__ __device__ __forceinline__ int perm32(int rho) { const int n = rho >> 4, i = rho & 15; return 8 * (i >> 2) + 4 * n + (i & 3); }

struct Unit { int pm, pn; };
struct Gemm { const bf16_t* A; const bf16_t* Bt; int M, N, K; };

struct StaticOrder {
    int nM, nN, nwg, G, c;
    __host__ __device__ void init(int M, int N, int G_, int c_) { nM = M / BM; nN = N / BM; nwg = nM * nN; G = G_; c = c_; }
    __host__ __device__ bool next(int i, Unit& u) const {
        const long L = (long)i * G + c; if (L >= nwg) return false;
        int wgid = (int)L; { const int q = nwg / NXCD, r = nwg % NXCD, xcd = wgid % NXCD, off = wgid / NXCD; wgid = (xcd < r ? xcd * (q + 1) : r * (q + 1) + (xcd - r) * q) + off; }
        const int nig = WGM * nN, gid = wgid / nig, fm = gid * WGM, gsz = (nM - fm) < WGM ? (nM - fm) : WGM;
        u.pm = fm + ((wgid % nig) % gsz); u.pn = (wgid % nig) / gsz; return true;
    }
    __device__ __forceinline__ void a_ready(const Unit&) const {}
    __device__ __forceinline__ void done(const Unit&) const {}
};
__device__ __forceinline__ unsigned cvt_pk_bf16(float lo, float hi) { unsigned r; asm volatile("v_cvt_pk_bf16_f32 %0, %1, %2" : "=v"(r) : "v"(lo), "v"(hi)); return r; }
typedef float f32x2 __attribute__((ext_vector_type(2)));
template <class Epi, class Sched, bool STAMP = false>
__device__ __forceinline__ void gemm_phase(PG8_LAS unsigned char* lds, const Gemm g, const Sched& S, const Epi& E, unsigned long long* stamps) {
    int tid_l_ = threadIdx.x; asm volatile("" : "+v"(tid_l_));
    const int tid = tid_l_, wid = __builtin_amdgcn_readfirstlane(tid >> 6), lane = tid & 63, wr = wid >> 2, wc = wid & 3, fr = lane & 15, fq = lane >> 4;
    const int K = g.K, nt = K / BK;
    int ts_lo = 0, ts_hi = 0, nts = 0; const unsigned long long rt_entry = STAMP ? (unsigned long long)wall_clock64() : 0ull;
#define PG8_STAMP() do { if (STAMP && wid == 0 && nts < 64) { const unsigned long long _c = (unsigned long long)clock64(); \
        ts_lo = (lane == nts) ? (int)(unsigned)_c : ts_lo; ts_hi = (lane == nts) ? (int)(unsigned)(_c >> 32) : ts_hi; ++nts; } } while (0)
    PG8_STAMP();
    unsigned voffA[2], voffB[2];
#pragma unroll
    for (int i = 0; i < 2; ++i) { int R, C; stage_rc(tid * 16 + i * 8192, R, C); const int Rb = Epi::PERM ? ((R & ~31) + perm32(R & 31)) : R;
        voffA[i] = (unsigned)(R * K + C) * 2u; voffB[i] = (unsigned)(Rb * K + C) * 2u; }
    const size_t kstep = (size_t)(BK * 2);
    const size_t hstep = (size_t)HALF * K * 2;
    const size_t tstep = 2 * hstep;
    const unsigned ldsw = (unsigned)wid * 1024u;
    const int aoff = lds_byte(wr * 64 + fr, fq * 8), boff = lds_byte(wc * 32 + fr, fq * 8);
#define PG8_SA(b, h) (((b) * 2 + (h)) * HTB)
#define PG8_SB(b, h) ((4 + (b) * 2 + (h)) * HTB)
#define PG8_STAGE(bufoff, gbase, voff) do { _Pragma("unroll") for (int _i = 0; _i < 2; ++_i) \
        __builtin_amdgcn_global_load_lds((const unsigned*)((const char*)(gbase) + (voff)[_i]), (PG8_LAS unsigned*)(lds + (bufoff) + ldsw + _i * 8192), 16, 0, 0); } while (0)
#define PG8_LDA(dst, b, h) do { _Pragma("unroll") for (int m = 0; m < 4; ++m) _Pragma("unroll") for (int k = 0; k < 2; ++k) dst[m][k] = *(const PG8_LAS bf16x8*)(lds + PG8_SA(b, h) + aoff + m * 2048 + k * 1024); } while (0)
#define PG8_LDB(dst, b, h) do { _Pragma("unroll") for (int n = 0; n < 2; ++n) _Pragma("unroll") for (int k = 0; k < 2; ++k) dst[n][k] = *(const PG8_LAS bf16x8*)(lds + PG8_SB(b, h) + boff + n * 2048 + k * 1024); } while (0)
#define PG8_MMA(ai, bj, At, Bt) do { __builtin_amdgcn_s_setprio(1); _Pragma("unroll") for (int m = 0; m < 4; ++m) _Pragma("unroll") for (int n = 0; n < 2; ++n) _Pragma("unroll") for (int k = 0; k < 2; ++k) \
        acc[ai][bj][m][n] = __builtin_amdgcn_mfma_f32_16x16x32_bf16(Bt[n][k], At[m][k], acc[ai][bj][m][n], 0, 0, 0); __builtin_amdgcn_s_setprio(0); } while (0)
#define PG8_WAIT_V(n) asm volatile("s_waitcnt vmcnt(" #n ")" ::: "memory")
#define PG8_WAIT_L(n) asm volatile("s_waitcnt lgkmcnt(" #n ")" ::: "memory")
#define PG8_BAR __builtin_amdgcn_s_barrier()
#define PG8_SCHED __builtin_amdgcn_sched_barrier(0)
    Unit cur, nxt; int ui = 0;
    if (!S.next(0, cur)) return;
    f32x4 acc[2][2][4][2];
#pragma unroll
    for (int a = 0; a < 2; ++a)
#pragma unroll
        for (int b = 0; b < 2; ++b)
#pragma unroll
            for (int m = 0; m < 4; ++m)
#pragma unroll
                for (int n = 0; n < 2; ++n) acc[a][b][m][n] = (f32x4){0.f, 0.f, 0.f, 0.f};
    bf16x8 At[4][2], B0[2][2], B1[2][2];
    const char* cA = (const char*)g.A + (size_t)cur.pm * tstep; const char* cB = (const char*)g.Bt + (size_t)cur.pn * tstep;
    S.a_ready(cur);
    PG8_STAGE(PG8_SB(0, 0), cB, voffB); PG8_STAGE(PG8_SA(0, 0), cA, voffA); PG8_STAGE(PG8_SB(0, 1), cB + hstep, voffB); PG8_STAGE(PG8_SA(0, 1), cA + hstep, voffA);
    if (wr == 1) PG8_BAR;
    PG8_WAIT_V(4); PG8_BAR;
    PG8_STAGE(PG8_SB(1, 0), cB + kstep, voffB); PG8_STAGE(PG8_SA(1, 0), cA + kstep, voffA); PG8_STAGE(PG8_SB(1, 1), cB + hstep + kstep, voffB);
    PG8_WAIT_V(6); PG8_BAR;
    PG8_STAMP();
    for (;;) {
        const bool has_next = S.next(ui + 1, nxt);
        const char* nA = has_next ? (const char*)g.A + (size_t)nxt.pm * tstep : cA; const char* nB = has_next ? (const char*)g.Bt + (size_t)nxt.pn * tstep : cB;
        for (int t = 0; t < nt; t += 2) {
            const bool last = (t == nt - 2);
            const char* a1 = cA + (size_t)(t + 1) * kstep;
            const char* a2 = last ? nA : cA + (size_t)(t + 2) * kstep; const char* b2 = last ? nB : cB + (size_t)(t + 2) * kstep;
            const char* a3 = a2 + kstep; const char* b3 = b2 + kstep;
            if (last && has_next) S.a_ready(nxt);
            PG8_LDB(B0, 0, 0); PG8_SCHED; PG8_LDA(At, 0, 0); PG8_STAGE(PG8_SA(1, 1), a1 + hstep, voffA);
            PG8_WAIT_L(8); PG8_BAR; PG8_WAIT_L(0); PG8_MMA(0, 0, At, B0); PG8_BAR; PG8_SCHED;
            PG8_LDB(B1, 0, 1); PG8_STAGE(PG8_SB(0, 0), b2, voffB);
            PG8_BAR; PG8_WAIT_L(0); PG8_MMA(0, 1, At, B1); PG8_BAR;
            PG8_LDA(At, 0, 1); PG8_STAGE(PG8_SA(0, 0), a2, voffA);
            PG8_BAR; PG8_WAIT_L(0); PG8_MMA(1, 0, At, B0); PG8_BAR; PG8_SCHED;
            PG8_STAGE(PG8_SB(0, 1), b2 + hstep, voffB);
            PG8_WAIT_V(6); PG8_BAR; PG8_MMA(1, 1, At, B1); PG8_BAR;
            PG8_LDB(B0, 1, 0); PG8_SCHED; PG8_LDA(At, 1, 0); PG8_STAGE(PG8_SA(0, 1), a2 + hstep, voffA);
            PG8_WAIT_L(8); PG8_BAR; PG8_WAIT_L(0); PG8_MMA(0, 0, At, B0); PG8_BAR; PG8_SCHED;
            PG8_LDB(B1, 1, 1); PG8_STAGE(PG8_SB(1, 0), b3, voffB);
            PG8_BAR; PG8_WAIT_L(0); PG8_MMA(0, 1, At, B1); PG8_BAR;
            PG8_LDA(At, 1, 1); PG8_STAGE(PG8_SA(1, 0), a3, voffA);
            PG8_BAR; PG8_WAIT_L(0); PG8_MMA(1, 0, At, B0); PG8_BAR; PG8_SCHED;
            PG8_STAGE(PG8_SB(1, 1), b3 + hstep, voffB);
            PG8_WAIT_V(6); PG8_BAR; PG8_MMA(1, 1, At, B1); PG8_BAR;
        }
        PG8_STAMP();
        if constexpr (!Epi::AFTER_DRAIN) { E(acc, cur, wr, wc, fr, fq); S.done(cur); }
        PG8_STAMP();
        if (!has_next) break;
#pragma unroll
        for (int a = 0; a < 2; ++a)
#pragma unroll
            for (int b = 0; b < 2; ++b)
#pragma unroll
                for (int m = 0; m < 4; ++m)
#pragma unroll
                    for (int n = 0; n < 2; ++n) acc[a][b][m][n] = (f32x4){0.f, 0.f, 0.f, 0.f};
        cur = nxt; cA = nA; cB = nB; ++ui;
    }
    PG8_WAIT_V(0);
    if (wr == 0) PG8_BAR;
    PG8_BAR;
    if constexpr (Epi::AFTER_DRAIN) { E.fused(acc, cur, wr, wc, fr, fq, lds, wid, lane); S.done(cur); }
    PG8_STAMP();
    if (STAMP && wid == 0) { stamps[lane] = lane < nts ? (((unsigned long long)(unsigned)ts_hi << 32) | (unsigned)ts_lo) : 0ull;
        if (lane == 62) stamps[62] = rt_entry; if (lane == 63) stamps[63] = (unsigned long long)wall_clock64(); }
#undef PG8_STAMP
#undef PG8_SA
#undef PG8_SB
#undef PG8_STAGE
#undef PG8_LDA
#undef PG8_LDB
#undef PG8_MMA
#undef PG8_WAIT_V
#undef PG8_WAIT_L
#undef PG8_BAR
#undef PG8_SCHED
}
}
#define XB_TMO      128
#define XB_XCNT(j)  (256  + 64 * (j))
#define XB_XSUB(j)  (1280 + 64 * (j))
#define XB_XGEN(j)  (2304 + 64 * (j))
#define XB_TOP      3328
#define XB_TOPGEN   3392
#define XCD_BAR_WORDS 3456
#define XB_SPIN_CAP (1u << 18)
#define LAS __attribute__((address_space(3)))

__device__ __forceinline__ unsigned xb_ld(unsigned* p)              { return __hip_atomic_load(p, __ATOMIC_RELAXED, __HIP_MEMORY_SCOPE_AGENT); }
__device__ __forceinline__ unsigned xb_add(unsigned* p, unsigned v) { return __hip_atomic_fetch_add(p, v, __ATOMIC_RELAXED, __HIP_MEMORY_SCOPE_AGENT); }
__device__ __forceinline__ unsigned xb_xcc_id() { return (unsigned)__builtin_amdgcn_s_getreg((3 << 11) | 20) & 0xFu; }
#define XB_SPIN(cond, bar) do { unsigned _sp = 0; while (cond) { __builtin_amdgcn_s_sleep(1); \
    if ((++_sp & 255u) == 0u) { if (xb_ld(&(bar)[XB_TMO])) break; if (_sp > XB_SPIN_CAP) { atomicAdd(&(bar)[XB_TMO], 1u); break; } } } } while (0)

struct XcdBarrier {
    unsigned* bar; unsigned x;
    volatile LAS unsigned* st;
};

__device__ __forceinline__ XcdBarrier xcd_barrier_post(unsigned* bar, volatile LAS unsigned* st) {
    XcdBarrier b; b.bar = bar; b.x = xb_xcc_id(); b.st = st;
    if (threadIdx.x == 0) (void)xb_add(&bar[XB_XCNT(b.x)], 1u);
    return b;
}
__device__ __forceinline__ void xcd_barrier_complete(unsigned* bar, unsigned x, unsigned& nloc, unsigned& nx) {
    const unsigned G = gridDim.x * gridDim.y * gridDim.z;
    unsigned sum, cnt, mine, sp = 0u;
    for (;;) {
        sum = 0u; cnt = 0u; mine = 0u;
#pragma unroll
        for (unsigned j = 0; j < 16; ++j) { const unsigned c = xb_ld(&bar[XB_XCNT(j)]); sum += c; cnt += (c > 0u) ? 1u : 0u; mine = (j == x) ? c : mine; }
        if (sum == G) break;
        __builtin_amdgcn_s_sleep(1);
        if ((++sp & 255u) == 0u) { if (xb_ld(&bar[XB_TMO])) break; if (sp > XB_SPIN_CAP) { atomicAdd(&bar[XB_TMO], 1u); break; } }
    }
    nloc = mine > 0u ? mine : 1u; nx = cnt > 0u ? cnt : 1u;
}

__device__ __forceinline__ void xcd_barrier(const XcdBarrier& b) {
    asm volatile("s_waitcnt vmcnt(0)" ::: "memory");
    __syncthreads();
    if (threadIdx.x == 0) {
        unsigned* bar = b.bar;
        __builtin_amdgcn_s_waitcnt(0);
        unsigned nloc = b.st[0], nx = b.st[1];
        if (nloc == 0u) { xcd_barrier_complete(bar, b.x, nloc, nx); b.st[0] = nloc; b.st[1] = nx; }
        const unsigned old = xb_add(&bar[XB_XSUB(b.x)], 1u);
        const unsigned gen = old / nloc;
        if (old + 1u == (gen + 1u) * nloc) {
            __builtin_amdgcn_fence(__ATOMIC_RELEASE, "agent");
            asm volatile("s_waitcnt vmcnt(0)" ::: "memory");
            const unsigned og = xb_add(&bar[XB_TOP], 1u);
            const unsigned tg = og / nx;
            if (og + 1u == (tg + 1u) * nx) xb_add(&bar[XB_TOPGEN], 1u);
            else XB_SPIN(xb_ld(&bar[XB_TOPGEN]) == tg, bar);
            __builtin_amdgcn_fence(__ATOMIC_ACQUIRE, "agent");
            xb_add(&bar[XB_XGEN(b.x)], 1u);
            asm volatile("s_waitcnt vmcnt(0)" ::: "memory");
        } else {
            XB_SPIN(xb_ld(&bar[XB_XGEN(b.x)]) == gen, bar);
            __builtin_amdgcn_fence(__ATOMIC_ACQUIRE, "agent");
            asm volatile("s_waitcnt vmcnt(0)" ::: "memory");
        }
    }
    __syncthreads();
}


typedef unsigned short bf16_t;
typedef float f32x4 __attribute__((ext_vector_type(4)));
typedef unsigned u32x4 __attribute__((ext_vector_type(4)));
typedef unsigned u32x2 __attribute__((ext_vector_type(2)));
constexpr int DM = 1024, NBATCH = 2, SEQ = 16384, M = NBATCH * SEQ, DEPTH = 4, PLE = 256;
constexpr float EPS = 1e-6f;
constexpr int EVEN_IN = 7168, ODD_IN = 8208;
constexpr int N1A_E = 3072, N1B_E = 4096, N1A_O = 4352, N1B_O = 4096;
constexpr int NUNIT_O = 2048;
constexpr int LDS_BYTES = 147456;
constexpr int LDS_BAR_OFF = LDS_BYTES - 16;

constexpr size_t MiB = 1u << 20;
constexpr size_t WS_CTL = 0, CTL_BYTES = 64 * 1024;
constexpr size_t WS_SSQA = 1 * MiB, WS_SSQY = 3 * MiB, WS_RSTD1 = 5 * MiB, WS_GATE = 6 * MiB, WS_GB = 8 * MiB, WS_CS = 10 * MiB, WS_MS = 10 * MiB + 65536, WS_NS = 11 * MiB;
constexpr size_t WS_WG = 12 * MiB, WS_WP = 20 * MiB, WS_WIN = 22 * MiB, WS_WOUT = 39 * MiB;
constexpr size_t WS_WSB = 43 * MiB;
constexpr size_t WS_HBA = 44 * MiB, WS_R1 = 108 * MiB, WS_R2 = 172 * MiB, WS_R3 = 236 * MiB, WS_R4 = 364 * MiB, WS_END = 492 * MiB;

__device__ __forceinline__ float bf2f(bf16_t b) { return __uint_as_float(((unsigned)b) << 16); }
__device__ __forceinline__ bf16_t f2bf(float f) { unsigned u = __float_as_uint(f); u += 0x7FFFu + ((u >> 16) & 1u); return (bf16_t)(u >> 16); }
__device__ __forceinline__ unsigned pk2(float lo, float hi) { return pg8::cvt_pk_bf16(lo, hi); }
__device__ __forceinline__ void unpack8(const u32x4 w, float (&f)[8]) {
    f[0] = __uint_as_float(w.x << 16); f[1] = __uint_as_float(w.x & 0xffff0000u); f[2] = __uint_as_float(w.y << 16); f[3] = __uint_as_float(w.y & 0xffff0000u);
    f[4] = __uint_as_float(w.z << 16); f[5] = __uint_as_float(w.z & 0xffff0000u); f[6] = __uint_as_float(w.w << 16); f[7] = __uint_as_float(w.w & 0xffff0000u);
}
__device__ __forceinline__ u32x4 pack8(const float (&f)[8]) { u32x4 w; w.x = pk2(f[0], f[1]); w.y = pk2(f[2], f[3]); w.z = pk2(f[4], f[5]); w.w = pk2(f[6], f[7]); return w; }
__device__ __forceinline__ float sigmoidf_(float x) { return __builtin_amdgcn_rcpf(1.0f + __expf(-x)); }
__device__ __forceinline__ float siluf_(float x) { return x * sigmoidf_(x); }
__device__ __forceinline__ float logsigmoidf_(float x) { return fminf(x, 0.f) - log1pf(__expf(-fabsf(x))); }
__device__ __forceinline__ float wave_sum(float s) { s += __shfl_xor(s, 1); s += __shfl_xor(s, 2); s += __shfl_xor(s, 4); s += __shfl_xor(s, 8); s += __shfl_xor(s, 16); s += __shfl_xor(s, 32); return s; }
__device__ __forceinline__ float rstd16(const float* p) {
    const f32x4 a = *(const f32x4*)p, b = *(const f32x4*)(p + 4), c = *(const f32x4*)(p + 8), d = *(const f32x4*)(p + 12);
    const float s = ((a[0] + a[1]) + (a[2] + a[3])) + ((b[0] + b[1]) + (b[2] + b[3])) + ((c[0] + c[1]) + (c[2] + c[3])) + ((d[0] + d[1]) + (d[2] + d[3]));
    return rsqrtf(s * (1.0f / 1024.0f) + EPS);
}

namespace pg8 {
#define EPI_ROWS_BEGIN  _Pragma("unroll") for (int ai = 0; ai < 2; ++ai) _Pragma("unroll") for (int m = 0; m < 4; ++m) { const int row = rowb + ai * HALF + m * 16;
#define EPI_ROWS_END    asm volatile("" ::: "memory"); }
struct EpiE1a { static constexpr bool PERM = true, AFTER_DRAIN = false;
    const float* ssq; bf16_t* U; bf16_t* BV;
    __device__ __forceinline__ void operator()(const f32x4 (&acc)[2][2][4][2], const Unit& u, int wr, int wc, int fr, int fq) const {
        const int rowb = u.pm * BM + wr * 64 + fr, cw = wc * 32 + 8 * fq;
        EPI_ROWS_BEGIN
            const float rs = rstd16(ssq + (size_t)row * 16);
            if (u.pn < 8) {
                const f32x4 p0 = (acc[ai][0][m][0] * rs) * (acc[ai][1][m][0] * rs), p1 = (acc[ai][0][m][1] * rs) * (acc[ai][1][m][1] * rs);
                u32x4 w; w.x = cvt_pk_bf16(p0[0], p0[1]); w.y = cvt_pk_bf16(p0[2], p0[3]); w.z = cvt_pk_bf16(p1[0], p1[1]); w.w = cvt_pk_bf16(p1[2], p1[3]);
                *(u32x4*)(U + (size_t)row * 1024 + u.pn * 128 + cw) = w;
            } else {
#pragma unroll
                for (int bj = 0; bj < 2; ++bj) { const f32x4 v0 = acc[ai][bj][m][0] * rs, v1 = acc[ai][bj][m][1] * rs;
                    u32x4 w; w.x = cvt_pk_bf16(v0[0], v0[1]); w.y = cvt_pk_bf16(v0[2], v0[3]); w.z = cvt_pk_bf16(v1[0], v1[1]); w.w = cvt_pk_bf16(v1[2], v1[3]);
                    *(u32x4*)(BV + (size_t)row * 1024 + (u.pn - 8) * 256 + bj * HALF + cw) = w; }
            }
        EPI_ROWS_END
    }
};
struct EpiE1b { static constexpr bool PERM = true, AFTER_DRAIN = false;
    const float* ssq; const bf16_t* U; const bf16_t* S; const float* convw; bf16_t* MIX;
    __device__ __forceinline__ void operator()(const f32x4 (&acc)[2][2][4][2], const Unit& u, int wr, int wc, int fr, int fq) const {
        const int rowb = u.pm * BM + wr * 64 + fr, cw = wc * 32 + 8 * fq;
        if (u.pn < 8) {
            const int ch0 = u.pn * 128 + cw;
            float w0[8], w1[8], w2[8];
#pragma unroll
            for (int j = 0; j < 8; ++j) { w0[j] = convw[ch0 + j]; w1[j] = convw[1024 + ch0 + j]; w2[j] = convw[2048 + ch0 + j]; }
            EPI_ROWS_BEGIN
                const float rs = rstd16(ssq + (size_t)row * 16);
                const int ts = row & (SEQ - 1);
                const bf16_t* up = U + (size_t)row * 1024 + ch0;
                float u0[8], u1[8], u2[8];
                unpack8(*(const u32x4*)up, u2);
                if (ts >= 1) unpack8(*(const u32x4*)(up - 1024), u1); else {
#pragma unroll
                    for (int j = 0; j < 8; ++j) u1[j] = 0.f; }
                if (ts >= 2) unpack8(*(const u32x4*)(up - 2048), u0); else {
#pragma unroll
                    for (int j = 0; j < 8; ++j) u0[j] = 0.f; }
                float o[8];
#pragma unroll
                for (int j = 0; j < 8; ++j) { const float ab = acc[ai][0][m][j >> 2][j & 3] * rs, ag = acc[ai][1][m][j >> 2][j & 3] * rs;
                    o[j] = ab * siluf_(ag) * (w2[j] * u2[j] + w1[j] * u1[j] + w0[j] * u0[j]); }
                *(u32x4*)(MIX + (size_t)row * 2048 + ch0) = pack8(o);
            EPI_ROWS_END
        } else {
            const int ch0 = (u.pn - 8) * 128 + cw;
            EPI_ROWS_BEGIN
                const float rs = rstd16(ssq + (size_t)row * 16);
                float sv[8]; unpack8(*(const u32x4*)(S + (size_t)row * 1024 + ch0), sv);
                float o[8];
#pragma unroll
                for (int j = 0; j < 8; ++j) { const float bu = acc[ai][0][m][j >> 2][j & 3] * rs, bg = acc[ai][1][m][j >> 2][j & 3] * rs; o[j] = bu * siluf_(bg) * sv[j]; }
                *(u32x4*)(MIX + (size_t)row * 2048 + 1024 + ch0) = pack8(o);
            EPI_ROWS_END
        }
    }
};
struct EpiO1a { static constexpr bool PERM = true, AFTER_DRAIN = false;
    const float* ssq; bf16_t* Q; bf16_t* K; bf16_t* V; float* GATE;
    __device__ __forceinline__ void operator()(const f32x4 (&acc)[2][2][4][2], const Unit& u, int wr, int wc, int fr, int fq) const {
        const int rowb = u.pm * BM + wr * 64 + fr, cw = wc * 32 + 8 * fq;
        if (u.pn < 16) {
            bf16_t* base; int ld, c0;
            if (u.pn < 4) { base = Q; ld = 1024; c0 = u.pn * 256; } else if (u.pn < 8) { base = K; ld = 1024; c0 = (u.pn - 4) * 256; } else { base = V; ld = 2048; c0 = (u.pn - 8) * 256; }
            EPI_ROWS_BEGIN
                const float rs = rstd16(ssq + (size_t)row * 16);
#pragma unroll
                for (int bj = 0; bj < 2; ++bj) { const f32x4 v0 = acc[ai][bj][m][0] * rs, v1 = acc[ai][bj][m][1] * rs;
                    u32x4 w; w.x = cvt_pk_bf16(v0[0], v0[1]); w.y = cvt_pk_bf16(v0[2], v0[3]); w.z = cvt_pk_bf16(v1[0], v1[1]); w.w = cvt_pk_bf16(v1[2], v1[3]);
                    *(u32x4*)(base + (size_t)row * ld + c0 + bj * HALF + cw) = w; }
            EPI_ROWS_END
        } else if (wc == 0 && fq < 2) {
            EPI_ROWS_BEGIN
                const float rs = rstd16(ssq + (size_t)row * 16);
                *(f32x4*)(GATE + (size_t)row * 16 + 8 * fq) = acc[ai][0][m][0] * rs;
                *(f32x4*)(GATE + (size_t)row * 16 + 8 * fq + 4) = acc[ai][0][m][1] * rs;
            EPI_ROWS_END
        }
    }
};
struct EpiO1b { static constexpr bool PERM = true, AFTER_DRAIN = false;
    const float* ssq; const bf16_t* HC; bf16_t* MIX;
    __device__ __forceinline__ void operator()(const f32x4 (&acc)[2][2][4][2], const Unit& u, int wr, int wc, int fr, int fq) const {
        const int rowb = u.pm * BM + wr * 64 + fr, ch0 = u.pn * 128 + wc * 32 + 8 * fq;
        EPI_ROWS_BEGIN
            const float rs = rstd16(ssq + (size_t)row * 16);
            float hv[8]; unpack8(*(const u32x4*)(HC + (size_t)row * 2048 + ch0), hv);
            float o[8];
#pragma unroll
            for (int j = 0; j < 8; ++j) { const float oo = acc[ai][0][m][j >> 2][j & 3] * rs, zz = acc[ai][1][m][j >> 2][j & 3] * rs; o[j] = hv[j] * sigmoidf_(oo) * siluf_(zz); }
            *(u32x4*)(MIX + (size_t)row * 2048 + ch0) = pack8(o);
        EPI_ROWS_END
    }
};
struct EpiOut { static constexpr bool PERM = true, AFTER_DRAIN = false;
    bf16_t* Y; float* SSQ;
    __device__ __forceinline__ void operator()(const f32x4 (&acc)[2][2][4][2], const Unit& u, int wr, int wc, int fr, int fq) const {
        const int rowb = u.pm * BM + wr * 64 + fr, cw = wc * 32 + 8 * fq;
        EPI_ROWS_BEGIN
            float s = 0.f;
#pragma unroll
            for (int bj = 0; bj < 2; ++bj) { const f32x4 v0 = acc[ai][bj][m][0], v1 = acc[ai][bj][m][1];
                s += (v0[0] * v0[0] + v0[1] * v0[1]) + (v0[2] * v0[2] + v0[3] * v0[3]) + (v1[0] * v1[0] + v1[1] * v1[1]) + (v1[2] * v1[2] + v1[3] * v1[3]);
                u32x4 w; w.x = cvt_pk_bf16(v0[0], v0[1]); w.y = cvt_pk_bf16(v0[2], v0[3]); w.z = cvt_pk_bf16(v1[0], v1[1]); w.w = cvt_pk_bf16(v1[2], v1[3]);
                *(u32x4*)(Y + (size_t)row * 1024 + u.pn * 256 + bj * HALF + cw) = w; }
            s += __shfl_xor(s, 16); s += __shfl_xor(s, 32);
            if (fq == 0) SSQ[(size_t)row * 16 + u.pn * 4 + wc] = s;
        EPI_ROWS_END
    }
};
struct EpiPw { static constexpr bool PERM = true, AFTER_DRAIN = false;
    bf16_t* PW;
    __device__ __forceinline__ void operator()(const f32x4 (&acc)[2][2][4][2], const Unit& u, int wr, int wc, int fr, int fq) const {
        const int rowb = u.pm * BM + wr * 64 + fr, cw = wc * 32 + 8 * fq;
        EPI_ROWS_BEGIN
#pragma unroll
            for (int bj = 0; bj < 2; ++bj) { const f32x4 v0 = acc[ai][bj][m][0], v1 = acc[ai][bj][m][1];
                u32x4 w; w.x = cvt_pk_bf16(v0[0], v0[1]); w.y = cvt_pk_bf16(v0[2], v0[3]); w.z = cvt_pk_bf16(v1[0], v1[1]); w.w = cvt_pk_bf16(v1[2], v1[3]);
                *(u32x4*)(PW + (size_t)row * 1024 + u.pn * 256 + bj * HALF + cw) = w; }
        EPI_ROWS_END
    }
};
struct EpiGate { static constexpr bool PERM = true, AFTER_DRAIN = false;
    const float* RSTD1; const bf16_t* PW; float* H; bf16_t* HB; float* SSQ;
    __device__ __forceinline__ void operator()(const f32x4 (&acc)[2][2][4][2], const Unit& u, int wr, int wc, int fr, int fq) const {
        const int rowb = u.pm * BM + wr * 64 + fr, cw = wc * 32 + 8 * fq;
        EPI_ROWS_BEGIN
            const float rs = RSTD1[row]; float s = 0.f;
#pragma unroll
            for (int bj = 0; bj < 2; ++bj) { const size_t off = (size_t)row * 1024 + u.pn * 256 + bj * HALF + cw;
                float pw[8]; unpack8(*(const u32x4*)(PW + off), pw);
                const f32x4 h0 = *(const f32x4*)(H + off), h1 = *(const f32x4*)(H + off + 4);
                float o[8];
#pragma unroll
                for (int j = 0; j < 8; ++j) { const float g = sigmoidf_(acc[ai][bj][m][j >> 2][j & 3] * rs); o[j] = (j < 4 ? h0[j & 3] : h1[j & 3]) + g * pw[j]; s += o[j] * o[j]; }
                *(f32x4*)(H + off) = (f32x4){o[0], o[1], o[2], o[3]}; *(f32x4*)(H + off + 4) = (f32x4){o[4], o[5], o[6], o[7]};
                *(u32x4*)(HB + off) = pack8(o); }
            s += __shfl_xor(s, 16); s += __shfl_xor(s, 32);
            if (fq == 0) SSQ[(size_t)row * 16 + u.pn * 4 + wc] = s;
        EPI_ROWS_END
    }
};
}

struct MapE1a { __device__ __forceinline__ int operator()(int np, float& sc) const { sc = 1.f; const int t = np >> 8; if (t < 8) { const int bj = (np >> 7) & 1, c = np & 127; return (bj ? 2048 : 1024) + t * 128 + c; } return 5120 + (np - 2048); } };
struct MapE1b { __device__ __forceinline__ int operator()(int np, float& sc) const { sc = 1.f; const int t = np >> 8, bj = (np >> 7) & 1, c = np & 127; if (t < 8) return (bj ? 3072 : 0) + t * 128 + c; return (bj ? 6144 : 4096) + (t - 8) * 128 + c; } };
struct MapO1a { __device__ __forceinline__ int operator()(int np, float& sc) const { sc = (np < 1024) ? 0.08838834764831845f : 1.f; if (np < 4096) return np; const int c = np - 4096; return c < 16 ? 8192 + c : -1; } };
struct MapO1b { __device__ __forceinline__ int operator()(int np, float& sc) const { sc = 1.f; const int t = np >> 8, bj = (np >> 7) & 1, c = np & 127; return (bj ? 6144 : 4096) + t * 128 + c; } };
struct MapId  { __device__ __forceinline__ int operator()(int np, float& sc) const { sc = 1.f; return np; } };
template <class F> __device__ __forceinline__ void conv_w(bf16_t* dst, const float* src, int K, int Nsrc, int Nrows, const float* gk, F map, int gt, int nth) {
    const int total = Nrows * (K >> 3);
    for (int idx = gt; idx < total; idx += nth) {
        const int np = idx % Nrows, k8 = idx / Nrows; float sc; const int n = map(np, sc);
        float v[8];
#pragma unroll
        for (int j = 0; j < 8; ++j) { const int k = k8 * 8 + j; v[j] = (n >= 0) ? src[(size_t)k * Nsrc + n] * (gk ? gk[k] : 1.f) * sc : 0.f; }
        *(u32x4*)(dst + (size_t)np * K + k8 * 8) = pack8(v);
    }
}

struct Ptrs { float* out; unsigned char* ws; };
template <int I> __device__ __forceinline__ const float* inp_() {
    const unsigned long long ka = (unsigned long long)__builtin_amdgcn_kernarg_segment_ptr(); unsigned long long v;
    asm volatile("s_load_dwordx2 %0, %1, %2\n\ts_waitcnt lgkmcnt(0)" : "=s"(v) : "s"(ka), "n"(I * 8) : "memory");
    return (const float*)v;
}
#define INP(i) (inp_<i>())
#define LAS3 __attribute__((address_space(3)))

__device__ __forceinline__ void prep_layer_weights(const Ptrs& P, int L, int gt, int nth) {
    const int j = L >> 1; bf16_t* WIN = (bf16_t*)(P.ws + WS_WIN); bf16_t* WOUT = (bf16_t*)(P.ws + WS_WOUT);
    const float* pre_g = INP(2) + (size_t)L * DM;
    if ((L & 1) == 0) {
        const float* w = INP(7) + (size_t)j * DM * EVEN_IN;
        conv_w(WIN, w, DM, EVEN_IN, N1A_E, pre_g, MapE1a(), gt, nth);
        conv_w(WIN + (size_t)N1A_E * DM, w, DM, EVEN_IN, N1B_E, pre_g, MapE1b(), gt, nth);
        conv_w(WOUT, INP(13) + (size_t)j * 2048 * DM, 2048, DM, DM, nullptr, MapId(), gt, nth);
        { const float* wsrc = INP(11) + (size_t)j * 8 * 16384; bf16_t* WSB = (bf16_t*)(P.ws + WS_WSB);
          for (int i = gt; i < 8 * 16384 / 8; i += nth) { const int e = i * 8, t = (e >> 7) & 127, s0 = e & 127;
              const f32x4 a = *(const f32x4*)(wsrc + e), b = *(const f32x4*)(wsrc + e + 4); float o[8] = {a[0], a[1], a[2], a[3], b[0], b[1], b[2], b[3]};
#pragma unroll
              for (int q = 0; q < 8; ++q) if (s0 + q > t) o[q] = 0.f;
              *(u32x4*)(WSB + e) = pack8(o); } }
    } else {
        const float* w = INP(14) + (size_t)j * DM * ODD_IN;
        conv_w(WIN, w, DM, ODD_IN, N1A_O, pre_g, MapO1a(), gt, nth);
        conv_w(WIN + (size_t)N1A_O * DM, w, DM, ODD_IN, N1B_O, pre_g, MapO1b(), gt, nth);
        conv_w(WOUT, INP(17) + (size_t)j * 2048 * DM, 2048, DM, DM, nullptr, MapId(), gt, nth);
    }
}

__device__ __forceinline__ void phase_prologue(const Ptrs& P, int G, int bid, int tid) {
    const int lane = tid & 63, wid = tid >> 6;
    const float* x = INP(0); bf16_t* HBA = (bf16_t*)(P.ws + WS_HBA); float* SSQA = (float*)(P.ws + WS_SSQA);
    for (int row = bid * 8 + wid; row < M; row += G * 8) {
        float sq = 0.f;
#pragma unroll
        for (int i = 0; i < 2; ++i) { const size_t off = (size_t)row * DM + i * 512 + lane * 8;
            const f32x4 a = *(const f32x4*)(x + off), b = *(const f32x4*)(x + off + 4);
            const float o[8] = {a[0], a[1], a[2], a[3], b[0], b[1], b[2], b[3]};
#pragma unroll
            for (int j = 0; j < 8; ++j) sq += o[j] * o[j];
            *(u32x4*)(HBA + off) = pack8(o); }
        sq = wave_sum(sq);
        if (lane < 16) SSQA[(size_t)row * 16 + lane] = (lane == 0) ? sq : 0.f;
    }
    const int gt = bid * 512 + tid, nth = G * 512;
    for (int L = 0; L < DEPTH; ++L) {
        conv_w((bf16_t*)(P.ws + WS_WG) + (size_t)L * DM * DM, INP(6) + (size_t)L * DM * DM, DM, DM, DM, INP(4) + (size_t)L * DM, MapId(), gt, nth);
        conv_w((bf16_t*)(P.ws + WS_WP) + (size_t)L * DM * PLE, INP(5) + (size_t)L * PLE * DM, PLE, DM, DM, nullptr, MapId(), gt, nth);
    }
    prep_layer_weights(P, 0, gt, nth);
}

__device__ __forceinline__ void phase_p4(const Ptrs& P, int L, int G, int bid, int tid) {
    const int lane = tid & 63, wid = tid >> 6;
    const float* hin = (L == 0) ? INP(0) : P.out; float* H = P.out;
    const bf16_t* Y = (const bf16_t*)(P.ws + WS_R1); const float* SSQY = (const float*)(P.ws + WS_SSQY);
    bf16_t* HBB = (bf16_t*)(P.ws + WS_R3); float* RSTD1 = (float*)(P.ws + WS_RSTD1);
    const float* pg = INP(3) + (size_t)L * DM;
    f32x4 g[2][2];
#pragma unroll
    for (int i = 0; i < 2; ++i) { g[i][0] = *(const f32x4*)(pg + i * 512 + lane * 8); g[i][1] = *(const f32x4*)(pg + i * 512 + lane * 8 + 4); }
    for (int row = bid * 8 + wid; row < M; row += G * 8) {
        float s = (lane < 16) ? SSQY[(size_t)row * 16 + lane] : 0.f;
        s = wave_sum(s);
        const float rsy = rsqrtf(s * (1.0f / 1024.0f) + EPS);
        float sq = 0.f;
#pragma unroll
        for (int i = 0; i < 2; ++i) { const size_t off = (size_t)row * DM + i * 512 + lane * 8;
            float yv[8]; unpack8(*(const u32x4*)(Y + off), yv);
            const f32x4 a = *(const f32x4*)(hin + off), b = *(const f32x4*)(hin + off + 4);
            float o[8];
#pragma unroll
            for (int j = 0; j < 8; ++j) { o[j] = (j < 4 ? a[j & 3] : b[j & 3]) + yv[j] * rsy * g[i][j >> 2][j & 3]; sq += o[j] * o[j]; }
            *(f32x4*)(H + off) = (f32x4){o[0], o[1], o[2], o[3]}; *(f32x4*)(H + off + 4) = (f32x4){o[4], o[5], o[6], o[7]};
            *(u32x4*)(HBB + off) = pack8(o); }
        sq = wave_sum(sq);
        if (lane == 0) RSTD1[row] = rsqrtf(sq * (1.0f / 1024.0f) + EPS);
    }
    const int gt = bid * 512 + tid, nth = G * 512;
    const float* pl = INP(1) + (size_t)L * M * PLE; bf16_t* PB = (bf16_t*)(P.ws + WS_R3 + 64 * MiB);
    for (int i = gt; i < M * PLE / 8; i += nth) { const f32x4 a = *(const f32x4*)(pl + (size_t)i * 8), b = *(const f32x4*)(pl + (size_t)i * 8 + 4);
        const float o[8] = {a[0], a[1], a[2], a[3], b[0], b[1], b[2], b[3]}; *(u32x4*)(PB + (size_t)i * 8) = pack8(o); }
    if (L + 1 < DEPTH) prep_layer_weights(P, L + 1, gt, nth);
}

typedef short bf16x8 __attribute__((ext_vector_type(8)));
typedef short s16x4 __attribute__((ext_vector_type(4)));
typedef float f32x16 __attribute__((ext_vector_type(16)));
__device__ __forceinline__ bf16x8 tr_frag(const LAS3 unsigned char* img, int a0, int a1) {
    const s16x4 x = __builtin_amdgcn_ds_read_tr16_b64_v4i16((LAS3 s16x4*)(img + a0)), y = __builtin_amdgcn_ds_read_tr16_b64_v4i16((LAS3 s16x4*)(img + a1));
    return (bf16x8){x[0], x[1], x[2], x[3], y[0], y[1], y[2], y[3]};
}
constexpr int RS_K = 272, RS_V = 576, RS_KW = 320;

__device__ __forceinline__ void gm_stage_load(u32x4 (&vq)[4], const bf16_t* BV, int r0, int g, int tid) {
#pragma unroll
    for (int i = 0; i < 4; ++i) { const int e8 = tid + 512 * i, s = e8 >> 4, c8 = e8 & 15; vq[i] = *(const u32x4*)(BV + (size_t)(r0 + s) * 1024 + g * 128 + c8 * 8); }
}
__device__ __forceinline__ void gm_stage_store(const u32x4 (&vq)[4], LAS3 unsigned char* img, const LAS3 float* mu, const LAS3 float* rsd, const float* lg, const float* lb, int g, int tid) {
#pragma unroll
    for (int i = 0; i < 4; ++i) { const int e8 = tid + 512 * i, s = e8 >> 4, c8 = e8 & 15;
        float x[8]; unpack8(vq[i], x); const float m_ = mu[s], r_ = rsd[s];
        const f32x4 g0 = *(const f32x4*)(lg + g * 128 + c8 * 8), g1 = *(const f32x4*)(lg + g * 128 + c8 * 8 + 4), b0 = *(const f32x4*)(lb + g * 128 + c8 * 8), b1 = *(const f32x4*)(lb + g * 128 + c8 * 8 + 4);
#pragma unroll
        for (int q = 0; q < 8; ++q) x[q] = (x[q] - m_) * r_ * (q < 4 ? g0[q & 3] : g1[q & 3]) + (q < 4 ? b0[q & 3] : b1[q & 3]);
        *(LAS3 u32x4*)(img + s * RS_KW + c8 * 16) = pack8(x); }
}
__device__ __forceinline__ void phase_gm(LAS3 unsigned char* lds, const Ptrs& P, int j, int G, int bid, int tid_in) {
    LAS3 float* mu = (LAS3 float*)(lds + 81920); LAS3 float* rsd = mu + 128;
    const bf16_t* BV = (const bf16_t*)(P.ws + WS_R2); bf16_t* S = (bf16_t*)(P.ws + WS_R3); const bf16_t* WSB = (const bf16_t*)(P.ws + WS_WSB);
    const float* bs = INP(12) + (size_t)j * 128 * 8;
    const float* lg = INP(9) + (size_t)j * 1024; const float* lb = INP(10) + (size_t)j * 1024;
    for (int c = bid; c < M / 128; c += G) {
        int tid = tid_in; asm volatile("" : "+v"(tid));
        const int lane = tid & 63, wid = __builtin_amdgcn_readfirstlane(tid >> 6), hh = lane >> 5, l31 = lane & 31, tb = wid & 3, chf = wid >> 2;
        const int r0 = c * 128;
        u32x4 vq[4];
        gm_stage_load(vq, BV, r0, 0, tid);
#pragma unroll 2
        for (int rr = 0; rr < 16; ++rr) { const int row = wid * 16 + rr; const bf16_t* p = BV + (size_t)(r0 + row) * 1024;
            float a[8], b[8]; unpack8(*(const u32x4*)(p + lane * 8), a); unpack8(*(const u32x4*)(p + 512 + lane * 8), b);
            float s = 0.f;
#pragma unroll
            for (int q = 0; q < 8; ++q) s += a[q] + b[q];
            s = wave_sum(s); const float mean = s * (1.0f / 1024.0f); float v = 0.f;
#pragma unroll
            for (int q = 0; q < 8; ++q) { const float d0 = a[q] - mean, d1 = b[q] - mean; v += d0 * d0 + d1 * d1; }
            v = wave_sum(v);
            if (lane == 0) { mu[row] = mean; rsd[row] = rsqrtf(v * (1.0f / 1024.0f) + EPS); } }
        __syncthreads();
        gm_stage_store(vq, lds, mu, rsd, lg, lb, 0, tid);
        __syncthreads();
        const int blk = (lane >> 4) & 1, q4 = (lane & 15) >> 2, p4 = lane & 3;
        const int trk = (q4 + 8 * hh) * RS_KW + (chf * 64 + 16 * blk + 4 * p4) * 2;
#pragma unroll 1
        for (int g = 0; g < 8; ++g) {
            LAS3 unsigned char* cur = lds + (g & 1) * 40960; LAS3 unsigned char* nxt = lds + ((g & 1) ^ 1) * 40960;
            if (g < 7) gm_stage_load(vq, BV, r0, g + 1, tid);
            f32x16 acc[2];
#pragma unroll
            for (int cb = 0; cb < 2; ++cb)
#pragma unroll
                for (int r = 0; r < 16; ++r) acc[cb][r] = 0.f;
            const bf16_t* wrow = WSB + (size_t)g * 16384 + (size_t)(tb * 32 + l31) * 128 + 8 * hh;
#pragma unroll
            for (int ks = 0; ks < 8; ++ks) {
                if (ks <= 2 * tb + 1) {
                    const bf16x8 af = *(const bf16x8*)(wrow + 16 * ks);
#pragma unroll
                    for (int cb = 0; cb < 2; ++cb) { const bf16x8 bfr = tr_frag(cur, trk + 16 * ks * RS_KW + cb * 64, trk + (16 * ks + 4) * RS_KW + cb * 64);
                        acc[cb] = __builtin_amdgcn_mfma_f32_32x32x16_bf16(af, bfr, acc[cb], 0, 0, 0); }
                }
            }
#pragma unroll
            for (int r = 0; r < 16; ++r) { const int t = tb * 32 + (r & 3) + 8 * (r >> 2) + 4 * hh; const float bt = bs[t * 8 + g];
#pragma unroll
                for (int cb = 0; cb < 2; ++cb) S[(size_t)(r0 + t) * 1024 + g * 128 + chf * 64 + cb * 32 + l31] = f2bf(acc[cb][r] + bt); }
            if (g < 7) gm_stage_store(vq, nxt, mu, rsd, lg, lb, g + 1, tid);
            __syncthreads();
        }
    }
}

__device__ __forceinline__ void phase_o2(LAS3 unsigned char* lds, const Ptrs& P, int j, int G, int bid, int tid_in) {
    LAS3 unsigned char* KW = lds; LAS3 unsigned char* VI = lds + 40960; LAS3 float* sc = (LAS3 float*)(lds + 40960 + 73728); LAS3 float* wv = sc + 128;
    const bf16_t* Kb = (const bf16_t*)(P.ws + WS_R2); const bf16_t* Vb = (const bf16_t*)(P.ws + WS_R3);
    const float* GATE = (const float*)(P.ws + WS_GATE); float* GB = (float*)(P.ws + WS_GB); float* CS = (float*)(P.ws + WS_CS);
    bf16_t* UC = (bf16_t*)(P.ws + WS_R4); float* NS = (float*)(P.ws + WS_NS);
    const float* bif = INP(15) + (size_t)j * 16;
    for (int unit = bid; unit < NUNIT_O; unit += G) {
        int tid = tid_in; asm volatile("" : "+v"(tid));
        const int lane = tid & 63, wid = __builtin_amdgcn_readfirstlane(tid >> 6), hh = lane >> 5, l31 = lane & 31;
        const int chain = unit >> 7, n = unit & 127, b = chain >> 3, h = chain & 7, r0 = b * SEQ + n * 128;
        u32x4 kq[4], vq[8];
#pragma unroll
        for (int i = 0; i < 4; ++i) { const int e8 = tid + 512 * i, s = e8 >> 4, k8 = e8 & 15; kq[i] = *(const u32x4*)(Kb + (size_t)(r0 + s) * 1024 + h * 128 + k8 * 8); }
#pragma unroll
        for (int i = 0; i < 8; ++i) { const int e8 = tid + 512 * i, s = e8 >> 5, v8 = e8 & 31; vq[i] = *(const u32x4*)(Vb + (size_t)(r0 + s) * 2048 + h * 256 + v8 * 8); }
        float ii = 0.f, a = 0.f;
        if (tid < 128) { const float fi = GATE[(size_t)(r0 + tid) * 16 + 8 + h] + bif[8 + h]; ii = GATE[(size_t)(r0 + tid) * 16 + h] + bif[h]; sc[tid] = logsigmoidf_(fi); }
        __syncthreads();
        for (int off = 1; off < 128; off <<= 1) { float v = 0.f; if (tid < 128) v = sc[tid] + (tid >= off ? sc[tid - off] : 0.f); __syncthreads(); if (tid < 128) sc[tid] = v; __syncthreads(); }
        const float gtot = sc[127];
        if (tid < 128) { a = gtot - sc[tid] + ii; wv[tid] = a; GB[((size_t)(r0 + tid) * 8 + h) * 2] = sc[tid]; GB[((size_t)(r0 + tid) * 8 + h) * 2 + 1] = ii; }
        __syncthreads();
        float amax = -3.0e38f;
#pragma unroll 8
        for (int t = 0; t < 128; ++t) amax = fmaxf(amax, wv[t]);
        __syncthreads();
        if (tid < 128) wv[tid] = __expf(a - amax);
        if (tid == 0) { CS[(size_t)unit * 2] = gtot; CS[(size_t)unit * 2 + 1] = amax; }
        __syncthreads();
#pragma unroll
        for (int i = 0; i < 4; ++i) { const int e8 = tid + 512 * i, s = e8 >> 4, k8 = e8 & 15;
            float kv[8]; unpack8(kq[i], kv); const float w = wv[s];
#pragma unroll
            for (int q = 0; q < 8; ++q) kv[q] *= w;
            *(LAS3 u32x4*)(KW + s * RS_KW + k8 * 16) = pack8(kv); }
#pragma unroll
        for (int i = 0; i < 8; ++i) { const int e8 = tid + 512 * i, s = e8 >> 5, v8 = e8 & 31; *(LAS3 u32x4*)(VI + s * RS_V + v8 * 16) = vq[i]; }
        __syncthreads();
        {
            const int blk = (lane >> 4) & 1, q = (lane & 15) >> 2, p = lane & 3;
            const int trv = (q + 8 * hh) * RS_V + (wid * 32 + 16 * blk + 4 * p) * 2, trk = (q + 8 * hh) * RS_KW + (16 * blk + 4 * p) * 2;
            f32x16 acc[4];
#pragma unroll
            for (int db = 0; db < 4; ++db)
#pragma unroll
                for (int r = 0; r < 16; ++r) acc[db][r] = 0.f;
#pragma unroll
            for (int ks = 0; ks < 8; ++ks) {
                const bf16x8 af = tr_frag(VI, trv + 16 * ks * RS_V, trv + (16 * ks + 4) * RS_V);
#pragma unroll
                for (int db = 0; db < 4; ++db) { const bf16x8 bfr = tr_frag(KW, trk + 16 * ks * RS_KW + db * 64, trk + (16 * ks + 4) * RS_KW + db * 64);
                    acc[db] = __builtin_amdgcn_mfma_f32_32x32x16_bf16(af, bfr, acc[db], 0, 0, 0); }
            }
            bf16_t* up = UC + (size_t)unit * 32768;
#pragma unroll
            for (int db = 0; db < 4; ++db)
#pragma unroll
                for (int r = 0; r < 16; ++r) { const int v = wid * 32 + (r & 3) + 8 * (r >> 2) + 4 * hh; up[v * 128 + db * 32 + l31] = f2bf(acc[db][r]); }
        }
        if (tid < 128) { float ns = 0.f;
#pragma unroll 8
            for (int s = 0; s < 128; ++s) ns += bf2f(*(const LAS3 bf16_t*)(KW + s * RS_KW + tid * 2));
            NS[(size_t)unit * 128 + tid] = ns; }
        __syncthreads();
    }
}

__device__ __forceinline__ void phase_o3(LAS3 unsigned char* lds, const Ptrs& P, int G, int bid, int tid) {
    LAS3 float* dec = (LAS3 float*)lds; LAS3 float* scl = dec + 128; LAS3 float* gg = scl + 128; LAS3 float* am = gg + 128;
    const float* CS = (const float*)(P.ws + WS_CS); float* MS = (float*)(P.ws + WS_MS); bf16_t* UC = (bf16_t*)(P.ws + WS_R4); float* NS = (float*)(P.ws + WS_NS);
    for (int task = bid; task < 256; task += G) {
        const int chain = task >> 4, eb = task & 15;
        if (tid < 128) { gg[tid] = CS[((size_t)chain * 128 + tid) * 2]; am[tid] = CS[((size_t)chain * 128 + tid) * 2 + 1]; }
        __syncthreads();
        if (tid == 0) { float m = 0.f;
            for (int n = 0; n < 128; ++n) { const float g = gg[n], a = am[n], mn = fmaxf(g + m, a); dec[n] = __expf(g + m - mn); scl[n] = __expf(a - mn); if (eb == 0) MS[chain * 128 + n] = m; m = mn; } }
        __syncthreads();
        const size_t e = (size_t)eb * 2048 + tid * 4;
        float c0 = 0.f, c1 = 0.f, c2 = 0.f, c3 = 0.f;
        for (int n0 = 0; n0 < 128; n0 += 8) {
            u32x2 u[8];
#pragma unroll
            for (int q = 0; q < 8; ++q) u[q] = *(const u32x2*)(UC + ((size_t)chain * 128 + n0 + q) * 32768 + e);
#pragma unroll
            for (int q = 0; q < 8; ++q) { u32x2 w; w.x = pk2(c0, c1); w.y = pk2(c2, c3); *(u32x2*)(UC + ((size_t)chain * 128 + n0 + q) * 32768 + e) = w;
                const float d = dec[n0 + q], s = scl[n0 + q];
                c0 = d * c0 + s * __uint_as_float(u[q].x << 16); c1 = d * c1 + s * __uint_as_float(u[q].x & 0xffff0000u);
                c2 = d * c2 + s * __uint_as_float(u[q].y << 16); c3 = d * c3 + s * __uint_as_float(u[q].y & 0xffff0000u); }
        }
        if (eb == 0 && tid < 128) { float cn = 0.f;
            for (int n = 0; n < 128; ++n) { const size_t o = ((size_t)chain * 128 + n) * 128 + tid; const float v = NS[o]; NS[o] = cn; cn = dec[n] * cn + scl[n] * v; } }
        __syncthreads();
    }
}


__device__ __forceinline__ void phase_o4(LAS3 unsigned char* lds, const Ptrs& P, int j, int G, int bid, int tid_in) {
    LAS3 unsigned char* RA = lds;
    LAS3 unsigned char* RB = lds + 73728;
    LAS3 float* bb = (LAS3 float*)(lds + 143360); LAS3 float* cc = bb + 128; LAS3 float* MM = cc + 128; LAS3 float* isc = MM + 128; LAS3 float* nst = isc + 128; LAS3 float* red = nst + 128;
    const bf16_t* Qb = (const bf16_t*)(P.ws + WS_R1); const bf16_t* Kb = (const bf16_t*)(P.ws + WS_R2); bf16_t* Vb = (bf16_t*)(P.ws + WS_R3);
    const bf16_t* UC = (const bf16_t*)(P.ws + WS_R4); const float* NS = (const float*)(P.ws + WS_NS); const float* MS = (const float*)(P.ws + WS_MS); const float* GB = (const float*)(P.ws + WS_GB);
    const float* mhg = INP(16) + (size_t)j * 8 * 256;
    for (int unit = bid; unit < NUNIT_O; unit += G) {
        int tid = tid_in; asm volatile("" : "+v"(tid));
        const int lane = tid & 63, wid = __builtin_amdgcn_readfirstlane(tid >> 6), hh = lane >> 5, l31 = lane & 31, tb = wid & 3, vh = wid >> 2;
        const int chain = unit >> 7, n = unit & 127, b = chain >> 3, h = chain & 7, r0 = b * SEQ + n * 128;
        const float mst = MS[chain * 128 + n];
        const int t = tb * 32 + l31;
        {
            u32x4 kq[4], cq[8];
#pragma unroll
            for (int i = 0; i < 4; ++i) { const int e8 = tid + 512 * i, s = e8 >> 4, k8 = e8 & 15; kq[i] = *(const u32x4*)(Kb + (size_t)(r0 + s) * 1024 + h * 128 + k8 * 8); }
#pragma unroll
            for (int i = 0; i < 8; ++i) { const int e8 = tid + 512 * i; cq[i] = *(const u32x4*)(UC + (size_t)unit * 32768 + (size_t)e8 * 8); }
            if (tid < 128) { const float bv = GB[((size_t)(r0 + tid) * 8 + h) * 2], iv = GB[((size_t)(r0 + tid) * 8 + h) * 2 + 1]; bb[tid] = bv; cc[tid] = iv - bv; nst[tid] = NS[(size_t)unit * 128 + tid]; }
#pragma unroll
            for (int i = 0; i < 4; ++i) { const int e8 = tid + 512 * i, s = e8 >> 4, k8 = e8 & 15; *(LAS3 u32x4*)(RA + s * RS_K + k8 * 16) = kq[i]; }
#pragma unroll
            for (int i = 0; i < 8; ++i) { const int e8 = tid + 512 * i, v = e8 >> 4, k8 = e8 & 15; *(LAS3 u32x4*)(RB + v * RS_K + k8 * 16) = cq[i]; }
        }
        bf16x8 qf[8];
#pragma unroll
        for (int ks = 0; ks < 8; ++ks) qf[ks] = *(const bf16x8*)(Qb + (size_t)(r0 + t) * 1024 + h * 128 + 16 * ks + 8 * hh);
        __syncthreads();
        if (tid < 128) { float mx = mst;
#pragma unroll 1
            for (int s = 0; s <= tid; ++s) mx = fmaxf(mx, cc[s]);
            MM[tid] = mx; isc[tid] = __expf(mst - mx); }
        f32x16 accS[4], acc[4];
#pragma unroll
        for (int sb = 0; sb < 4; ++sb) {
#pragma unroll
            for (int r = 0; r < 16; ++r) accS[sb][r] = 0.f;
            if (sb <= tb) {
#pragma unroll
                for (int ks = 0; ks < 8; ++ks) { const bf16x8 af = *(const LAS3 bf16x8*)(RA + (sb * 32 + l31) * RS_K + (16 * ks + 8 * hh) * 2); accS[sb] = __builtin_amdgcn_mfma_f32_32x32x16_bf16(af, qf[ks], accS[sb], 0, 0, 0); }
            }
        }
#pragma unroll
        for (int vb = 0; vb < 4; ++vb) {
#pragma unroll
            for (int r = 0; r < 16; ++r) acc[vb][r] = 0.f;
#pragma unroll
            for (int ks = 0; ks < 8; ++ks) { const bf16x8 af = *(const LAS3 bf16x8*)(RB + ((vh * 4 + vb) * 32 + l31) * RS_K + (16 * ks + 8 * hh) * 2); acc[vb] = __builtin_amdgcn_mfma_f32_32x32x16_bf16(af, qf[ks], acc[vb], 0, 0, 0); }
        }
        float qn = 0.f;
#pragma unroll
        for (int ks = 0; ks < 8; ++ks) { const f32x4 n0 = *(const LAS3 f32x4*)&nst[16 * ks + 8 * hh], n1 = *(const LAS3 f32x4*)&nst[16 * ks + 8 * hh + 4];
            float qv[8]; unpack8(__builtin_bit_cast(u32x4, qf[ks]), qv);
            qn += (qv[0] * n0[0] + qv[1] * n0[1]) + (qv[2] * n0[2] + qv[3] * n0[3]) + (qv[4] * n1[0] + qv[5] * n1[1]) + (qv[6] * n1[2] + qv[7] * n1[3]); }
        qn += __shfl_xor(qn, 32);
        __syncthreads();
        u32x4 vq[8];
#pragma unroll
        for (int i = 0; i < 8; ++i) { const int e8 = tid + 512 * i, s = e8 >> 5, v8 = e8 & 31; vq[i] = *(const u32x4*)(Vb + (size_t)(r0 + s) * 2048 + h * 256 + v8 * 8); }
        const float MMt = MM[t], isct = isc[t];
        bf16x8 pf[8]; float dsum = 0.f;
#pragma unroll
        for (int sb = 0; sb < 4; ++sb) {
            u32x4 w0 = (u32x4){0u, 0u, 0u, 0u}, w1 = (u32x4){0u, 0u, 0u, 0u};
            if (sb <= tb) {
                float pv[16];
#pragma unroll
                for (int rg = 0; rg < 4; ++rg) { const f32x4 c4 = *(const LAS3 f32x4*)&cc[sb * 32 + 8 * rg + 4 * hh];
#pragma unroll
                    for (int e = 0; e < 4; ++e) { const int s = sb * 32 + 8 * rg + 4 * hh + e; const float pvv = (s <= t) ? __expf(c4[e] - MMt) * accS[sb][rg * 4 + e] : 0.f; pv[rg * 4 + e] = pvv; dsum += pvv; } }
                w0.x = pk2(pv[0], pv[1]); w0.y = pk2(pv[2], pv[3]); w0.z = pk2(pv[4], pv[5]); w0.w = pk2(pv[6], pv[7]);
                w1.x = pk2(pv[8], pv[9]); w1.y = pk2(pv[10], pv[11]); w1.z = pk2(pv[12], pv[13]); w1.w = pk2(pv[14], pv[15]);
            }
            pf[2 * sb] = __builtin_bit_cast(bf16x8, w0); pf[2 * sb + 1] = __builtin_bit_cast(bf16x8, w1);
        }
#pragma unroll
        for (int vb = 0; vb < 4; ++vb)
#pragma unroll
            for (int r = 0; r < 16; ++r) acc[vb][r] *= isct;
#pragma unroll
        for (int i = 0; i < 8; ++i) { const int e8 = tid + 512 * i, s = e8 >> 5, v8 = e8 & 31; *(LAS3 u32x4*)(RA + s * RS_V + v8 * 16) = vq[i]; }
        __syncthreads();
        {
            const int blk = (lane >> 4) & 1, q = (lane & 15) >> 2, p = lane & 3;
            const int trv = (q + 4 * hh) * RS_V + (vh * 128 + 16 * blk + 4 * p) * 2;
#pragma unroll
            for (int sp = 0; sp < 8; ++sp) {
                if (sp <= 2 * tb + 1) {
#pragma unroll
                    for (int vb = 0; vb < 4; ++vb) { const bf16x8 af = tr_frag(RA, trv + 16 * sp * RS_V + vb * 64, trv + (16 * sp + 8) * RS_V + vb * 64);
                        acc[vb] = __builtin_amdgcn_mfma_f32_32x32x16_bf16(af, pf[sp], acc[vb], 0, 0, 0); }
                }
            }
        }
        dsum += __shfl_xor(dsum, 32);
        const float den = isct * qn + dsum, dn = fmaxf(fabsf(den), __expf(-(bb[t] + MMt))), inv = 1.0f / dn;
        float ssq = 0.f;
#pragma unroll
        for (int vb = 0; vb < 4; ++vb)
#pragma unroll
            for (int r = 0; r < 16; ++r) { acc[vb][r] *= inv; ssq += acc[vb][r] * acc[vb][r]; }
        ssq += __shfl_xor(ssq, 32);
        if (hh == 0) red[t * 2 + vh] = ssq;
        __syncthreads();
        const float rn = rsqrtf((red[t * 2] + red[t * 2 + 1]) * (1.0f / 256.0f) + EPS);
#pragma unroll
        for (int vb = 0; vb < 4; ++vb)
#pragma unroll
            for (int rg = 0; rg < 4; ++rg) { const int v0 = (vh * 4 + vb) * 32 + 8 * rg + 4 * hh; const f32x4 g4 = *(const f32x4*)(mhg + h * 256 + v0);
                u32x2 w; w.x = pk2(acc[vb][rg * 4 + 0] * rn * g4[0], acc[vb][rg * 4 + 1] * rn * g4[1]); w.y = pk2(acc[vb][rg * 4 + 2] * rn * g4[2], acc[vb][rg * 4 + 3] * rn * g4[3]);
                *(u32x2*)(Vb + (size_t)(r0 + t) * 2048 + h * 256 + v0) = w; }
        __syncthreads();
    }
}

constexpr int NPHASE = 1 + 8 * DEPTH;
__host__ __device__ constexpr bool phase_exists(int ph) { return ph == 0 || !((((ph - 1) >> 3) & 1) == 0 && (((ph - 1) & 7) == 2 || ((ph - 1) & 7) == 3)); }
struct Args { const float* in[18]; float* out; unsigned char* ws; int ph_lo, ph_hi; };

__global__ void __launch_bounds__(512, 2) fwd(Args args) {
    extern __shared__ __attribute__((aligned(16))) unsigned char lds_raw[];
    LAS3 unsigned char* lds = (LAS3 unsigned char*)lds_raw;
    const int tid0 = threadIdx.x, bid = blockIdx.x, G = gridDim.x;
    Ptrs P; P.out = args.out; P.ws = args.ws;
    const int lo0 = args.ph_lo, hi0 = args.ph_hi;
    const bool multi = (hi0 - lo0) > 1;
    XcdBarrier bar; bar.bar = (unsigned*)(P.ws + WS_CTL); bar.x = 0; bar.st = nullptr;
    if (multi) {
        if (tid0 < 4) ((LAS3 unsigned*)(lds + LDS_BAR_OFF))[tid0] = 0u;
        __syncthreads();
        bar = xcd_barrier_post((unsigned*)(P.ws + WS_CTL), (volatile LAS unsigned*)(lds + LDS_BAR_OFF));
    }
#ifndef PHMASK
#define PHMASK 0xFFFF
#endif
#define PHM(k) (((PHMASK) >> (k)) & 1)
#define RUN(ph) (lo <= (ph) && (ph) < hi)
#define SEAM(ph) do { if ((ph) + 1 < hi) xcd_barrier(bar); } while (0)
    bf16_t* const HBA = (bf16_t*)(P.ws + WS_HBA); bf16_t* const WIN = (bf16_t*)(P.ws + WS_WIN); bf16_t* const WOUT = (bf16_t*)(P.ws + WS_WOUT);
    bf16_t* const R1 = (bf16_t*)(P.ws + WS_R1); bf16_t* const R2 = (bf16_t*)(P.ws + WS_R2); bf16_t* const R3 = (bf16_t*)(P.ws + WS_R3); bf16_t* const R4 = (bf16_t*)(P.ws + WS_R4);
    float* const SSQA = (float*)(P.ws + WS_SSQA); float* const SSQY = (float*)(P.ws + WS_SSQY);

    { const int tid = tid0, lo = lo0, hi = hi0; if (PHM(0) && RUN(0)) { phase_prologue(P, G, bid, tid); SEAM(0); } }
#pragma unroll 1
    for (int L = 0; L < DEPTH; ++L) {
        int tid = tid0, lo = lo0, hi = hi0; asm volatile("" : "+v"(tid), "+s"(lo), "+s"(hi));
        const int pb = 1 + 8 * L, j = L >> 1;
        if ((L & 1) == 0) {
            if (PHM(1) && RUN(pb + 0)) { pg8::Gemm g{HBA, WIN, M, N1A_E, DM}; pg8::StaticOrder S; S.init(M, N1A_E, G, bid);
                pg8::EpiE1a E{SSQA, R1, R2}; pg8::gemm_phase<pg8::EpiE1a, pg8::StaticOrder>(lds, g, S, E, nullptr); SEAM(pb + 0); }
            if (PHM(2) && RUN(pb + 1)) { phase_gm(lds, P, j, G, bid, tid); SEAM(pb + 1); }
            if (PHM(3) && RUN(pb + 4)) { pg8::Gemm g{HBA, WIN + (size_t)N1A_E * DM, M, N1B_E, DM}; pg8::StaticOrder S; S.init(M, N1B_E, G, bid);
                pg8::EpiE1b E{SSQA, R1, R3, INP(8) + (size_t)j * 3 * 1024, R4}; pg8::gemm_phase<pg8::EpiE1b, pg8::StaticOrder>(lds, g, S, E, nullptr); SEAM(pb + 4); }
        } else {
            if (PHM(4) && RUN(pb + 0)) { pg8::Gemm g{HBA, WIN, M, N1A_O, DM}; pg8::StaticOrder S; S.init(M, N1A_O, G, bid);
                pg8::EpiO1a E{SSQA, R1, R2, R3, (float*)(P.ws + WS_GATE)}; pg8::gemm_phase<pg8::EpiO1a, pg8::StaticOrder>(lds, g, S, E, nullptr); SEAM(pb + 0); }
            if (PHM(5) && RUN(pb + 1)) { phase_o2(lds, P, j, G, bid, tid); SEAM(pb + 1); }
            if (PHM(6) && RUN(pb + 2)) { phase_o3(lds, P, G, bid, tid); SEAM(pb + 2); }
            if (PHM(7) && RUN(pb + 3)) { phase_o4(lds, P, j, G, bid, tid); SEAM(pb + 3); }
            if (PHM(8) && RUN(pb + 4)) { pg8::Gemm g{HBA, WIN + (size_t)N1A_O * DM, M, N1B_O, DM}; pg8::StaticOrder S; S.init(M, N1B_O, G, bid);
                pg8::EpiO1b E{SSQA, R3, R4}; pg8::gemm_phase<pg8::EpiO1b, pg8::StaticOrder>(lds, g, S, E, nullptr); SEAM(pb + 4); }
        }
        if (PHM(9) && RUN(pb + 5)) { pg8::Gemm g{R4, WOUT, M, DM, 2048}; pg8::StaticOrder S; S.init(M, DM, G, bid);
            pg8::EpiOut E{R1, SSQY}; pg8::gemm_phase<pg8::EpiOut, pg8::StaticOrder>(lds, g, S, E, nullptr); SEAM(pb + 5); }
        if (PHM(10) && RUN(pb + 6)) { phase_p4(P, L, G, bid, tid); SEAM(pb + 6); }
        if (PHM(11) && RUN(pb + 7)) {
            { pg8::Gemm g{R3 + (size_t)32 * MiB, (bf16_t*)(P.ws + WS_WP) + (size_t)L * DM * PLE, M, DM, PLE}; pg8::StaticOrder S; S.init(M, DM, G, bid);
              pg8::EpiPw E{R2}; pg8::gemm_phase<pg8::EpiPw, pg8::StaticOrder>(lds, g, S, E, nullptr); }
            __syncthreads();
            { pg8::Gemm g{R3, (bf16_t*)(P.ws + WS_WG) + (size_t)L * DM * DM, M, DM, DM}; pg8::StaticOrder S; S.init(M, DM, G, bid);
              pg8::EpiGate E{(const float*)(P.ws + WS_RSTD1), R2, P.out, HBA, SSQA}; pg8::gemm_phase<pg8::EpiGate, pg8::StaticOrder>(lds, g, S, E, nullptr); }
            SEAM(pb + 7);
        }
    }
#undef RUN
#undef SEAM
}

#ifndef ONE_LAUNCH
#define ONE_LAUNCH 1
#endif
extern "C" void kernel_launch(void* const* d_in, const int* in_sizes, int n_in, void* d_out, int out_size, void* d_ws, size_t ws_size, hipStream_t stream) {
    static int grid = 0;
    if (grid == 0) {
        if (n_in != 18 || out_size != M * DM || ws_size < WS_END) { fprintf(stderr, "kernel_launch: unexpected shapes (n_in %d out %d ws %zu)\n", n_in, out_size, ws_size); grid = -1; return; }
        int dev = 0, cus = 0, per_cu = 0;
        if (hipGetDevice(&dev) != hipSuccess || hipDeviceGetAttribute(&cus, hipDeviceAttributeMultiprocessorCount, dev) != hipSuccess) { grid = -1; return; }
        if (hipFuncSetAttribute((const void*)fwd, hipFuncAttributeMaxDynamicSharedMemorySize, LDS_BYTES) != hipSuccess) { fprintf(stderr, "kernel_launch: hipFuncSetAttribute failed\n"); grid = -1; return; }
        if (hipOccupancyMaxActiveBlocksPerMultiprocessor(&per_cu, (const void*)fwd, 512, LDS_BYTES) != hipSuccess || per_cu < 1) { fprintf(stderr, "kernel_launch: occupancy query says %d\n", per_cu); }
        (void)hipGetLastError();
        grid = cus;
    }
    if (grid < 0) return;
    (void)hipMemsetAsync((char*)d_ws + WS_CTL, 0, CTL_BYTES, stream);
    Args a{};
    for (int i = 0; i < 18; ++i) a.in[i] = (const float*)d_in[i];
    a.out = (float*)d_out; a.ws = (unsigned char*)d_ws;
#if ONE_LAUNCH
    a.ph_lo = 0; a.ph_hi = NPHASE;
    hipLaunchKernelGGL(fwd, dim3(grid), dim3(512), LDS_BYTES, stream, a);
#else
    for (int ph = 0; ph < NPHASE; ++ph) { if (!phase_exists(ph)) continue; a.ph_lo = ph; a.ph_hi = ph + 1; hipLaunchKernelGGL(fwd, dim3(grid), dim3(512), LDS_BYTES, stream, a); }
#endif
}
```

```cpp
#include <hip/hip_runtime.h>
#include <cstdio>
#include <cstdint>
namespace pg8 {
#define PG8_LAS __attribute__((address_space(3)))
typedef unsigned short bf16_t;
typedef short bf16x8 __attribute__((ext_vector_type(8)));
typedef float f32x4 __attribute__((ext_vector_type(4)));
typedef unsigned u32x4 __attribute__((ext_vector_type(4)));
constexpr int BM = 256, BK = 64, HALF = 128, HTB = HALF * BK * 2  , STAGE_BYTES = 8 * HTB, NXCD = 8, WGM = 8;

__host__ __device__ __forceinline__ int lds_byte(int r, int c) { const int st = (r >> 4) * 2 + (c >> 5), rr = r & 15, cc = c & 31, ob = rr * 64 + cc * 2; return st * 1024 + (ob ^ (((ob >> 9) & 1) << 5)); }
__host__ __device__ __forceinline__ void stage_rc(int b, int& R, int& C) { const int st = b / 1024, sb = b % 1024, swz = sb ^ (((sb >> 9) & 1) << 5); R = (st >> 1) * 16 + swz / 64; C = (st & 1) * 32 + (swz % 64) / 2; }
__host__ __device__ __forceinline__ int perm32(int rho) { const int n = rho >> 4, i = rho & 15; return 8 * (i >> 2) + 4 * n + (i & 3); }

struct Unit { int pm, pn; };
struct Gemm { const bf16_t* A; const bf16_t* Bt; int M, N, K; };

struct StaticOrder {
    int nM, nN, nwg, G, c;
    __host__ __device__ void init(int M, int N, int G_, int c_) { nM = M / BM; nN = N / BM; nwg = nM * nN; G = G_; c = c_; }
    __host__ __device__ bool next(int i, Unit& u) const {
        const long L = (long)i * G + c; if (L >= nwg) return false;
        int wgid = (int)L; { const int q = nwg / NXCD, r = nwg % NXCD, xcd = wgid % NXCD, off = wgid / NXCD; wgid = (xcd < r ? xcd * (q + 1) : r * (q + 1) + (xcd - r) * q) + off; }
        const int nig = WGM * nN, gid = wgid / nig, fm = gid * WGM, gsz = (nM - fm) < WGM ? (nM - fm) : WGM;
        u.pm = fm + ((wgid % nig) % gsz); u.pn = (wgid % nig) / gsz; return true;
    }
    __device__ __forceinline__ void a_ready(const Unit&) const {}
    __device__ __forceinline__ void done(const Unit&) const {}
};
__device__ __forceinline__ unsigned cvt_pk_bf16(float lo, float hi) { unsigned r; asm volatile("v_cvt_pk_bf16_f32 %0, %1, %2" : "=v"(r) : "v"(lo), "v"(hi)); return r; }
typedef float f32x2 __attribute__((ext_vector_type(2)));
template <class Epi, class Sched, bool STAMP = false>
__device__ __forceinline__ void gemm_phase(PG8_LAS unsigned char* lds, const Gemm g, const Sched& S, const Epi& E, unsigned long long* stamps) {
    int tid_l_ = threadIdx.x; asm volatile("" : "+v"(tid_l_));
    const int tid = tid_l_, wid = __builtin_amdgcn_readfirstlane(tid >> 6), lane = tid & 63, wr = wid >> 2, wc = wid & 3, fr = lane & 15, fq = lane >> 4;
    const int K = g.K, nt = K / BK;
    int ts_lo = 0, ts_hi = 0, nts = 0; const unsigned long long rt_entry = STAMP ? (unsigned long long)wall_clock64() : 0ull;
#define PG8_STAMP() do { if (STAMP && wid == 0 && nts < 64) { const unsigned long long _c = (unsigned long long)clock64(); \
        ts_lo = (lane == nts) ? (int)(unsigned)_c : ts_lo; ts_hi = (lane == nts) ? (int)(unsigned)(_c >> 32) : ts_hi; ++nts; } } while (0)
    PG8_STAMP();
    unsigned voffA[2], voffB[2];
#pragma unroll
    for (int i = 0; i < 2; ++i) { int R, C; stage_rc(tid * 16 + i * 8192, R, C); const int Rb = Epi::PERM ? ((R & ~31) + perm32(R & 31)) : R;
        voffA[i] = (unsigned)(R * K + C) * 2u; voffB[i] = (unsigned)(Rb * K + C) * 2u; }
    const size_t kstep = (size_t)(BK * 2);
    const size_t hstep = (size_t)HALF * K * 2;
    const size_t tstep = 2 * hstep;
    const unsigned ldsw = (unsigned)wid * 1024u;
    const int aoff = lds_byte(wr * 64 + fr, fq * 8), boff = lds_byte(wc * 32 + fr, fq * 8);
#define PG8_SA(b, h) (((b) * 2 + (h)) * HTB)
#define PG8_SB(b, h) ((4 + (b) * 2 + (h)) * HTB)
#define PG8_STAGE(bufoff, gbase, voff) do { _Pragma("unroll") for (int _i = 0; _i < 2; ++_i) \
        __builtin_amdgcn_global_load_lds((const unsigned*)((const char*)(gbase) + (voff)[_i]), (PG8_LAS unsigned*)(lds + (bufoff) + ldsw + _i * 8192), 16, 0, 0); } while (0)
#define PG8_LDA(dst, b, h) do { _Pragma("unroll") for (int m = 0; m < 4; ++m) _Pragma("unroll") for (int k = 0; k < 2; ++k) dst[m][k] = *(const PG8_LAS bf16x8*)(lds + PG8_SA(b, h) + aoff + m * 2048 + k * 1024); } while (0)
#define PG8_LDB(dst, b, h) do { _Pragma("unroll") for (int n = 0; n < 2; ++n) _Pragma("unroll") for (int k = 0; k < 2; ++k) dst[n][k] = *(const PG8_LAS bf16x8*)(lds + PG8_SB(b, h) + boff + n * 2048 + k * 1024); } while (0)
#define PG8_MMA(ai, bj, At, Bt) do { __builtin_amdgcn_s_setprio(1); _Pragma("unroll") for (int m = 0; m < 4; ++m) _Pragma("unroll") for (int n = 0; n < 2; ++n) _Pragma("unroll") for (int k = 0; k < 2; ++k) \
        acc[ai][bj][m][n] = __builtin_amdgcn_mfma_f32_16x16x32_bf16(Bt[n][k], At[m][k], acc[ai][bj][m][n], 0, 0, 0); __builtin_amdgcn_s_setprio(0); } while (0)
#define PG8_WAIT_V(n) asm volatile("s_waitcnt vmcnt(" #n ")" ::: "memory")
#define PG8_WAIT_L(n) asm volatile("s_waitcnt lgkmcnt(" #n ")" ::: "memory")
#define PG8_BAR __builtin_amdgcn_s_barrier()
#define PG8_SCHED __builtin_amdgcn_sched_barrier(0)
    Unit cur, nxt; int ui = 0;
    if (!S.next(0, cur)) return;
    f32x4 acc[2][2][4][2];
#pragma unroll
    for (int a = 0; a < 2; ++a)
#pragma unroll
        for (int b = 0; b < 2; ++b)
#pragma unroll
            for (int m = 0; m < 4; ++m)
#pragma unroll
                for (int n = 0; n < 2; ++n) acc[a][b][m][n] = (f32x4){0.f, 0.f, 0.f, 0.f};
    bf16x8 At[4][2], B0[2][2], B1[2][2];
    const char* cA = (const char*)g.A + (size_t)cur.pm * tstep; const char* cB = (const char*)g.Bt + (size_t)cur.pn * tstep;
    S.a_ready(cur);
    PG8_STAGE(PG8_SB(0, 0), cB, voffB); PG8_STAGE(PG8_SA(0, 0), cA, voffA); PG8_STAGE(PG8_SB(0, 1), cB + hstep, voffB); PG8_STAGE(PG8_SA(0, 1), cA + hstep, voffA);
    if (wr == 1) PG8_BAR;
    PG8_WAIT_V(4); PG8_BAR;
    PG8_STAGE(PG8_SB(1, 0), cB + kstep, voffB); PG8_STAGE(PG8_SA(1, 0), cA + kstep, voffA); PG8_STAGE(PG8_SB(1, 1), cB + hstep + kstep, voffB);
    PG8_WAIT_V(6); PG8_BAR;
    PG8_STAMP();
    for (;;) {
        const bool has_next = S.next(ui + 1, nxt);
        const char* nA = has_next ? (const char*)g.A + (size_t)nxt.pm * tstep : cA; const char* nB = has_next ? (const char*)g.Bt + (size_t)nxt.pn * tstep : cB;
        for (int t = 0; t < nt; t += 2) {
            const bool last = (t == nt - 2);
            const char* a1 = cA + (size_t)(t + 1) * kstep;
            const char* a2 = last ? nA : cA + (size_t)(t + 2) * kstep; const char* b2 = last ? nB : cB + (size_t)(t + 2) * kstep;
            const char* a3 = a2 + kstep; const char* b3 = b2 + kstep;
            if (last && has_next) S.a_ready(nxt);
            PG8_LDB(B0, 0, 0); PG8_SCHED; PG8_LDA(At, 0, 0); PG8_STAGE(PG8_SA(1, 1), a1 + hstep, voffA);
            PG8_WAIT_L(8); PG8_BAR; PG8_WAIT_L(0); PG8_MMA(0, 0, At, B0); PG8_BAR; PG8_SCHED;
            PG8_LDB(B1, 0, 1); PG8_STAGE(PG8_SB(0, 0), b2, voffB);
            PG8_BAR; PG8_WAIT_L(0); PG8_MMA(0, 1, At, B1); PG8_BAR;
            PG8_LDA(At, 0, 1); PG8_STAGE(PG8_SA(0, 0), a2, voffA);
            PG8_BAR; PG8_WAIT_L(0); PG8_MMA(1, 0, At, B0); PG8_BAR; PG8_SCHED;
            PG8_STAGE(PG8_SB(0, 1), b2 + hstep, voffB);
            PG8_WAIT_V(6); PG8_BAR; PG8_MMA(1, 1, At, B1); PG8_BAR;
            PG8_LDB(B0, 1, 0); PG8_SCHED; PG8_LDA(At, 1, 0); PG8_STAGE(PG8_SA(0, 1), a2 + hstep, voffA);
            PG8_WAIT_L(8); PG8_BAR; PG8_WAIT_L(0); PG8_MMA(0, 0, At, B0); PG8_BAR; PG8_SCHED;
            PG8_LDB(B1, 1, 1); PG8_STAGE(PG8_SB(1, 0), b3, voffB);
            PG8_BAR; PG8_WAIT_L(0); PG8_MMA(0, 1, At, B1); PG8_BAR;
            PG8_LDA(At, 1, 1); PG8_STAGE(PG8_SA(1, 0), a3, voffA);
            PG8_BAR; PG8_WAIT_L(0); PG8_MMA(1, 0, At, B0); PG8_BAR; PG8_SCHED;
            PG8_STAGE(PG8_SB(1, 1), b3 + hstep, voffB);
            PG8_WAIT_V(6); PG8_BAR; PG8_MMA(1, 1, At, B1); PG8_BAR;
        }
        PG8_STAMP();
        if constexpr (!Epi::AFTER_DRAIN) { E(acc, cur, wr, wc, fr, fq); S.done(cur); }
        PG8_STAMP();
        if (!has_next) break;
#pragma unroll
        for (int a = 0; a < 2; ++a)
#pragma unroll
            for (int b = 0; b < 2; ++b)
#pragma unroll
                for (int m = 0; m < 4; ++m)
#pragma unroll
                    for (int n = 0; n < 2; ++n) acc[a][b][m][n] = (f32x4){0.f, 0.f, 0.f, 0.f};
        cur = nxt; cA = nA; cB = nB; ++ui;
    }
    PG8_WAIT_V(0);
    if (wr == 0) PG8_BAR;
    PG8_BAR;
    if constexpr (Epi::AFTER_DRAIN) { E.fused(acc, cur, wr, wc, fr, fq, lds, wid, lane); S.done(cur); }
    PG8_STAMP();
    if (STAMP && wid == 0) { stamps[lane] = lane < nts ? (((unsigned long long)(unsigned)ts_hi << 32) | (unsigned)ts_lo) : 0ull;
        if (lane == 62) stamps[62] = rt_entry; if (lane == 63) stamps[63] = (unsigned long long)wall_clock64(); }
#undef PG8_STAMP
#undef PG8_SA
#undef PG8_SB
#undef PG8_STAGE
#undef PG8_LDA
#undef PG8_LDB
#undef PG8_MMA
#undef PG8_WAIT_V
#undef PG8_WAIT_L
#undef PG8_BAR
#undef PG8_SCHED
}
}
#define XB_TMO      128
#define XB_XCNT(j)  (256  + 64 * (j))
#define XB_XSUB(j)  (1280 + 64 * (j))
#define XB_XGEN(j)  (2304 + 64 * (j))
#define XB_TOP      3328
#define XB_TOPGEN   3392
#define XCD_BAR_WORDS 3456
#define XB_SPIN_CAP (1u << 18)
#define LAS __attribute__((address_space(3)))

__device__ __forceinline__ unsigned xb_ld(unsigned* p)              { return __hip_atomic_load(p, __ATOMIC_RELAXED, __HIP_MEMORY_SCOPE_AGENT); }
__device__ __forceinline__ unsigned xb_add(unsigned* p, unsigned v) { return __hip_atomic_fetch_add(p, v, __ATOMIC_RELAXED, __HIP_MEMORY_SCOPE_AGENT); }
__device__ __forceinline__ unsigned xb_xcc_id() { return (unsigned)__builtin_amdgcn_s_getreg((3 << 11) | 20) & 0xFu; }
#define XB_SPIN(cond, bar) do { unsigned _sp = 0; while (cond) { __builtin_amdgcn_s_sleep(1); \
    if ((++_sp & 255u) == 0u) { if (xb_ld(&(bar)[XB_TMO])) break; if (_sp > XB_SPIN_CAP) { atomicAdd(&(bar)[XB_TMO], 1u); break; } } } } while (0)

struct XcdBarrier {
    unsigned* bar; unsigned x;
    volatile LAS unsigned* st;
};

__device__ __forceinline__ XcdBarrier xcd_barrier_post(unsigned* bar, volatile LAS unsigned* st) {
    XcdBarrier b; b.bar = bar; b.x = xb_xcc_id(); b.st = st;
    if (threadIdx.x == 0) (void)xb_add(&bar[XB_XCNT(b.x)], 1u);
    return b;
}
__device__ __forceinline__ void xcd_barrier_complete(unsigned* bar, unsigned x, unsigned& nloc, unsigned& nx) {
    const unsigned G = gridDim.x * gridDim.y * gridDim.z;
    unsigned sum, cnt, mine, sp = 0u;
    for (;;) {
        sum = 0u; cnt = 0u; mine = 0u;
#pragma unroll
        for (unsigned j = 0; j < 16; ++j) { const unsigned c = xb_ld(&bar[XB_XCNT(j)]); sum += c; cnt += (c > 0u) ? 1u : 0u; mine = (j == x) ? c : mine; }
        if (sum == G) break;
        __builtin_amdgcn_s_sleep(1);
        if ((++sp & 255u) == 0u) { if (xb_ld(&bar[XB_TMO])) break; if (sp > XB_SPIN_CAP) { atomicAdd(&bar[XB_TMO], 1u); break; } }
    }
    nloc = mine > 0u ? mine : 1u; nx = cnt > 0u ? cnt : 1u;
}

__device__ __forceinline__ void xcd_barrier(const XcdBarrier& b) {
    asm volatile("s_waitcnt vmcnt(0)" ::: "memory");
    __syncthreads();
    if (threadIdx.x == 0) {
        unsigned* bar = b.bar;
        __builtin_amdgcn_s_waitcnt(0);
        unsigned nloc = b.st[0], nx = b.st[1];
        if (nloc == 0u) { xcd_barrier_complete(bar, b.x, nloc, nx); b.st[0] = nloc; b.st[1] = nx; }
        const unsigned old = xb_add(&bar[XB_XSUB(b.x)], 1u);
        const unsigned gen = old / nloc;
        if (old + 1u == (gen + 1u) * nloc) {
            __builtin_amdgcn_fence(__ATOMIC_RELEASE, "agent");
            asm volatile("s_waitcnt vmcnt(0)" ::: "memory");
            const unsigned og = xb_add(&bar[XB_TOP], 1u);
            const unsigned tg = og / nx;
            if (og + 1u == (tg + 1u) * nx) xb_add(&bar[XB_TOPGEN], 1u);
            else XB_SPIN(xb_ld(&bar[XB_TOPGEN]) == tg, bar);
            __builtin_amdgcn_fence(__ATOMIC_ACQUIRE, "agent");
            xb_add(&bar[XB_XGEN(b.x)], 1u);
            asm volatile("s_waitcnt vmcnt(0)" ::: "memory");
        } else {
            XB_SPIN(xb_ld(&bar[XB_XGEN(b.x)]) == gen, bar);
            __builtin_amdgcn_fence(__ATOMIC_ACQUIRE, "agent");
            asm volatile("s_waitcnt vmcnt(0)" ::: "memory");
        }
    }
    __syncthreads();
}


typedef unsigned short bf16_t;
typedef float f32x4 __attribute__((ext_vector_type(4)));
typedef unsigned u32x4 __attribute__((ext_vector_type(4)));
typedef unsigned u32x2 __attribute__((ext_vector_type(2)));
constexpr int DM = 1024, NBATCH = 2, SEQ = 16384, M = NBATCH * SEQ, DEPTH = 4, PLE = 256;
constexpr float EPS = 1e-6f;
constexpr int EVEN_IN = 7168, ODD_IN = 8208;
constexpr int N1A_E = 3072, N1B_E = 4096, N1A_O = 4352, N1B_O = 4096;
constexpr int NUNIT_O = 2048;
constexpr int LDS_BYTES = 147456;
constexpr int LDS_BAR_OFF = LDS_BYTES - 16;

constexpr size_t MiB = 1u << 20;
constexpr size_t WS_CTL = 0, CTL_BYTES = 64 * 1024;
constexpr size_t WS_SSQA = 1 * MiB, WS_SSQY = 3 * MiB, WS_RSTD1 = 5 * MiB, WS_GATE = 6 * MiB, WS_GB = 8 * MiB, WS_CS = 10 * MiB, WS_MS = 10 * MiB + 65536, WS_NS = 11 * MiB;
constexpr size_t WS_WG = 12 * MiB, WS_WP = 20 * MiB, WS_WIN = 22 * MiB, WS_WOUT = 39 * MiB;
constexpr size_t WS_WSB = 43 * MiB;
constexpr size_t WS_HBA = 44 * MiB, WS_R1 = 108 * MiB, WS_R2 = 172 * MiB, WS_R3 = 236 * MiB, WS_R4 = 364 * MiB, WS_END = 492 * MiB;

__device__ __forceinline__ float bf2f(bf16_t b) { return __uint_as_float(((unsigned)b) << 16); }
__device__ __forceinline__ bf16_t f2bf(float f) { unsigned u = __float_as_uint(f); u += 0x7FFFu + ((u >> 16) & 1u); return (bf16_t)(u >> 16); }
__device__ __forceinline__ unsigned pk2(float lo, float hi) { return pg8::cvt_pk_bf16(lo, hi); }
__device__ __forceinline__ void unpack8(const u32x4 w, float (&f)[8]) {
    f[0] = __uint_as_float(w.x << 16); f[1] = __uint_as_float(w.x & 0xffff0000u); f[2] = __uint_as_float(w.y << 16); f[3] = __uint_as_float(w.y & 0xffff0000u);
    f[4] = __uint_as_float(w.z << 16); f[5] = __uint_as_float(w.z & 0xffff0000u); f[6] = __uint_as_float(w.w << 16); f[7] = __uint_as_float(w.w & 0xffff0000u);
}
__device__ __forceinline__ u32x4 pack8(const float (&f)[8]) { u32x4 w; w.x = pk2(f[0], f[1]); w.y = pk2(f[2], f[3]); w.z = pk2(f[4], f[5]); w.w = pk2(f[6], f[7]); return w; }
__device__ __forceinline__ float sigmoidf_(float x) { return __builtin_amdgcn_rcpf(1.0f + __expf(-x)); }
__device__ __forceinline__ float siluf_(float x) { return x * sigmoidf_(x); }
__device__ __forceinline__ float logsigmoidf_(float x) { return fminf(x, 0.f) - log1pf(__expf(-fabsf(x))); }
__device__ __forceinline__ float wave_sum(float s) { s += __shfl_xor(s, 1); s += __shfl_xor(s, 2); s += __shfl_xor(s, 4); s += __shfl_xor(s, 8); s += __shfl_xor(s, 16); s += __shfl_xor(s, 32); return s; }
__device__ __forceinline__ float rstd16(const float* p) {
    const f32x4 a = *(const f32x4*)p, b = *(const f32x4*)(p + 4), c = *(const f32x4*)(p + 8), d = *(const f32x4*)(p + 12);
    const float s = ((a[0] + a[1]) + (a[2] + a[3])) + ((b[0] + b[1]) + (b[2] + b[3])) + ((c[0] + c[1]) + (c[2] + c[3])) + ((d[0] + d[1]) + (d[2] + d[3]));
    return rsqrtf(s * (1.0f / 1024.0f) + EPS);
}

namespace pg8 {
#define EPI_ROWS_BEGIN  _Pragma("unroll") for (int ai = 0; ai < 2; ++ai) _Pragma("unroll") for (int m = 0; m < 4; ++m) { const int row = rowb + ai * HALF + m * 16;
#define EPI_ROWS_END    asm volatile("" ::: "memory"); }
struct EpiE1a { static constexpr bool PERM = true, AFTER_DRAIN = false;
    const float* ssq; bf16_t* U; bf16_t* BV;
    __device__ __forceinline__ void operator()(const f32x4 (&acc)[2][2][4][2], const Unit& u, int wr, int wc, int fr, int fq) const {
        const int rowb = u.pm * BM + wr * 64 + fr, cw = wc * 32 + 8 * fq;
        EPI_ROWS_BEGIN
            const float rs = rstd16(ssq + (size_t)row * 16);
            if (u.pn < 8) {
                const f32x4 p0 = (acc[ai][0][m][0] * rs) * (acc[ai][1][m][0] * rs), p1 = (acc[ai][0][m][1] * rs) * (acc[ai][1][m][1] * rs);
                u32x4 w; w.x = cvt_pk_bf16(p0[0], p0[1]); w.y = cvt_pk_bf16(p0[2], p0[3]); w.z = cvt_pk_bf16(p1[0], p1[1]); w.w = cvt_pk_bf16(p1[2], p1[3]);
                *(u32x4*)(U + (size_t)row * 1024 + u.pn * 128 + cw) = w;
            } else {
#pragma unroll
                for (int bj = 0; bj < 2; ++bj) { const f32x4 v0 = acc[ai][bj][m][0] * rs, v1 = acc[ai][bj][m][1] * rs;
                    u32x4 w; w.x = cvt_pk_bf16(v0[0], v0[1]); w.y = cvt_pk_bf16(v0[2], v0[3]); w.z = cvt_pk_bf16(v1[0], v1[1]); w.w = cvt_pk_bf16(v1[2], v1[3]);
                    *(u32x4*)(BV + (size_t)row * 1024 + (u.pn - 8) * 256 + bj * HALF + cw) = w; }
            }
        EPI_ROWS_END
    }
};
struct EpiE1b { static constexpr bool PERM = true, AFTER_DRAIN = false;
    const float* ssq; const bf16_t* U; const bf16_t* S; const float* convw; bf16_t* MIX;
    __device__ __forceinline__ void operator()(const f32x4 (&acc)[2][2][4][2], const Unit& u, int wr, int wc, int fr, int fq) const {
        const int rowb = u.pm * BM + wr * 64 + fr, cw = wc * 32 + 8 * fq;
        if (u.pn < 8) {
            const int ch0 = u.pn * 128 + cw;
            float w0[8], w1[8], w2[8];
#pragma unroll
            for (int j = 0; j < 8; ++j) { w0[j] = convw[ch0 + j]; w1[j] = convw[1024 + ch0 + j]; w2[j] = convw[2048 + ch0 + j]; }
            EPI_ROWS_BEGIN
                const float rs = rstd16(ssq + (size_t)row * 16);
                const int ts = row & (SEQ - 1);
                const bf16_t* up = U + (size_t)row * 1024 + ch0;
                float u0[8], u1[8], u2[8];
                unpack8(*(const u32x4*)up, u2);
                if (ts >= 1) unpack8(*(const u32x4*)(up - 1024), u1); else {
#pragma unroll
                    for (int j = 0; j < 8; ++j) u1[j] = 0.f; }
                if (ts >= 2) unpack8(*(const u32x4*)(up - 2048), u0); else {
#pragma unroll
                    for (int j = 0; j < 8; ++j) u0[j] = 0.f; }
                float o[8];
#pragma unroll
                for (int j = 0; j < 8; ++j) { const float ab = acc[ai][0][m][j >> 2][j & 3] * rs, ag = acc[ai][1][m][j >> 2][j & 3] * rs;
                    o[j] = ab * siluf_(ag) * (w2[j] * u2[j] + w1[j] * u1[j] + w0[j] * u0[j]); }
                *(u32x4*)(MIX + (size_t)row * 2048 + ch0) = pack8(o);
            EPI_ROWS_END
        } else {
            const int ch0 = (u.pn - 8) * 128 + cw;
            EPI_ROWS_BEGIN
                const float rs = rstd16(ssq + (size_t)row * 16);
                float sv[8]; unpack8(*(const u32x4*)(S + (size_t)row * 1024 + ch0), sv);
                float o[8];
#pragma unroll
                for (int j = 0; j < 8; ++j) { const float bu = acc[ai][0][m][j >> 2][j & 3] * rs, bg = acc[ai][1][m][j >> 2][j & 3] * rs; o[j] = bu * siluf_(bg) * sv[j]; }
                *(u32x4*)(MIX + (size_t)row * 2048 + 1024 + ch0) = pack8(o);
            EPI_ROWS_END
        }
    }
};
struct EpiO1a { static constexpr bool PERM = true, AFTER_DRAIN = false;
    const float* ssq; bf16_t* Q; bf16_t* K; bf16_t* V; float* GATE;
    __device__ __forceinline__ void operator()(const f32x4 (&acc)[2][2][4][2], const Unit& u, int wr, int wc, int fr, int fq) const {
        const int rowb = u.pm * BM + wr * 64 + fr, cw = wc * 32 + 8 * fq;
        if (u.pn < 16) {
            bf16_t* base; int ld, c0;
            if (u.pn < 4) { base = Q; ld = 1024; c0 = u.pn * 256; } else if (u.pn < 8) { base = K; ld = 1024; c0 = (u.pn - 4) * 256; } else { base = V; ld = 2048; c0 = (u.pn - 8) * 256; }
            EPI_ROWS_BEGIN
                const float rs = rstd16(ssq + (size_t)row * 16);
#pragma unroll
                for (int bj = 0; bj < 2; ++bj) { const f32x4 v0 = acc[ai][bj][m][0] * rs, v1 = acc[ai][bj][m][1] * rs;
                    u32x4 w; w.x = cvt_pk_bf16(v0[0], v0[1]); w.y = cvt_pk_bf16(v0[2], v0[3]); w.z = cvt_pk_bf16(v1[0], v1[1]); w.w = cvt_pk_bf16(v1[2], v1[3]);
                    *(u32x4*)(base + (size_t)row * ld + c0 + bj * HALF + cw) = w; }
            EPI_ROWS_END
        } else if (wc == 0 && fq < 2) {
            EPI_ROWS_BEGIN
                const float rs = rstd16(ssq + (size_t)row * 16);
                *(f32x4*)(GATE + (size_t)row * 16 + 8 * fq) = acc[ai][0][m][0] * rs;
                *(f32x4*)(GATE + (size_t)row * 16 + 8 * fq + 4) = acc[ai][0][m][1] * rs;
            EPI_ROWS_END
        }
    }
};
struct EpiO1b { static constexpr bool PERM = true, AFTER_DRAIN = false;
    const float* ssq; const bf16_t* HC; bf16_t* MIX;
    __device__ __forceinline__ void operator()(const f32x4 (&acc)[2][2][4][2], const Unit& u, int wr, int wc, int fr, int fq) const {
        const int rowb = u.pm * BM + wr * 64 + fr, ch0 = u.pn * 128 + wc * 32 + 8 * fq;
        EPI_ROWS_BEGIN
            const float rs = rstd16(ssq + (size_t)row * 16);
            float hv[8]; unpack8(*(const u32x4*)(HC + (size_t)row * 2048 + ch0), hv);
            float o[8];
#pragma unroll
            for (int j = 0; j < 8; ++j) { const float oo = acc[ai][0][m][j >> 2][j & 3] * rs, zz = acc[ai][1][m][j >> 2][j & 3] * rs; o[j] = hv[j] * sigmoidf_(oo) * siluf_(zz); }
            *(u32x4*)(MIX + (size_t)row * 2048 + ch0) = pack8(o);
        EPI_ROWS_END
    }
};
struct EpiOut { static constexpr bool PERM = true, AFTER_DRAIN = false;
    bf16_t* Y; float* SSQ;
    __device__ __forceinline__ void operator()(const f32x4 (&acc)[2][2][4][2], const Unit& u, int wr, int wc, int fr, int fq) const {
        const int rowb = u.pm * BM + wr * 64 + fr, cw = wc * 32 + 8 * fq;
        EPI_ROWS_BEGIN
            float s = 0.f;
#pragma unroll
            for (int bj = 0; bj < 2; ++bj) { const f32x4 v0 = acc[ai][bj][m][0], v1 = acc[ai][bj][m][1];
                s += (v0[0] * v0[0] + v0[1] * v0[1]) + (v0[2] * v0[2] + v0[3] * v0[3]) + (v1[0] * v1[0] + v1[1] * v1[1]) + (v1[2] * v1[2] + v1[3] * v1[3]);
                u32x4 w; w.x = cvt_pk_bf16(v0[0], v0[1]); w.y = cvt_pk_bf16(v0[2], v0[3]); w.z = cvt_pk_bf16(v1[0], v1[1]); w.w = cvt_pk_bf16(v1[2], v1[3]);
                *(u32x4*)(Y + (size_t)row * 1024 + u.pn * 256 + bj * HALF + cw) = w; }
            s += __shfl_xor(s, 16); s += __shfl_xor(s, 32);
            if (fq == 0) SSQ[(size_t)row * 16 + u.pn * 4 + wc] = s;
        EPI_ROWS_END
    }
};
struct EpiPw { static constexpr bool PERM = true, AFTER_DRAIN = false;
    bf16_t* PW;
    __device__ __forceinline__ void operator()(const f32x4 (&acc)[2][2][4][2], const Unit& u, int wr, int wc, int fr, int fq) const {
        const int rowb = u.pm * BM + wr * 64 + fr, cw = wc * 32 + 8 * fq;
        EPI_ROWS_BEGIN
#pragma unroll
            for (int bj = 0; bj < 2; ++bj) { const f32x4 v0 = acc[ai][bj][m][0], v1 = acc[ai][bj][m][1];
                u32x4 w; w.x = cvt_pk_bf16(v0[0], v0[1]); w.y = cvt_pk_bf16(v0[2], v0[3]); w.z = cvt_pk_bf16(v1[0], v1[1]); w.w = cvt_pk_bf16(v1[2], v1[3]);
                *(u32x4*)(PW + (size_t)row * 1024 + u.pn * 256 + bj * HALF + cw) = w; }
        EPI_ROWS_END
    }
};
struct EpiGate { static constexpr bool PERM = true, AFTER_DRAIN = false;
    const float* RSTD1; const bf16_t* PW; const bf16_t* HB1; bf16_t* HB2; float* SSQ; float* OUT;
    __device__ __forceinline__ void operator()(const f32x4 (&acc)[2][2][4][2], const Unit& u, int wr, int wc, int fr, int fq) const {
        const int rowb = u.pm * BM + wr * 64 + fr, cw = wc * 32 + 8 * fq;
        EPI_ROWS_BEGIN
            const float rs = RSTD1[row]; float s = 0.f;
#pragma unroll
            for (int bj = 0; bj < 2; ++bj) { const size_t off = (size_t)row * 1024 + u.pn * 256 + bj * HALF + cw;
                float pw[8], hv[8]; unpack8(*(const u32x4*)(PW + off), pw); unpack8(*(const u32x4*)(HB1 + off), hv);
                float o[8];
#pragma unroll
                for (int j = 0; j < 8; ++j) { const float g = sigmoidf_(acc[ai][bj][m][j >> 2][j & 3] * rs); o[j] = hv[j] + g * pw[j]; s += o[j] * o[j]; }
                if (OUT) { *(f32x4*)(OUT + off) = (f32x4){o[0], o[1], o[2], o[3]}; *(f32x4*)(OUT + off + 4) = (f32x4){o[4], o[5], o[6], o[7]}; }
                else *(u32x4*)(HB2 + off) = pack8(o); }
            s += __shfl_xor(s, 16); s += __shfl_xor(s, 32);
            if (fq == 0) SSQ[(size_t)row * 16 + u.pn * 4 + wc] = s;
        EPI_ROWS_END
    }
};
}

struct MapE1a { __device__ __forceinline__ int operator()(int np, float& sc) const { sc = 1.f; const int t = np >> 8; if (t < 8) { const int bj = (np >> 7) & 1, c = np & 127; return (bj ? 2048 : 1024) + t * 128 + c; } return 5120 + (np - 2048); } };
struct MapE1b { __device__ __forceinline__ int operator()(int np, float& sc) const { sc = 1.f; const int t = np >> 8, bj = (np >> 7) & 1, c = np & 127; if (t < 8) return (bj ? 3072 : 0) + t * 128 + c; return (bj ? 6144 : 4096) + (t - 8) * 128 + c; } };
struct MapO1a { __device__ __forceinline__ int operator()(int np, float& sc) const { sc = (np < 1024) ? 0.08838834764831845f : 1.f; if (np < 4096) return np; const int c = np - 4096; return c < 16 ? 8192 + c : -1; } };
struct MapO1b { __device__ __forceinline__ int operator()(int np, float& sc) const { sc = 1.f; const int t = np >> 8, bj = (np >> 7) & 1, c = np & 127; return (bj ? 6144 : 4096) + t * 128 + c; } };
struct MapId  { __device__ __forceinline__ int operator()(int np, float& sc) const { sc = 1.f; return np; } };
template <class F> __device__ __forceinline__ void conv_w(bf16_t* dst, const float* src, int K, int Nsrc, int Nrows, const float* gk, F map, int gt, int nth) {
    const int total = Nrows * (K >> 3);
    for (int idx = gt; idx < total; idx += nth) {
        const int np = idx % Nrows, k8 = idx / Nrows; float sc; const int n = map(np, sc);
        float v[8];
#pragma unroll
        for (int j = 0; j < 8; ++j) { const int k = k8 * 8 + j; v[j] = (n >= 0) ? src[(size_t)k * Nsrc + n] * (gk ? gk[k] : 1.f) * sc : 0.f; }
        *(u32x4*)(dst + (size_t)np * K + k8 * 8) = pack8(v);
    }
}

struct Ptrs { float* out; unsigned char* ws; };
template <int I> __device__ __forceinline__ const float* inp_() {
    const unsigned long long ka = (unsigned long long)__builtin_amdgcn_kernarg_segment_ptr(); unsigned long long v;
    asm volatile("s_load_dwordx2 %0, %1, %2\n\ts_waitcnt lgkmcnt(0)" : "=s"(v) : "s"(ka), "n"(I * 8) : "memory");
    return (const float*)v;
}
#define INP(i) (inp_<i>())
#define LAS3 __attribute__((address_space(3)))

__device__ __forceinline__ void prep_layer_weights(const Ptrs& P, int L, int gt, int nth) {
    const int j = L >> 1; bf16_t* WIN = (bf16_t*)(P.ws + WS_WIN); bf16_t* WOUT = (bf16_t*)(P.ws + WS_WOUT);
    const float* pre_g = INP(2) + (size_t)L * DM;
    if ((L & 1) == 0) {
        const float* w = INP(7) + (size_t)j * DM * EVEN_IN;
        conv_w(WIN, w, DM, EVEN_IN, N1A_E, pre_g, MapE1a(), gt, nth);
        conv_w(WIN + (size_t)N1A_E * DM, w, DM, EVEN_IN, N1B_E, pre_g, MapE1b(), gt, nth);
        conv_w(WOUT, INP(13) + (size_t)j * 2048 * DM, 2048, DM, DM, nullptr, MapId(), gt, nth);
        { const float* wsrc = INP(11) + (size_t)j * 8 * 16384; bf16_t* WSB = (bf16_t*)(P.ws + WS_WSB);
          for (int i = gt; i < 8 * 16384 / 8; i += nth) { const int e = i * 8, t = (e >> 7) & 127, s0 = e & 127;
              const f32x4 a = *(const f32x4*)(wsrc + e), b = *(const f32x4*)(wsrc + e + 4); float o[8] = {a[0], a[1], a[2], a[3], b[0], b[1], b[2], b[3]};
#pragma unroll
              for (int q = 0; q < 8; ++q) if (s0 + q > t) o[q] = 0.f;
              *(u32x4*)(WSB + e) = pack8(o); } }
    } else {
        const float* w = INP(14) + (size_t)j * DM * ODD_IN;
        conv_w(WIN, w, DM, ODD_IN, N1A_O, pre_g, MapO1a(), gt, nth);
        conv_w(WIN + (size_t)N1A_O * DM, w, DM, ODD_IN, N1B_O, pre_g, MapO1b(), gt, nth);
        conv_w(WOUT, INP(17) + (size_t)j * 2048 * DM, 2048, DM, DM, nullptr, MapId(), gt, nth);
    }
}

__device__ __forceinline__ void phase_prologue(const Ptrs& P, int G, int bid, int tid) {
    const int lane = tid & 63, wid = tid >> 6;
    const float* x = INP(0); bf16_t* HBA = (bf16_t*)(P.ws + WS_HBA); float* SSQA = (float*)(P.ws + WS_SSQA);
    for (int row = bid * 8 + wid; row < M; row += G * 8) {
        float sq = 0.f;
#pragma unroll
        for (int i = 0; i < 2; ++i) { const size_t off = (size_t)row * DM + i * 512 + lane * 8;
            const f32x4 a = *(const f32x4*)(x + off), b = *(const f32x4*)(x + off + 4);
            const float o[8] = {a[0], a[1], a[2], a[3], b[0], b[1], b[2], b[3]};
#pragma unroll
            for (int j = 0; j < 8; ++j) sq += o[j] * o[j];
            *(u32x4*)(HBA + off) = pack8(o); }
        sq = wave_sum(sq);
        if (lane < 16) SSQA[(size_t)row * 16 + lane] = (lane == 0) ? sq : 0.f;
    }
    const int gt = bid * 512 + tid, nth = G * 512;
    for (int L = 0; L < DEPTH; ++L) {
        conv_w((bf16_t*)(P.ws + WS_WG) + (size_t)L * DM * DM, INP(6) + (size_t)L * DM * DM, DM, DM, DM, INP(4) + (size_t)L * DM, MapId(), gt, nth);
        conv_w((bf16_t*)(P.ws + WS_WP) + (size_t)L * DM * PLE, INP(5) + (size_t)L * PLE * DM, PLE, DM, DM, nullptr, MapId(), gt, nth);
    }
    prep_layer_weights(P, 0, gt, nth);
}

__device__ __forceinline__ void phase_p4(const Ptrs& P, int L, int G, int bid, int tid) {
    const int lane = tid & 63, wid = tid >> 6;
    const bf16_t* HBA = (const bf16_t*)(P.ws + WS_HBA);
    const bf16_t* Y = (const bf16_t*)(P.ws + WS_R1); const float* SSQY = (const float*)(P.ws + WS_SSQY);
    bf16_t* HBB = (bf16_t*)(P.ws + WS_R3); float* RSTD1 = (float*)(P.ws + WS_RSTD1);
    const float* pg = INP(3) + (size_t)L * DM;
    f32x4 g[2][2];
#pragma unroll
    for (int i = 0; i < 2; ++i) { g[i][0] = *(const f32x4*)(pg + i * 512 + lane * 8); g[i][1] = *(const f32x4*)(pg + i * 512 + lane * 8 + 4); }
    for (int row = bid * 8 + wid; row < M; row += G * 8) {
        float s = (lane < 16) ? SSQY[(size_t)row * 16 + lane] : 0.f;
        s = wave_sum(s);
        const float rsy = rsqrtf(s * (1.0f / 1024.0f) + EPS);
        float sq = 0.f;
#pragma unroll
        for (int i = 0; i < 2; ++i) { const size_t off = (size_t)row * DM + i * 512 + lane * 8;
            float yv[8], hv[8]; unpack8(*(const u32x4*)(Y + off), yv); unpack8(*(const u32x4*)(HBA + off), hv);
            float o[8];
#pragma unroll
            for (int j = 0; j < 8; ++j) { o[j] = hv[j] + yv[j] * rsy * g[i][j >> 2][j & 3]; sq += o[j] * o[j]; }
            *(u32x4*)(HBB + off) = pack8(o); }
        sq = wave_sum(sq);
        if (lane == 0) RSTD1[row] = rsqrtf(sq * (1.0f / 1024.0f) + EPS);
    }
    const int gt = bid * 512 + tid, nth = G * 512;
    const float* pl = INP(1) + (size_t)L * M * PLE; bf16_t* PB = (bf16_t*)(P.ws + WS_R3 + 64 * MiB);
    for (int i = gt; i < M * PLE / 8; i += nth) { const f32x4 a = *(const f32x4*)(pl + (size_t)i * 8), b = *(const f32x4*)(pl + (size_t)i * 8 + 4);
        const float o[8] = {a[0], a[1], a[2], a[3], b[0], b[1], b[2], b[3]}; *(u32x4*)(PB + (size_t)i * 8) = pack8(o); }
    if (L + 1 < DEPTH) prep_layer_weights(P, L + 1, gt, nth);
}

typedef short bf16x8 __attribute__((ext_vector_type(8)));
typedef short s16x4 __attribute__((ext_vector_type(4)));
typedef float f32x16 __attribute__((ext_vector_type(16)));
__device__ __forceinline__ bf16x8 tr_frag(const LAS3 unsigned char* img, int a0, int a1) {
    const s16x4 x = __builtin_amdgcn_ds_read_tr16_b64_v4i16((LAS3 s16x4*)(img + a0)), y = __builtin_amdgcn_ds_read_tr16_b64_v4i16((LAS3 s16x4*)(img + a1));
    return (bf16x8){x[0], x[1], x[2], x[3], y[0], y[1], y[2], y[3]};
}
constexpr int RS_K = 272, RS_V = 576, RS_KW = 320;

__device__ __forceinline__ void gm_stage_load(u32x4 (&vq)[4], const bf16_t* BV, int r0, int g, int tid) {
#pragma unroll
    for (int i = 0; i < 4; ++i) { const int e8 = tid + 512 * i, s = e8 >> 4, c8 = e8 & 15; vq[i] = *(const u32x4*)(BV + (size_t)(r0 + s) * 1024 + g * 128 + c8 * 8); }
}
__device__ __forceinline__ void gm_stage_store(const u32x4 (&vq)[4], LAS3 unsigned char* img, const LAS3 float* mu, const LAS3 float* rsd, const float* lg, const float* lb, int g, int tid) {
#pragma unroll
    for (int i = 0; i < 4; ++i) { const int e8 = tid + 512 * i, s = e8 >> 4, c8 = e8 & 15;
        float x[8]; unpack8(vq[i], x); const float m_ = mu[s], r_ = rsd[s];
        const f32x4 g0 = *(const f32x4*)(lg + g * 128 + c8 * 8), g1 = *(const f32x4*)(lg + g * 128 + c8 * 8 + 4), b0 = *(const f32x4*)(lb + g * 128 + c8 * 8), b1 = *(const f32x4*)(lb + g * 128 + c8 * 8 + 4);
#pragma unroll
        for (int q = 0; q < 8; ++q) x[q] = (x[q] - m_) * r_ * (q < 4 ? g0[q & 3] : g1[q & 3]) + (q < 4 ? b0[q & 3] : b1[q & 3]);
        *(LAS3 u32x4*)(img + s * RS_KW + c8 * 16) = pack8(x); }
}
__device__ __forceinline__ void phase_gm(LAS3 unsigned char* lds, const Ptrs& P, int j, int G, int bid, int tid_in) {
    LAS3 float* mu = (LAS3 float*)(lds + 81920); LAS3 float* rsd = mu + 128;
    const bf16_t* BV = (const bf16_t*)(P.ws + WS_R2); bf16_t* S = (bf16_t*)(P.ws + WS_R3); const bf16_t* WSB = (const bf16_t*)(P.ws + WS_WSB);
    const float* bs = INP(12) + (size_t)j * 128 * 8;
    const float* lg = INP(9) + (size_t)j * 1024; const float* lb = INP(10) + (size_t)j * 1024;
    for (int c = bid; c < M / 128; c += G) {
        int tid = tid_in; asm volatile("" : "+v"(tid));
        const int lane = tid & 63, wid = __builtin_amdgcn_readfirstlane(tid >> 6), hh = lane >> 5, l31 = lane & 31, tb = wid & 3, chf = wid >> 2;
        const int r0 = c * 128;
        u32x4 vq[4];
        gm_stage_load(vq, BV, r0, 0, tid);
#pragma unroll 2
        for (int rr = 0; rr < 16; ++rr) { const int row = wid * 16 + rr; const bf16_t* p = BV + (size_t)(r0 + row) * 1024;
            float a[8], b[8]; unpack8(*(const u32x4*)(p + lane * 8), a); unpack8(*(const u32x4*)(p + 512 + lane * 8), b);
            float s = 0.f;
#pragma unroll
            for (int q = 0; q < 8; ++q) s += a[q] + b[q];
            s = wave_sum(s); const float mean = s * (1.0f / 1024.0f); float v = 0.f;
#pragma unroll
            for (int q = 0; q < 8; ++q) { const float d0 = a[q] - mean, d1 = b[q] - mean; v += d0 * d0 + d1 * d1; }
            v = wave_sum(v);
            if (lane == 0) { mu[row] = mean; rsd[row] = rsqrtf(v * (1.0f / 1024.0f) + EPS); } }
        __syncthreads();
        gm_stage_store(vq, lds, mu, rsd, lg, lb, 0, tid);
        __syncthreads();
        const int blk = (lane >> 4) & 1, q4 = (lane & 15) >> 2, p4 = lane & 3;
        const int trk = (q4 + 8 * hh) * RS_KW + (chf * 64 + 16 * blk + 4 * p4) * 2;
#pragma unroll 1
        for (int g = 0; g < 8; ++g) {
            LAS3 unsigned char* cur = lds + (g & 1) * 40960; LAS3 unsigned char* nxt = lds + ((g & 1) ^ 1) * 40960;
            if (g < 7) gm_stage_load(vq, BV, r0, g + 1, tid);
            f32x16 acc[2];
#pragma unroll
            for (int cb = 0; cb < 2; ++cb)
#pragma unroll
                for (int r = 0; r < 16; ++r) acc[cb][r] = 0.f;
            const bf16_t* wrow = WSB + (size_t)g * 16384 + (size_t)(tb * 32 + l31) * 128 + 8 * hh;
#pragma unroll
            for (int ks = 0; ks < 8; ++ks) {
                if (ks <= 2 * tb + 1) {
                    const bf16x8 af = *(const bf16x8*)(wrow + 16 * ks);
#pragma unroll
                    for (int cb = 0; cb < 2; ++cb) { const bf16x8 bfr = tr_frag(cur, trk + 16 * ks * RS_KW + cb * 64, trk + (16 * ks + 4) * RS_KW + cb * 64);
                        acc[cb] = __builtin_amdgcn_mfma_f32_32x32x16_bf16(af, bfr, acc[cb], 0, 0, 0); }
                }
            }
#pragma unroll
            for (int r = 0; r < 16; ++r) { const int t = tb * 32 + (r & 3) + 8 * (r >> 2) + 4 * hh; const float bt = bs[t * 8 + g];
#pragma unroll
                for (int cb = 0; cb < 2; ++cb) S[(size_t)(r0 + t) * 1024 + g * 128 + chf * 64 + cb * 32 + l31] = f2bf(acc[cb][r] + bt); }
            if (g < 7) gm_stage_store(vq, nxt, mu, rsd, lg, lb, g + 1, tid);
            __syncthreads();
        }
    }
}

__device__ __forceinline__ void phase_o2(LAS3 unsigned char* lds, const Ptrs& P, int j, int G, int bid, int tid_in) {
    LAS3 unsigned char* KW = lds; LAS3 unsigned char* VI = lds + 40960; LAS3 float* sc = (LAS3 float*)(lds + 40960 + 73728); LAS3 float* wv = sc + 128;
    const bf16_t* Kb = (const bf16_t*)(P.ws + WS_R2); const bf16_t* Vb = (const bf16_t*)(P.ws + WS_R3);
    const float* GATE = (const float*)(P.ws + WS_GATE); float* GB = (float*)(P.ws + WS_GB); float* CS = (float*)(P.ws + WS_CS);
    bf16_t* UC = (bf16_t*)(P.ws + WS_R4); float* NS = (float*)(P.ws + WS_NS);
    const float* bif = INP(15) + (size_t)j * 16;
    for (int unit = bid; unit < NUNIT_O; unit += G) {
        int tid = tid_in; asm volatile("" : "+v"(tid));
        const int lane = tid & 63, wid = __builtin_amdgcn_readfirstlane(tid >> 6), hh = lane >> 5, l31 = lane & 31;
        const int chain = unit >> 7, n = unit & 127, b = chain >> 3, h = chain & 7, r0 = b * SEQ + n * 128;
        u32x4 kq[4], vq[8];
#pragma unroll
        for (int i = 0; i < 4; ++i) { const int e8 = tid + 512 * i, s = e8 >> 4, k8 = e8 & 15; kq[i] = *(const u32x4*)(Kb + (size_t)(r0 + s) * 1024 + h * 128 + k8 * 8); }
#pragma unroll
        for (int i = 0; i < 8; ++i) { const int e8 = tid + 512 * i, s = e8 >> 5, v8 = e8 & 31; vq[i] = *(const u32x4*)(Vb + (size_t)(r0 + s) * 2048 + h * 256 + v8 * 8); }
        float ii = 0.f, a = 0.f;
        if (tid < 128) { const float fi = GATE[(size_t)(r0 + tid) * 16 + 8 + h] + bif[8 + h]; ii = GATE[(size_t)(r0 + tid) * 16 + h] + bif[h]; sc[tid] = logsigmoidf_(fi); }
        __syncthreads();
        for (int off = 1; off < 128; off <<= 1) { float v = 0.f; if (tid < 128) v = sc[tid] + (tid >= off ? sc[tid - off] : 0.f); __syncthreads(); if (tid < 128) sc[tid] = v; __syncthreads(); }
        const float gtot = sc[127];
        if (tid < 128) { a = gtot - sc[tid] + ii; wv[tid] = a; GB[((size_t)(r0 + tid) * 8 + h) * 2] = sc[tid]; GB[((size_t)(r0 + tid) * 8 + h) * 2 + 1] = ii; }
        __syncthreads();
        float amax = -3.0e38f;
#pragma unroll 8
        for (int t = 0; t < 128; ++t) amax = fmaxf(amax, wv[t]);
        __syncthreads();
        if (tid < 128) wv[tid] = __expf(a - amax);
        if (tid == 0) { CS[(size_t)unit * 2] = gtot; CS[(size_t)unit * 2 + 1] = amax; }
        __syncthreads();
#pragma unroll
        for (int i = 0; i < 4; ++i) { const int e8 = tid + 512 * i, s = e8 >> 4, k8 = e8 & 15;
            float kv[8]; unpack8(kq[i], kv); const float w = wv[s];
#pragma unroll
            for (int q = 0; q < 8; ++q) kv[q] *= w;
            *(LAS3 u32x4*)(KW + s * RS_KW + k8 * 16) = pack8(kv); }
#pragma unroll
        for (int i = 0; i < 8; ++i) { const int e8 = tid + 512 * i, s = e8 >> 5, v8 = e8 & 31; *(LAS3 u32x4*)(VI + s * RS_V + v8 * 16) = vq[i]; }
        __syncthreads();
        {
            const int blk = (lane >> 4) & 1, q = (lane & 15) >> 2, p = lane & 3;
            const int trv = (q + 8 * hh) * RS_V + (wid * 32 + 16 * blk + 4 * p) * 2, trk = (q + 8 * hh) * RS_KW + (16 * blk + 4 * p) * 2;
            f32x16 acc[4];
#pragma unroll
            for (int db = 0; db < 4; ++db)
#pragma unroll
                for (int r = 0; r < 16; ++r) acc[db][r] = 0.f;
#pragma unroll
            for (int ks = 0; ks < 8; ++ks) {
                const bf16x8 af = tr_frag(VI, trv + 16 * ks * RS_V, trv + (16 * ks + 4) * RS_V);
#pragma unroll
                for (int db = 0; db < 4; ++db) { const bf16x8 bfr = tr_frag(KW, trk + 16 * ks * RS_KW + db * 64, trk + (16 * ks + 4) * RS_KW + db * 64);
                    acc[db] = __builtin_amdgcn_mfma_f32_32x32x16_bf16(af, bfr, acc[db], 0, 0, 0); }
            }
            bf16_t* up = UC + (size_t)unit * 32768;
#pragma unroll
            for (int db = 0; db < 4; ++db)
#pragma unroll
                for (int r = 0; r < 16; ++r) { const int v = wid * 32 + (r & 3) + 8 * (r >> 2) + 4 * hh; up[v * 128 + db * 32 + l31] = f2bf(acc[db][r]); }
        }
        if (tid < 128) { float ns = 0.f;
#pragma unroll 8
            for (int s = 0; s < 128; ++s) ns += bf2f(*(const LAS3 bf16_t*)(KW + s * RS_KW + tid * 2));
            NS[(size_t)unit * 128 + tid] = ns; }
        __syncthreads();
    }
}

__device__ __forceinline__ void phase_o3(LAS3 unsigned char* lds, const Ptrs& P, int G, int bid, int tid) {
    LAS3 float* dec = (LAS3 float*)lds; LAS3 float* scl = dec + 128; LAS3 float* gg = scl + 128; LAS3 float* am = gg + 128;
    const float* CS = (const float*)(P.ws + WS_CS); float* MS = (float*)(P.ws + WS_MS); bf16_t* UC = (bf16_t*)(P.ws + WS_R4); float* NS = (float*)(P.ws + WS_NS);
    for (int task = bid; task < 256; task += G) {
        const int chain = task >> 4, eb = task & 15;
        if (tid < 128) { gg[tid] = CS[((size_t)chain * 128 + tid) * 2]; am[tid] = CS[((size_t)chain * 128 + tid) * 2 + 1]; }
        __syncthreads();
        if (tid == 0) { float m = 0.f;
            for (int n = 0; n < 128; ++n) { const float g = gg[n], a = am[n], mn = fmaxf(g + m, a); dec[n] = __expf(g + m - mn); scl[n] = __expf(a - mn); if (eb == 0) MS[chain * 128 + n] = m; m = mn; } }
        __syncthreads();
        const size_t e = (size_t)eb * 2048 + tid * 4;
        float c0 = 0.f, c1 = 0.f, c2 = 0.f, c3 = 0.f;
        for (int n0 = 0; n0 < 128; n0 += 8) {
            u32x2 u[8];
#pragma unroll
            for (int q = 0; q < 8; ++q) u[q] = *(const u32x2*)(UC + ((size_t)chain * 128 + n0 + q) * 32768 + e);
#pragma unroll
            for (int q = 0; q < 8; ++q) { u32x2 w; w.x = pk2(c0, c1); w.y = pk2(c2, c3); *(u32x2*)(UC + ((size_t)chain * 128 + n0 + q) * 32768 + e) = w;
                const float d = dec[n0 + q], s = scl[n0 + q];
                c0 = d * c0 + s * __uint_as_float(u[q].x << 16); c1 = d * c1 + s * __uint_as_float(u[q].x & 0xffff0000u);
                c2 = d * c2 + s * __uint_as_float(u[q].y << 16); c3 = d * c3 + s * __uint_as_float(u[q].y & 0xffff0000u); }
        }
        if (eb == 0 && tid < 128) { float cn = 0.f;
            for (int n = 0; n < 128; ++n) { const size_t o = ((size_t)chain * 128 + n) * 128 + tid; const float v = NS[o]; NS[o] = cn; cn = dec[n] * cn + scl[n] * v; } }
        __syncthreads();
    }
}


__device__ __forceinline__ void phase_o4(LAS3 unsigned char* lds, const Ptrs& P, int j, int G, int bid, int tid_in) {
    LAS3 unsigned char* RA = lds;
    LAS3 unsigned char* RB = lds + 73728;
    LAS3 float* bb = (LAS3 float*)(lds + 143360); LAS3 float* cc = bb + 128; LAS3 float* MM = cc + 128; LAS3 float* isc = MM + 128; LAS3 float* nst = isc + 128; LAS3 float* red = nst + 128;
    const bf16_t* Qb = (const bf16_t*)(P.ws + WS_R1); const bf16_t* Kb = (const bf16_t*)(P.ws + WS_R2); bf16_t* Vb = (bf16_t*)(P.ws + WS_R3);
    const bf16_t* UC = (const bf16_t*)(P.ws + WS_R4); const float* NS = (const float*)(P.ws + WS_NS); const float* MS = (const float*)(P.ws + WS_MS); const float* GB = (const float*)(P.ws + WS_GB);
    const float* mhg = INP(16) + (size_t)j * 8 * 256;
    for (int unit = bid; unit < NUNIT_O; unit += G) {
        int tid = tid_in; asm volatile("" : "+v"(tid));
        const int lane = tid & 63, wid = __builtin_amdgcn_readfirstlane(tid >> 6), hh = lane >> 5, l31 = lane & 31, tb = wid & 3, vh = wid >> 2;
        const int chain = unit >> 7, n = unit & 127, b = chain >> 3, h = chain & 7, r0 = b * SEQ + n * 128;
        const float mst = MS[chain * 128 + n];
        const int t = tb * 32 + l31;
        {
            u32x4 kq[4], cq[8];
#pragma unroll
            for (int i = 0; i < 4; ++i) { const int e8 = tid + 512 * i, s = e8 >> 4, k8 = e8 & 15; kq[i] = *(const u32x4*)(Kb + (size_t)(r0 + s) * 1024 + h * 128 + k8 * 8); }
#pragma unroll
            for (int i = 0; i < 8; ++i) { const int e8 = tid + 512 * i; cq[i] = *(const u32x4*)(UC + (size_t)unit * 32768 + (size_t)e8 * 8); }
            if (tid < 128) { const float bv = GB[((size_t)(r0 + tid) * 8 + h) * 2], iv = GB[((size_t)(r0 + tid) * 8 + h) * 2 + 1]; bb[tid] = bv; cc[tid] = iv - bv; nst[tid] = NS[(size_t)unit * 128 + tid]; }
#pragma unroll
            for (int i = 0; i < 4; ++i) { const int e8 = tid + 512 * i, s = e8 >> 4, k8 = e8 & 15; *(LAS3 u32x4*)(RA + s * RS_K + k8 * 16) = kq[i]; }
#pragma unroll
            for (int i = 0; i < 8; ++i) { const int e8 = tid + 512 * i, v = e8 >> 4, k8 = e8 & 15; *(LAS3 u32x4*)(RB + v * RS_K + k8 * 16) = cq[i]; }
        }
        bf16x8 qf[8];
#pragma unroll
        for (int ks = 0; ks < 8; ++ks) qf[ks] = *(const bf16x8*)(Qb + (size_t)(r0 + t) * 1024 + h * 128 + 16 * ks + 8 * hh);
        __syncthreads();
        if (tid < 128) { float mx = mst;
#pragma unroll 1
            for (int s = 0; s <= tid; ++s) mx = fmaxf(mx, cc[s]);
            MM[tid] = mx; isc[tid] = __expf(mst - mx); }
        f32x16 accS[4], acc[4];
#pragma unroll
        for (int sb = 0; sb < 4; ++sb) {
#pragma unroll
            for (int r = 0; r < 16; ++r) accS[sb][r] = 0.f;
            if (sb <= tb) {
#pragma unroll
                for (int ks = 0; ks < 8; ++ks) { const bf16x8 af = *(const LAS3 bf16x8*)(RA + (sb * 32 + l31) * RS_K + (16 * ks + 8 * hh) * 2); accS[sb] = __builtin_amdgcn_mfma_f32_32x32x16_bf16(af, qf[ks], accS[sb], 0, 0, 0); }
            }
        }
#pragma unroll
        for (int vb = 0; vb < 4; ++vb) {
#pragma unroll
            for (int r = 0; r < 16; ++r) acc[vb][r] = 0.f;
#pragma unroll
            for (int ks = 0; ks < 8; ++ks) { const bf16x8 af = *(const LAS3 bf16x8*)(RB + ((vh * 4 + vb) * 32 + l31) * RS_K + (16 * ks + 8 * hh) * 2); acc[vb] = __builtin_amdgcn_mfma_f32_32x32x16_bf16(af, qf[ks], acc[vb], 0, 0, 0); }
        }
        float qn = 0.f;
#pragma unroll
        for (int ks = 0; ks < 8; ++ks) { const f32x4 n0 = *(const LAS3 f32x4*)&nst[16 * ks + 8 * hh], n1 = *(const LAS3 f32x4*)&nst[16 * ks + 8 * hh + 4];
            float qv[8]; unpack8(__builtin_bit_cast(u32x4, qf[ks]), qv);
            qn += (qv[0] * n0[0] + qv[1] * n0[1]) + (qv[2] * n0[2] + qv[3] * n0[3]) + (qv[4] * n1[0] + qv[5] * n1[1]) + (qv[6] * n1[2] + qv[7] * n1[3]); }
        qn += __shfl_xor(qn, 32);
        __syncthreads();
        u32x4 vq[8];
#pragma unroll
        for (int i = 0; i < 8; ++i) { const int e8 = tid + 512 * i, s = e8 >> 5, v8 = e8 & 31; vq[i] = *(const u32x4*)(Vb + (size_t)(r0 + s) * 2048 + h * 256 + v8 * 8); }
        const float MMt = MM[t], isct = isc[t];
        bf16x8 pf[8]; float dsum = 0.f;
#pragma unroll
        for (int sb = 0; sb < 4; ++sb) {
            u32x4 w0 = (u32x4){0u, 0u, 0u, 0u}, w1 = (u32x4){0u, 0u, 0u, 0u};
            if (sb <= tb) {
                float pv[16];
#pragma unroll
                for (int rg = 0; rg < 4; ++rg) { const f32x4 c4 = *(const LAS3 f32x4*)&cc[sb * 32 + 8 * rg + 4 * hh];
#pragma unroll
                    for (int e = 0; e < 4; ++e) { const int s = sb * 32 + 8 * rg + 4 * hh + e; const float pvv = (s <= t) ? __expf(c4[e] - MMt) * accS[sb][rg * 4 + e] : 0.f; pv[rg * 4 + e] = pvv; dsum += pvv; } }
                w0.x = pk2(pv[0], pv[1]); w0.y = pk2(pv[2], pv[3]); w0.z = pk2(pv[4], pv[5]); w0.w = pk2(pv[6], pv[7]);
                w1.x = pk2(pv[8], pv[9]); w1.y = pk2(pv[10], pv[11]); w1.z = pk2(pv[12], pv[13]); w1.w = pk2(pv[14], pv[15]);
            }
            pf[2 * sb] = __builtin_bit_cast(bf16x8, w0); pf[2 * sb + 1] = __builtin_bit_cast(bf16x8, w1);
        }
#pragma unroll
        for (int vb = 0; vb < 4; ++vb)
#pragma unroll
            for (int r = 0; r < 16; ++r) acc[vb][r] *= isct;
#pragma unroll
        for (int i = 0; i < 8; ++i) { const int e8 = tid + 512 * i, s = e8 >> 5, v8 = e8 & 31; *(LAS3 u32x4*)(RA + s * RS_V + v8 * 16) = vq[i]; }
        __syncthreads();
        {
            const int blk = (lane >> 4) & 1, q = (lane & 15) >> 2, p = lane & 3;
            const int trv = (q + 4 * hh) * RS_V + (vh * 128 + 16 * blk + 4 * p) * 2;
#pragma unroll
            for (int sp = 0; sp < 8; ++sp) {
                if (sp <= 2 * tb + 1) {
#pragma unroll
                    for (int vb = 0; vb < 4; ++vb) { const bf16x8 af = tr_frag(RA, trv + 16 * sp * RS_V + vb * 64, trv + (16 * sp + 8) * RS_V + vb * 64);
                        acc[vb] = __builtin_amdgcn_mfma_f32_32x32x16_bf16(af, pf[sp], acc[vb], 0, 0, 0); }
                }
            }
        }
        dsum += __shfl_xor(dsum, 32);
        const float den = isct * qn + dsum, dn = fmaxf(fabsf(den), __expf(-(bb[t] + MMt))), inv = 1.0f / dn;
        float ssq = 0.f;
#pragma unroll
        for (int vb = 0; vb < 4; ++vb)
#pragma unroll
            for (int r = 0; r < 16; ++r) { acc[vb][r] *= inv; ssq += acc[vb][r] * acc[vb][r]; }
        ssq += __shfl_xor(ssq, 32);
        if (hh == 0) red[t * 2 + vh] = ssq;
        __syncthreads();
        const float rn = rsqrtf((red[t * 2] + red[t * 2 + 1]) * (1.0f / 256.0f) + EPS);
#pragma unroll
        for (int vb = 0; vb < 4; ++vb)
#pragma unroll
            for (int rg = 0; rg < 4; ++rg) { const int v0 = (vh * 4 + vb) * 32 + 8 * rg + 4 * hh; const f32x4 g4 = *(const f32x4*)(mhg + h * 256 + v0);
                u32x2 w; w.x = pk2(acc[vb][rg * 4 + 0] * rn * g4[0], acc[vb][rg * 4 + 1] * rn * g4[1]); w.y = pk2(acc[vb][rg * 4 + 2] * rn * g4[2], acc[vb][rg * 4 + 3] * rn * g4[3]);
                *(u32x2*)(Vb + (size_t)(r0 + t) * 2048 + h * 256 + v0) = w; }
        __syncthreads();
    }
}

constexpr int NPHASE = 1 + 8 * DEPTH;
__host__ __device__ constexpr bool phase_exists(int ph) { return ph == 0 || !((((ph - 1) >> 3) & 1) == 0 && (((ph - 1) & 7) == 2 || ((ph - 1) & 7) == 3)); }
struct Args { const float* in[18]; float* out; unsigned char* ws; int ph_lo, ph_hi; };

__global__ void __launch_bounds__(512, 2) fwd(Args args) {
    extern __shared__ __attribute__((aligned(16))) unsigned char lds_raw[];
    LAS3 unsigned char* lds = (LAS3 unsigned char*)lds_raw;
    const int tid0 = threadIdx.x, bid = blockIdx.x, G = gridDim.x;
    Ptrs P; P.out = args.out; P.ws = args.ws;
    const int lo0 = args.ph_lo, hi0 = args.ph_hi;
    const bool multi = (hi0 - lo0) > 1;
    XcdBarrier bar; bar.bar = (unsigned*)(P.ws + WS_CTL); bar.x = 0; bar.st = nullptr;
    if (multi) {
        if (tid0 < 4) ((LAS3 unsigned*)(lds + LDS_BAR_OFF))[tid0] = 0u;
        __syncthreads();
        bar = xcd_barrier_post((unsigned*)(P.ws + WS_CTL), (volatile LAS unsigned*)(lds + LDS_BAR_OFF));
    }
#ifndef PHMASK
#define PHMASK 0xFFFF
#endif
#define PHM(k) (((PHMASK) >> (k)) & 1)
#ifndef DUPMASK
#define DUPMASK 0
#endif
#define DUPN(k) ((((DUPMASK) >> (k)) & 1) ? 2 : 1)
#define RUN(ph) (lo <= (ph) && (ph) < hi)
#define SEAM(ph) do { if ((ph) + 1 < hi) xcd_barrier(bar); } while (0)
    bf16_t* const HBA = (bf16_t*)(P.ws + WS_HBA); bf16_t* const WIN = (bf16_t*)(P.ws + WS_WIN); bf16_t* const WOUT = (bf16_t*)(P.ws + WS_WOUT);
    bf16_t* const R1 = (bf16_t*)(P.ws + WS_R1); bf16_t* const R2 = (bf16_t*)(P.ws + WS_R2); bf16_t* const R3 = (bf16_t*)(P.ws + WS_R3); bf16_t* const R4 = (bf16_t*)(P.ws + WS_R4);
    float* const SSQA = (float*)(P.ws + WS_SSQA); float* const SSQY = (float*)(P.ws + WS_SSQY);

    { const int tid = tid0, lo = lo0, hi = hi0; if (PHM(0) && RUN(0)) { phase_prologue(P, G, bid, tid); SEAM(0); } }
#pragma unroll 1
    for (int L = 0; L < DEPTH; ++L) {
        int tid = tid0, lo = lo0, hi = hi0; asm volatile("" : "+v"(tid), "+s"(lo), "+s"(hi));
        const int pb = 1 + 8 * L, j = L >> 1;
        if ((L & 1) == 0) {
            if (PHM(1) && RUN(pb + 0)) { for (int rep = 0; rep < DUPN(1); ++rep) { pg8::Gemm g{HBA, WIN, M, N1A_E, DM}; pg8::StaticOrder S; S.init(M, N1A_E, G, bid);
                pg8::EpiE1a E{SSQA, R1, R2}; pg8::gemm_phase<pg8::EpiE1a, pg8::StaticOrder>(lds, g, S, E, nullptr); } SEAM(pb + 0); }
            if (PHM(2) && RUN(pb + 1)) { for (int rep = 0; rep < DUPN(2); ++rep) phase_gm(lds, P, j, G, bid, tid); SEAM(pb + 1); }
            if (PHM(3) && RUN(pb + 4)) { for (int rep = 0; rep < DUPN(3); ++rep) { pg8::Gemm g{HBA, WIN + (size_t)N1A_E * DM, M, N1B_E, DM}; pg8::StaticOrder S; S.init(M, N1B_E, G, bid);
                pg8::EpiE1b E{SSQA, R1, R3, INP(8) + (size_t)j * 3 * 1024, R4}; pg8::gemm_phase<pg8::EpiE1b, pg8::StaticOrder>(lds, g, S, E, nullptr); } SEAM(pb + 4); }
        } else {
            if (PHM(4) && RUN(pb + 0)) { for (int rep = 0; rep < DUPN(4); ++rep) { pg8::Gemm g{HBA, WIN, M, N1A_O, DM}; pg8::StaticOrder S; S.init(M, N1A_O, G, bid);
                pg8::EpiO1a E{SSQA, R1, R2, R3, (float*)(P.ws + WS_GATE)}; pg8::gemm_phase<pg8::EpiO1a, pg8::StaticOrder>(lds, g, S, E, nullptr); } SEAM(pb + 0); }
            if (PHM(5) && RUN(pb + 1)) { for (int rep = 0; rep < DUPN(5); ++rep) phase_o2(lds, P, j, G, bid, tid); SEAM(pb + 1); }
            if (PHM(6) && RUN(pb + 2)) { phase_o3(lds, P, G, bid, tid); SEAM(pb + 2); }
            if (PHM(7) && RUN(pb + 3)) { phase_o4(lds, P, j, G, bid, tid); SEAM(pb + 3); }
            if (PHM(8) && RUN(pb + 4)) { for (int rep = 0; rep < DUPN(8); ++rep) { pg8::Gemm g{HBA, WIN + (size_t)N1A_O * DM, M, N1B_O, DM}; pg8::StaticOrder S; S.init(M, N1B_O, G, bid);
                pg8::EpiO1b E{SSQA, R3, R4}; pg8::gemm_phase<pg8::EpiO1b, pg8::StaticOrder>(lds, g, S, E, nullptr); } SEAM(pb + 4); }
        }
        if (PHM(9) && RUN(pb + 5)) { for (int rep = 0; rep < DUPN(9); ++rep) { pg8::Gemm g{R4, WOUT, M, DM, 2048}; pg8::StaticOrder S; S.init(M, DM, G, bid);
            pg8::EpiOut E{R1, SSQY}; pg8::gemm_phase<pg8::EpiOut, pg8::StaticOrder>(lds, g, S, E, nullptr); } SEAM(pb + 5); }
        if (PHM(10) && RUN(pb + 6)) { phase_p4(P, L, G, bid, tid); SEAM(pb + 6); }
        if (PHM(11) && RUN(pb + 7)) {
            { pg8::Gemm g{R3 + (size_t)32 * MiB, (bf16_t*)(P.ws + WS_WP) + (size_t)L * DM * PLE, M, DM, PLE}; pg8::StaticOrder S; S.init(M, DM, G, bid);
              pg8::EpiPw E{R2}; pg8::gemm_phase<pg8::EpiPw, pg8::StaticOrder>(lds, g, S, E, nullptr); }
            __syncthreads();
            { pg8::Gemm g{R3, (bf16_t*)(P.ws + WS_WG) + (size_t)L * DM * DM, M, DM, DM}; pg8::StaticOrder S; S.init(M, DM, G, bid);
              pg8::EpiGate E{(const float*)(P.ws + WS_RSTD1), R2, R3, HBA, SSQA, (L == DEPTH - 1) ? P.out : nullptr}; pg8::gemm_phase<pg8::EpiGate, pg8::StaticOrder>(lds, g, S, E, nullptr); }
            SEAM(pb + 7);
        }
    }
#undef RUN
#undef SEAM
}

#ifndef ONE_LAUNCH
#define ONE_LAUNCH 1
#endif
extern "C" void kernel_launch(void* const* d_in, const int* in_sizes, int n_in, void* d_out, int out_size, void* d_ws, size_t ws_size, hipStream_t stream) {
    static int grid = 0;
    if (grid == 0) {
        if (n_in != 18 || out_size != M * DM || ws_size < WS_END) { fprintf(stderr, "kernel_launch: unexpected shapes (n_in %d out %d ws %zu)\n", n_in, out_size, ws_size); grid = -1; return; }
        int dev = 0, cus = 0, per_cu = 0;
        if (hipGetDevice(&dev) != hipSuccess || hipDeviceGetAttribute(&cus, hipDeviceAttributeMultiprocessorCount, dev) != hipSuccess) { grid = -1; return; }
        if (hipFuncSetAttribute((const void*)fwd, hipFuncAttributeMaxDynamicSharedMemorySize, LDS_BYTES) != hipSuccess) { fprintf(stderr, "kernel_launch: hipFuncSetAttribute failed\n"); grid = -1; return; }
        if (hipOccupancyMaxActiveBlocksPerMultiprocessor(&per_cu, (const void*)fwd, 512, LDS_BYTES) != hipSuccess || per_cu < 1) { fprintf(stderr, "kernel_launch: occupancy query says %d\n", per_cu); }
        (void)hipGetLastError();
        grid = cus;
    }
    if (grid < 0) return;
    (void)hipMemsetAsync((char*)d_ws + WS_CTL, 0, CTL_BYTES, stream);
    Args a{};
    for (int i = 0; i < 18; ++i) a.in[i] = (const float*)d_in[i];
    a.out = (float*)d_out; a.ws = (unsigned char*)d_ws;
#if ONE_LAUNCH
    a.ph_lo = 0; a.ph_hi = NPHASE;
    hipLaunchKernelGGL(fwd, dim3(grid), dim3(512), LDS_BYTES, stream, a);
#else
    for (int ph = 0; ph < NPHASE; ++ph) { if (!phase_exists(ph)) continue; a.ph_lo = ph; a.ph_hi = ph + 1; hipLaunchKernelGGL(fwd, dim3(grid), dim3(512), LDS_BYTES, stream, a); }
#endif
}
```

```cpp
#include <hip/hip_runtime.h>
#include <cstdio>
#include <cstdint>
namespace pg8 {
#define PG8_LAS __attribute__((address_space(3)))
typedef unsigned short bf16_t;
typedef short bf16x8 __attribute__((ext_vector_type(8)));
typedef float f32x4 __attribute__((ext_vector_type(4)));
typedef unsigned u32x4 __attribute__((ext_vector_type(4)));
constexpr int BM = 256, BK = 64, HALF = 128, HTB = HALF * BK * 2  , STAGE_BYTES = 8 * HTB, NXCD = 8, WGM = 8;

__host__ __device__ __forceinline__ int lds_byte(int r, int c) { const int st = (r >> 4) * 2 + (c >> 5), rr = r & 15, cc = c & 31, ob = rr * 64 + cc * 2; return st * 1024 + (ob ^ (((ob >> 9) & 1) << 5)); }
__host__ __device__ __forceinline__ void stage_rc(int b, int& R, int& C) { const int st = b / 1024, sb = b % 1024, swz = sb ^ (((sb >> 9) & 1) << 5); R = (st >> 1) * 16 + swz / 64; C = (st & 1) * 32 + (swz % 64) / 2; }
__host__ __device__ __forceinline__ int perm32(int rho) { const int n = rho >> 4, i = rho & 15; return 8 * (i >> 2) + 4 * n + (i & 3); }

struct Unit { int pm, pn; };
struct Gemm { const bf16_t* A; const bf16_t* Bt; int M, N, K; };

struct StaticOrder {
    int nM, nN, nwg, G, c;
    __host__ __device__ void init(int M, int N, int G_, int c_) { nM = M / BM; nN = N / BM; nwg = nM * nN; G = G_; c = c_; }
    __host__ __device__ bool next(int i, Unit& u) const {
        const long L = (long)i * G + c; if (L >= nwg) return false;
        int wgid = (int)L; { const int q = nwg / NXCD, r = nwg % NXCD, xcd = wgid % NXCD, off = wgid / NXCD; wgid = (xcd < r ? xcd * (q + 1) : r * (q + 1) + (xcd - r) * q) + off; }
        const int nig = WGM * nN, gid = wgid / nig, fm = gid * WGM, gsz = (nM - fm) < WGM ? (nM - fm) : WGM;
        u.pm = fm + ((wgid % nig) % gsz); u.pn = (wgid % nig) / gsz; return true;
    }
    __device__ __forceinline__ void a_ready(const Unit&) const {}
    __device__ __forceinline__ void done(const Unit&) const {}
};
__device__ __forceinline__ unsigned cvt_pk_bf16(float lo, float hi) { unsigned r; asm volatile("v_cvt_pk_bf16_f32 %0, %1, %2" : "=v"(r) : "v"(lo), "v"(hi)); return r; }
typedef float f32x2 __attribute__((ext_vector_type(2)));
template <class Epi, class Sched, bool STAMP = false>
__device__ __forceinline__ void gemm_phase(PG8_LAS unsigned char* lds, const Gemm g, const Sched& S, const Epi& E, unsigned long long* stamps, int wbase) {
    int tid_l_; { unsigned z_ = 0u; asm volatile("" : "+v"(z_)); tid_l_ = wbase + (int)__builtin_amdgcn_mbcnt_hi(~0u, __builtin_amdgcn_mbcnt_lo(~0u, z_)); }
    const int tid = tid_l_, wid = __builtin_amdgcn_readfirstlane(tid >> 6), lane = tid & 63, wr = wid >> 2, wc = wid & 3, fr = lane & 15, fq = lane >> 4;
    const int K = g.K, nt = K / BK;
    int ts_lo = 0, ts_hi = 0, nts = 0; const unsigned long long rt_entry = STAMP ? (unsigned long long)wall_clock64() : 0ull;
#define PG8_STAMP() do { if (STAMP && wid == 0 && nts < 64) { const unsigned long long _c = (unsigned long long)clock64(); \
        ts_lo = (lane == nts) ? (int)(unsigned)_c : ts_lo; ts_hi = (lane == nts) ? (int)(unsigned)(_c >> 32) : ts_hi; ++nts; } } while (0)
    PG8_STAMP();
    unsigned voffA[2], voffB[2];
#pragma unroll
    for (int i = 0; i < 2; ++i) { int R, C; stage_rc(tid * 16 + i * 8192, R, C); const int Rb = Epi::PERM ? ((R & ~31) + perm32(R & 31)) : R;
        voffA[i] = (unsigned)(R * K + C) * 2u; voffB[i] = (unsigned)(Rb * K + C) * 2u; }
    const size_t kstep = (size_t)(BK * 2);
    const size_t hstep = (size_t)HALF * K * 2;
    const size_t tstep = 2 * hstep;
    const unsigned ldsw = (unsigned)wid * 1024u;
    const int aoff = lds_byte(wr * 64 + fr, fq * 8), boff = lds_byte(wc * 32 + fr, fq * 8);
#define PG8_SA(b, h) (((b) * 2 + (h)) * HTB)
#define PG8_SB(b, h) ((4 + (b) * 2 + (h)) * HTB)
#define PG8_STAGE(bufoff, gbase, voff) do { _Pragma("unroll") for (int _i = 0; _i < 2; ++_i) \
        __builtin_amdgcn_global_load_lds((const unsigned*)((const char*)(gbase) + (voff)[_i]), (PG8_LAS unsigned*)(lds + (bufoff) + ldsw + _i * 8192), 16, 0, 0); } while (0)
#define PG8_LDA(dst, b, h) do { _Pragma("unroll") for (int m = 0; m < 4; ++m) _Pragma("unroll") for (int k = 0; k < 2; ++k) dst[m][k] = *(const PG8_LAS bf16x8*)(lds + PG8_SA(b, h) + aoff + m * 2048 + k * 1024); } while (0)
#define PG8_LDB(dst, b, h) do { _Pragma("unroll") for (int n = 0; n < 2; ++n) _Pragma("unroll") for (int k = 0; k < 2; ++k) dst[n][k] = *(const PG8_LAS bf16x8*)(lds + PG8_SB(b, h) + boff + n * 2048 + k * 1024); } while (0)
#define PG8_MMA(ai, bj, At, Bt) do { __builtin_amdgcn_s_setprio(1); _Pragma("unroll") for (int m = 0; m < 4; ++m) _Pragma("unroll") for (int n = 0; n < 2; ++n) _Pragma("unroll") for (int k = 0; k < 2; ++k) \
        acc[ai][bj][m][n] = __builtin_amdgcn_mfma_f32_16x16x32_bf16(Bt[n][k], At[m][k], acc[ai][bj][m][n], 0, 0, 0); __builtin_amdgcn_s_setprio(0); } while (0)
#define PG8_WAIT_V(n) asm volatile("s_waitcnt vmcnt(" #n ")" ::: "memory")
#define PG8_WAIT_L(n) asm volatile("s_waitcnt lgkmcnt(" #n ")" ::: "memory")
#define PG8_BAR __builtin_amdgcn_s_barrier()
#define PG8_SCHED __builtin_amdgcn_sched_barrier(0)
    Unit cur, nxt; int ui = 0;
    if (!S.next(0, cur)) return;
    f32x4 acc[2][2][4][2];
#pragma unroll
    for (int a = 0; a < 2; ++a)
#pragma unroll
        for (int b = 0; b < 2; ++b)
#pragma unroll
            for (int m = 0; m < 4; ++m)
#pragma unroll
                for (int n = 0; n < 2; ++n) acc[a][b][m][n] = (f32x4){0.f, 0.f, 0.f, 0.f};
    bf16x8 At[4][2], B0[2][2], B1[2][2];
    const char* cA = (const char*)g.A + (size_t)cur.pm * tstep; const char* cB = (const char*)g.Bt + (size_t)cur.pn * tstep;
    S.a_ready(cur);
    PG8_STAGE(PG8_SB(0, 0), cB, voffB); PG8_STAGE(PG8_SA(0, 0), cA, voffA); PG8_STAGE(PG8_SB(0, 1), cB + hstep, voffB); PG8_STAGE(PG8_SA(0, 1), cA + hstep, voffA);
    if (wr == 1) PG8_BAR;
    PG8_WAIT_V(4); PG8_BAR;
    PG8_STAGE(PG8_SB(1, 0), cB + kstep, voffB); PG8_STAGE(PG8_SA(1, 0), cA + kstep, voffA); PG8_STAGE(PG8_SB(1, 1), cB + hstep + kstep, voffB);
    PG8_WAIT_V(6); PG8_BAR;
    PG8_STAMP();
    for (;;) {
        const bool has_next = S.next(ui + 1, nxt);
        const char* nA = has_next ? (const char*)g.A + (size_t)nxt.pm * tstep : cA; const char* nB = has_next ? (const char*)g.Bt + (size_t)nxt.pn * tstep : cB;
        for (int t = 0; t < nt; t += 2) {
            const bool last = (t == nt - 2);
            const char* a1 = cA + (size_t)(t + 1) * kstep;
            const char* a2 = last ? nA : cA + (size_t)(t + 2) * kstep; const char* b2 = last ? nB : cB + (size_t)(t + 2) * kstep;
            const char* a3 = a2 + kstep; const char* b3 = b2 + kstep;
            if (last && has_next) S.a_ready(nxt);
            PG8_LDB(B0, 0, 0); PG8_SCHED; PG8_LDA(At, 0, 0); PG8_STAGE(PG8_SA(1, 1), a1 + hstep, voffA);
            PG8_WAIT_L(8); PG8_BAR; PG8_WAIT_L(0); PG8_MMA(0, 0, At, B0); PG8_BAR; PG8_SCHED;
            PG8_LDB(B1, 0, 1); PG8_STAGE(PG8_SB(0, 0), b2, voffB);
            PG8_BAR; PG8_WAIT_L(0); PG8_MMA(0, 1, At, B1); PG8_BAR;
            PG8_LDA(At, 0, 1); PG8_STAGE(PG8_SA(0, 0), a2, voffA);
            PG8_BAR; PG8_WAIT_L(0); PG8_MMA(1, 0, At, B0); PG8_BAR; PG8_SCHED;
            PG8_STAGE(PG8_SB(0, 1), b2 + hstep, voffB);
            PG8_WAIT_V(6); PG8_BAR; PG8_MMA(1, 1, At, B1); PG8_BAR;
            PG8_LDB(B0, 1, 0); PG8_SCHED; PG8_LDA(At, 1, 0); PG8_STAGE(PG8_SA(0, 1), a2 + hstep, voffA);
            PG8_WAIT_L(8); PG8_BAR; PG8_WAIT_L(0); PG8_MMA(0, 0, At, B0); PG8_BAR; PG8_SCHED;
            PG8_LDB(B1, 1, 1); PG8_STAGE(PG8_SB(1, 0), b3, voffB);
            PG8_BAR; PG8_WAIT_L(0); PG8_MMA(0, 1, At, B1); PG8_BAR;
            PG8_LDA(At, 1, 1); PG8_STAGE(PG8_SA(1, 0), a3, voffA);
            PG8_BAR; PG8_WAIT_L(0); PG8_MMA(1, 0, At, B0); PG8_BAR; PG8_SCHED;
            PG8_STAGE(PG8_SB(1, 1), b3 + hstep, voffB);
            PG8_WAIT_V(6); PG8_BAR; PG8_MMA(1, 1, At, B1); PG8_BAR;
        }
        PG8_STAMP();
        if constexpr (!Epi::AFTER_DRAIN) { int fr_e = fr, fq_e = fq, wr_e = wr, wc_e = wc; asm volatile("" : "+v"(fr_e), "+v"(fq_e), "+s"(wr_e), "+s"(wc_e));
            E(acc, cur, wr_e, wc_e, fr_e, fq_e);
            if constexpr (Epi::PROBE2) { asm volatile("" ::: "memory"); E(acc, cur, wr_e, wc_e, fr_e, fq_e); }
            S.done(cur); }
        PG8_STAMP();
        if (!has_next) break;
#pragma unroll
        for (int a = 0; a < 2; ++a)
#pragma unroll
            for (int b = 0; b < 2; ++b)
#pragma unroll
                for (int m = 0; m < 4; ++m)
#pragma unroll
                    for (int n = 0; n < 2; ++n) acc[a][b][m][n] = (f32x4){0.f, 0.f, 0.f, 0.f};
        cur = nxt; cA = nA; cB = nB; ++ui;
    }
    PG8_WAIT_V(0);
    if (wr == 0) PG8_BAR;
    PG8_BAR;
    if constexpr (Epi::AFTER_DRAIN) { E.fused(acc, cur, wr, wc, fr, fq, lds, wid, lane); S.done(cur); }
    PG8_STAMP();
    if (STAMP && wid == 0) { stamps[lane] = lane < nts ? (((unsigned long long)(unsigned)ts_hi << 32) | (unsigned)ts_lo) : 0ull;
        if (lane == 62) stamps[62] = rt_entry; if (lane == 63) stamps[63] = (unsigned long long)wall_clock64(); }
#undef PG8_STAMP
#undef PG8_SA
#undef PG8_SB
#undef PG8_STAGE
#undef PG8_LDA
#undef PG8_LDB
#undef PG8_MMA
#undef PG8_WAIT_V
#undef PG8_WAIT_L
#undef PG8_BAR
#undef PG8_SCHED
}
}
#define XB_TMO      128
#define XB_XCNT(j)  (256  + 64 * (j))
#define XB_XSUB(j)  (1280 + 64 * (j))
#define XB_XGEN(j)  (2304 + 64 * (j))
#define XB_TOP      3328
#define XB_TOPGEN   3392
#define XCD_BAR_WORDS 3456
#define XB_SPIN_CAP (1u << 18)
#define LAS __attribute__((address_space(3)))

__device__ __forceinline__ unsigned xb_ld(unsigned* p)              { return __hip_atomic_load(p, __ATOMIC_RELAXED, __HIP_MEMORY_SCOPE_AGENT); }
__device__ __forceinline__ unsigned xb_add(unsigned* p, unsigned v) { return __hip_atomic_fetch_add(p, v, __ATOMIC_RELAXED, __HIP_MEMORY_SCOPE_AGENT); }
__device__ __forceinline__ unsigned xb_xcc_id() { return (unsigned)__builtin_amdgcn_s_getreg((3 << 11) | 20) & 0xFu; }
#define XB_SPIN(cond, bar) do { unsigned _sp = 0; while (cond) { __builtin_amdgcn_s_sleep(1); \
    if ((++_sp & 255u) == 0u) { if (xb_ld(&(bar)[XB_TMO])) break; if (_sp > XB_SPIN_CAP) { atomicAdd(&(bar)[XB_TMO], 1u); break; } } } } while (0)

struct XcdBarrier {
    unsigned* bar; unsigned x;
    volatile LAS unsigned* st;
};

__device__ __forceinline__ XcdBarrier xcd_barrier_post(unsigned* bar, volatile LAS unsigned* st) {
    XcdBarrier b; b.bar = bar; b.x = xb_xcc_id(); b.st = st;
    if (threadIdx.x == 0) (void)xb_add(&bar[XB_XCNT(b.x)], 1u);
    return b;
}
__device__ __forceinline__ void xcd_barrier_complete(unsigned* bar, unsigned x_in, unsigned& nloc, unsigned& nx) {
    unsigned x = x_in;
    const unsigned G = gridDim.x * gridDim.y * gridDim.z;
    asm volatile("" : "+s"(x));
    unsigned sum, cnt, mine, sp = 0u;
    for (;;) {
        sum = 0u; cnt = 0u; mine = 0u;
#pragma unroll
        for (unsigned j = 0; j < 16; ++j) { const unsigned c = xb_ld(&bar[XB_XCNT(j)]); sum += c; cnt += (c > 0u) ? 1u : 0u; mine = (j == x) ? c : mine; }
        if (sum == G) break;
        __builtin_amdgcn_s_sleep(1);
        if ((++sp & 255u) == 0u) { if (xb_ld(&bar[XB_TMO])) break; if (sp > XB_SPIN_CAP) { atomicAdd(&bar[XB_TMO], 1u); break; } }
    }
    nloc = mine > 0u ? mine : 1u; nx = cnt > 0u ? cnt : 1u;
}

__device__ __forceinline__ void xcd_barrier(const XcdBarrier& b) {
    asm volatile("s_waitcnt vmcnt(0)" ::: "memory");
    __syncthreads();
    if (threadIdx.x == 0) {
        unsigned* bar = b.bar;
        __builtin_amdgcn_s_waitcnt(0);
        unsigned nloc = b.st[0], nx = b.st[1];
        if (nloc == 0u) { xcd_barrier_complete(bar, b.x, nloc, nx); b.st[0] = nloc; b.st[1] = nx; }
        const unsigned old = xb_add(&bar[XB_XSUB(b.x)], 1u);
        const unsigned gen = old / nloc;
        if (old + 1u == (gen + 1u) * nloc) {
            __builtin_amdgcn_fence(__ATOMIC_RELEASE, "agent");
            asm volatile("s_waitcnt vmcnt(0)" ::: "memory");
            const unsigned og = xb_add(&bar[XB_TOP], 1u);
            const unsigned tg = og / nx;
            if (og + 1u == (tg + 1u) * nx) xb_add(&bar[XB_TOPGEN], 1u);
            else XB_SPIN(xb_ld(&bar[XB_TOPGEN]) == tg, bar);
            __builtin_amdgcn_fence(__ATOMIC_ACQUIRE, "agent");
            xb_add(&bar[XB_XGEN(b.x)], 1u);
            asm volatile("s_waitcnt vmcnt(0)" ::: "memory");
        } else {
            XB_SPIN(xb_ld(&bar[XB_XGEN(b.x)]) == gen, bar);
            __builtin_amdgcn_fence(__ATOMIC_ACQUIRE, "agent");
            asm volatile("s_waitcnt vmcnt(0)" ::: "memory");
        }
    }
    __syncthreads();
}


typedef unsigned short bf16_t;
typedef float f32x4 __attribute__((ext_vector_type(4)));
typedef unsigned u32x4 __attribute__((ext_vector_type(4)));
typedef unsigned u32x2 __attribute__((ext_vector_type(2)));
constexpr int DM = 1024, NBATCH = 2, SEQ = 16384, M = NBATCH * SEQ, DEPTH = 4, PLE = 256;
constexpr float EPS = 1e-6f;
constexpr int EVEN_IN = 7168, ODD_IN = 8208;
constexpr int N1A_E = 3072, N1B_E = 4096, N1A_O = 4352, N1B_O = 4096;
constexpr int NUNIT_O = 2048;
constexpr int LDS_BYTES = 147456;
constexpr int LDS_BAR_OFF = LDS_BYTES - 16;

constexpr size_t MiB = 1u << 20;
constexpr size_t WS_CTL = 0, CTL_BYTES = 64 * 1024;
constexpr size_t WS_SSQA = 1 * MiB, WS_SSQY = 3 * MiB, WS_RSTD1 = 5 * MiB, WS_GATE = 6 * MiB, WS_GB = 8 * MiB, WS_CS = 10 * MiB, WS_MS = 10 * MiB + 65536, WS_NS = 11 * MiB;
constexpr size_t WS_WG = 12 * MiB, WS_WP = 20 * MiB, WS_WIN = 22 * MiB, WS_WOUT = 39 * MiB;
constexpr size_t WS_WSB = 43 * MiB;
constexpr size_t WS_HBA = 44 * MiB, WS_R1 = 108 * MiB, WS_R2 = 172 * MiB, WS_R3 = 236 * MiB, WS_R4 = 364 * MiB, WS_END = 492 * MiB;

__device__ __forceinline__ float bf2f(bf16_t b) { return __uint_as_float(((unsigned)b) << 16); }
__device__ __forceinline__ bf16_t f2bf(float f) { unsigned u = __float_as_uint(f); u += 0x7FFFu + ((u >> 16) & 1u); return (bf16_t)(u >> 16); }
__device__ __forceinline__ unsigned pk2(float lo, float hi) { return pg8::cvt_pk_bf16(lo, hi); }
__device__ __forceinline__ void unpack8(const u32x4 w, float (&f)[8]) {
    f[0] = __uint_as_float(w.x << 16); f[1] = __uint_as_float(w.x & 0xffff0000u); f[2] = __uint_as_float(w.y << 16); f[3] = __uint_as_float(w.y & 0xffff0000u);
    f[4] = __uint_as_float(w.z << 16); f[5] = __uint_as_float(w.z & 0xffff0000u); f[6] = __uint_as_float(w.w << 16); f[7] = __uint_as_float(w.w & 0xffff0000u);
}
__device__ __forceinline__ u32x4 pack8(const float (&f)[8]) { u32x4 w; w.x = pk2(f[0], f[1]); w.y = pk2(f[2], f[3]); w.z = pk2(f[4], f[5]); w.w = pk2(f[6], f[7]); return w; }
__device__ __forceinline__ float sigmoidf_(float x) { return __builtin_amdgcn_rcpf(1.0f + __expf(-x)); }
__device__ __forceinline__ float siluf_(float x) { return x * sigmoidf_(x); }
__device__ __forceinline__ float logsigmoidf_(float x) { return fminf(x, 0.f) - __logf(1.0f + __expf(-fabsf(x))); }
__device__ __forceinline__ float bperm(int srclane, float v) { return __int_as_float(__builtin_amdgcn_ds_bpermute(srclane << 2, __float_as_int(v))); }
__device__ __forceinline__ float wave_sum(float s, int lane) { s += bperm(lane ^ 1, s); s += bperm(lane ^ 2, s); s += bperm(lane ^ 4, s); s += bperm(lane ^ 8, s); s += bperm(lane ^ 16, s); s += bperm(lane ^ 32, s); return s; }
__device__ __forceinline__ float rstd16(const float* p) {
    const f32x4 a = *(const f32x4*)p, b = *(const f32x4*)(p + 4), c = *(const f32x4*)(p + 8), d = *(const f32x4*)(p + 12);
    const float s = ((a[0] + a[1]) + (a[2] + a[3])) + ((b[0] + b[1]) + (b[2] + b[3])) + ((c[0] + c[1]) + (c[2] + c[3])) + ((d[0] + d[1]) + (d[2] + d[3]));
    return rsqrtf(s * (1.0f / 1024.0f) + EPS);
}

namespace pg8 {
#ifdef EPI_TWICE
constexpr bool EPI_TWICE_ = true;
#else
constexpr bool EPI_TWICE_ = false;
#endif
#define EPI_ROWS_BEGIN  _Pragma("unroll") for (int ai = 0; ai < 2; ++ai) _Pragma("unroll") for (int m = 0; m < 4; ++m) { const int row = rowb + ai * HALF + m * 16;
#define EPI_ROWS_END    }
__device__ __forceinline__ void row_scales16(const float* ssq, int rowb, int fr, int fq, float (&rs)[2][4]) {
    const float a = rstd16(ssq + (size_t)(rowb + fq * 16) * 16), b = rstd16(ssq + (size_t)(rowb + HALF + fq * 16) * 16);
#pragma unroll
    for (int m = 0; m < 4; ++m) { rs[0][m] = bperm(fr + 16 * m, a); rs[1][m] = bperm(fr + 16 * m, b); }
}
#define EPI_STORE8(ptr, v0, v1) do { u32x4 w_; w_.x = cvt_pk_bf16((v0)[0], (v0)[1]); w_.y = cvt_pk_bf16((v0)[2], (v0)[3]); w_.z = cvt_pk_bf16((v1)[0], (v1)[1]); w_.w = cvt_pk_bf16((v1)[2], (v1)[3]); *(u32x4*)(ptr) = w_; } while (0)
struct EpiE1a { static constexpr bool PERM = true, AFTER_DRAIN = false, PROBE2 = EPI_TWICE_;
    const float* ssq; bf16_t* U; bf16_t* BV;
    __device__ __forceinline__ void operator()(const f32x4 (&acc)[2][2][4][2], const Unit& u, int wr, int wc, int fr, int fq) const {
        const int rowb = u.pm * BM + wr * 64 + fr, cw = wc * 32 + 8 * fq;
        float rsv[2][4]; row_scales16(ssq, rowb, fr, fq, rsv);
        EPI_ROWS_BEGIN
            const float rs = rsv[ai][m];
            if (u.pn < 8) {
                const f32x4 p0 = (acc[ai][0][m][0] * rs) * (acc[ai][1][m][0] * rs), p1 = (acc[ai][0][m][1] * rs) * (acc[ai][1][m][1] * rs);
                EPI_STORE8(U + (size_t)row * 1024 + u.pn * 128 + cw, p0, p1);
            } else {
#pragma unroll
                for (int bj = 0; bj < 2; ++bj) { const f32x4 v0 = acc[ai][bj][m][0] * rs, v1 = acc[ai][bj][m][1] * rs;
                    EPI_STORE8(BV + (size_t)row * 1024 + (u.pn - 8) * 256 + bj * HALF + cw, v0, v1); }
            }
        }
    }
};
struct EpiE1b { static constexpr bool PERM = true, AFTER_DRAIN = false, PROBE2 = EPI_TWICE_;
    const float* ssq; const bf16_t* CU; const bf16_t* S; bf16_t* MIX;
    __device__ __forceinline__ void operator()(const f32x4 (&acc)[2][2][4][2], const Unit& u, int wr, int wc, int fr, int fq) const {
        const int rowb = u.pm * BM + wr * 64 + fr, cw = wc * 32 + 8 * fq;
        float rsv[2][4]; row_scales16(ssq, rowb, fr, fq, rsv);
        const bool isA = u.pn < 8;
        const int ch0 = (isA ? u.pn : u.pn - 8) * 128 + cw;
        const bf16_t* X = isA ? CU : S; bf16_t* O = MIX + (isA ? 0 : 1024);
        u32x4 sq[2][4];
#pragma unroll
        for (int ai = 0; ai < 2; ++ai)
#pragma unroll
            for (int m = 0; m < 4; ++m) sq[ai][m] = *(const u32x4*)(X + (size_t)(rowb + ai * HALF + m * 16) * 1024 + ch0);
        EPI_ROWS_BEGIN
            const float rs = rsv[ai][m];
            float sv[8]; unpack8(sq[ai][m], sv);
            float o[8];
#pragma unroll
            for (int j = 0; j < 8; ++j) { const float bu = acc[ai][0][m][j >> 2][j & 3] * rs, bg = acc[ai][1][m][j >> 2][j & 3] * rs; o[j] = bu * siluf_(bg) * sv[j]; }
            *(u32x4*)(O + (size_t)row * 2048 + ch0) = pack8(o);
        }
    }
};
struct EpiO1a { static constexpr bool PERM = true, AFTER_DRAIN = false, PROBE2 = EPI_TWICE_;
    const float* ssq; bf16_t* Q; bf16_t* K; bf16_t* V; float* GATE;
    __device__ __forceinline__ void operator()(const f32x4 (&acc)[2][2][4][2], const Unit& u, int wr, int wc, int fr, int fq) const {
        const int rowb = u.pm * BM + wr * 64 + fr, cw = wc * 32 + 8 * fq;
        float rsv[2][4]; row_scales16(ssq, rowb, fr, fq, rsv);
        if (u.pn < 16) {
            bf16_t* base; int ld, c0;
            if (u.pn < 4) { base = Q; ld = 1024; c0 = u.pn * 256; } else if (u.pn < 8) { base = K; ld = 1024; c0 = (u.pn - 4) * 256; } else { base = V; ld = 2048; c0 = (u.pn - 8) * 256; }
            EPI_ROWS_BEGIN
                const float rs = rsv[ai][m];
#pragma unroll
                for (int bj = 0; bj < 2; ++bj) { const f32x4 v0 = acc[ai][bj][m][0] * rs, v1 = acc[ai][bj][m][1] * rs;
                    EPI_STORE8(base + (size_t)row * ld + c0 + bj * HALF + cw, v0, v1); }
            }
        } else if (wc == 0 && fq < 2) {
            EPI_ROWS_BEGIN
                const float rs = rsv[ai][m];
                *(f32x4*)(GATE + (size_t)row * 16 + 8 * fq) = acc[ai][0][m][0] * rs;
                *(f32x4*)(GATE + (size_t)row * 16 + 8 * fq + 4) = acc[ai][0][m][1] * rs;
            }
        }
    }
};
struct EpiO1b { static constexpr bool PERM = true, AFTER_DRAIN = false, PROBE2 = EPI_TWICE_;
    const float* ssq; const bf16_t* HC; bf16_t* MIX;
    __device__ __forceinline__ void operator()(const f32x4 (&acc)[2][2][4][2], const Unit& u, int wr, int wc, int fr, int fq) const {
        const int rowb = u.pm * BM + wr * 64 + fr, ch0 = u.pn * 128 + wc * 32 + 8 * fq;
        float rsv[2][4]; row_scales16(ssq, rowb, fr, fq, rsv);
        u32x4 hq[2][4];
#pragma unroll
        for (int ai = 0; ai < 2; ++ai)
#pragma unroll
            for (int m = 0; m < 4; ++m) hq[ai][m] = *(const u32x4*)(HC + (size_t)(rowb + ai * HALF + m * 16) * 2048 + ch0);
        EPI_ROWS_BEGIN
            const float rs = rsv[ai][m];
            float hv[8]; unpack8(hq[ai][m], hv);
            float o[8];
#pragma unroll
            for (int j = 0; j < 8; ++j) { const float oo = acc[ai][0][m][j >> 2][j & 3] * rs, zz = acc[ai][1][m][j >> 2][j & 3] * rs; o[j] = hv[j] * sigmoidf_(oo) * siluf_(zz); }
            *(u32x4*)(MIX + (size_t)row * 2048 + ch0) = pack8(o);
        }
    }
};
struct EpiOut { static constexpr bool PERM = true, AFTER_DRAIN = false, PROBE2 = EPI_TWICE_;
    bf16_t* Y; float* SSQ;
    __device__ __forceinline__ void operator()(const f32x4 (&acc)[2][2][4][2], const Unit& u, int wr, int wc, int fr, int fq) const {
        const int rowb = u.pm * BM + wr * 64 + fr, cw = wc * 32 + 8 * fq;
        EPI_ROWS_BEGIN
            float s = 0.f;
#pragma unroll
            for (int bj = 0; bj < 2; ++bj) { const f32x4 v0 = acc[ai][bj][m][0], v1 = acc[ai][bj][m][1];
                s += (v0[0] * v0[0] + v0[1] * v0[1]) + (v0[2] * v0[2] + v0[3] * v0[3]) + (v1[0] * v1[0] + v1[1] * v1[1]) + (v1[2] * v1[2] + v1[3] * v1[3]);
                EPI_STORE8(Y + (size_t)row * 1024 + u.pn * 256 + bj * HALF + cw, v0, v1); }
            s += bperm((fr + 16 * fq) ^ 16, s); s += bperm((fr + 16 * fq) ^ 32, s);
            if (fq == 0) SSQ[(size_t)row * 16 + u.pn * 4 + wc] = s;
        }
    }
};
struct EpiPw { static constexpr bool PERM = true, AFTER_DRAIN = false, PROBE2 = false;
    bf16_t* PW;
    __device__ __forceinline__ void operator()(const f32x4 (&acc)[2][2][4][2], const Unit& u, int wr, int wc, int fr, int fq) const {
        const int rowb = u.pm * BM + wr * 64 + fr, cw = wc * 32 + 8 * fq;
        EPI_ROWS_BEGIN
#pragma unroll
            for (int bj = 0; bj < 2; ++bj) { const f32x4 v0 = acc[ai][bj][m][0], v1 = acc[ai][bj][m][1];
                EPI_STORE8(PW + (size_t)row * 1024 + u.pn * 256 + bj * HALF + cw, v0, v1); }
        }
    }
};
struct EpiGate { static constexpr bool PERM = true, AFTER_DRAIN = false, PROBE2 = false;
    const float* RSTD1; const bf16_t* PW; const bf16_t* HB1; bf16_t* HB2; float* SSQ; float* OUT; bool dry;
    __device__ __forceinline__ void operator()(const f32x4 (&acc)[2][2][4][2], const Unit& u, int wr, int wc, int fr, int fq) const {
        const int rowb = u.pm * BM + wr * 64 + fr, cw = wc * 32 + 8 * fq;
        float rsv[2][4];
#pragma unroll
        for (int ai = 0; ai < 2; ++ai)
#pragma unroll
            for (int m = 0; m < 4; ++m) rsv[ai][m] = RSTD1[rowb + ai * HALF + m * 16];
#pragma unroll
        for (int ai = 0; ai < 2; ++ai) {
            u32x4 pq[4][2], hq[4][2];
#pragma unroll
            for (int m = 0; m < 4; ++m)
#pragma unroll
                for (int bj = 0; bj < 2; ++bj) { const size_t off = (size_t)(rowb + ai * HALF + m * 16) * 1024 + u.pn * 256 + bj * HALF + cw; pq[m][bj] = *(const u32x4*)(PW + off); hq[m][bj] = *(const u32x4*)(HB1 + off); }
#pragma unroll
            for (int m = 0; m < 4; ++m) { const int row = rowb + ai * HALF + m * 16; const float rs = rsv[ai][m]; float s = 0.f;
#pragma unroll
                for (int bj = 0; bj < 2; ++bj) { const size_t off = (size_t)row * 1024 + u.pn * 256 + bj * HALF + cw;
                    float pw[8], hv[8]; unpack8(pq[m][bj], pw); unpack8(hq[m][bj], hv);
                    float o[8];
#pragma unroll
                    for (int j = 0; j < 8; ++j) { const float g = sigmoidf_(acc[ai][bj][m][j >> 2][j & 3] * rs); o[j] = hv[j] + g * pw[j]; s += o[j] * o[j]; }
                    if (dry) {} else if (OUT) { *(f32x4*)(OUT + off) = (f32x4){o[0], o[1], o[2], o[3]}; *(f32x4*)(OUT + off + 4) = (f32x4){o[4], o[5], o[6], o[7]}; }
                    else *(u32x4*)(HB2 + off) = pack8(o); }
                s += bperm((fr + 16 * fq) ^ 16, s); s += bperm((fr + 16 * fq) ^ 32, s);
                if (fq == 0 && !dry) SSQ[(size_t)row * 16 + u.pn * 4 + wc] = s; }
            asm volatile("" ::: "memory");
        }
    }
};
}

struct MapE1a { __device__ __forceinline__ int operator()(int np, float& sc) const { sc = 1.f; const int t = np >> 8; if (t < 8) { const int bj = (np >> 7) & 1, c = np & 127; return (bj ? 2048 : 1024) + t * 128 + c; } return 5120 + (np - 2048); } };
struct MapE1b { __device__ __forceinline__ int operator()(int np, float& sc) const { sc = 1.f; const int t = np >> 8, bj = (np >> 7) & 1, c = np & 127; if (t < 8) return (bj ? 3072 : 0) + t * 128 + c; return (bj ? 6144 : 4096) + (t - 8) * 128 + c; } };
struct MapO1a { __device__ __forceinline__ int operator()(int np, float& sc) const { sc = (np < 1024) ? 0.08838834764831845f : 1.f; if (np < 4096) return np; const int c = np - 4096; return c < 16 ? 8192 + c : -1; } };
struct MapO1b { __device__ __forceinline__ int operator()(int np, float& sc) const { sc = 1.f; const int t = np >> 8, bj = (np >> 7) & 1, c = np & 127; return (bj ? 6144 : 4096) + t * 128 + c; } };
struct MapId  { __device__ __forceinline__ int operator()(int np, float& sc) const { sc = 1.f; return np; } };
template <class F> __device__ __forceinline__ void conv_w(bf16_t* dst, const float* src, int K, int Nsrc, int Nrows, const float* gk, F map, int gt, int nth) {
    const int total = Nrows * (K >> 3);
    for (int idx = gt; idx < total; idx += nth) {
        const int np = idx % Nrows, k8 = idx / Nrows; float sc; const int n = map(np, sc);
        float v[8];
#pragma unroll
        for (int j = 0; j < 8; ++j) { const int k = k8 * 8 + j; v[j] = (n >= 0) ? src[(size_t)k * Nsrc + n] * (gk ? gk[k] : 1.f) * sc : 0.f; }
        *(u32x4*)(dst + (size_t)np * K + k8 * 8) = pack8(v);
    }
}

struct Ptrs { float* out; unsigned char* ws; };
template <int I> __device__ __forceinline__ const float* inp_() {
    const unsigned long long ka = (unsigned long long)__builtin_amdgcn_kernarg_segment_ptr(); unsigned long long v;
    asm volatile("s_load_dwordx2 %0, %1, %2\n\ts_waitcnt lgkmcnt(0)" : "=s"(v) : "s"(ka), "n"(I * 8) : "memory");
    return (const float*)v;
}
#define INP(i) (inp_<i>())
#define LAS3 __attribute__((address_space(3)))

__device__ __forceinline__ void prep_layer_weights(const Ptrs& P, int L, int gt, int nth) {
    const int j = L >> 1; bf16_t* WIN = (bf16_t*)(P.ws + WS_WIN); bf16_t* WOUT = (bf16_t*)(P.ws + WS_WOUT);
    const float* pre_g = INP(2) + (size_t)L * DM;
    if ((L & 1) == 0) {
        const float* w = INP(7) + (size_t)j * DM * EVEN_IN;
        conv_w(WIN, w, DM, EVEN_IN, N1A_E, pre_g, MapE1a(), gt, nth);
        conv_w(WIN + (size_t)N1A_E * DM, w, DM, EVEN_IN, N1B_E, pre_g, MapE1b(), gt, nth);
        conv_w(WOUT, INP(13) + (size_t)j * 2048 * DM, 2048, DM, DM, nullptr, MapId(), gt, nth);
        { const float* wsrc = INP(11) + (size_t)j * 8 * 16384; bf16_t* WSB = (bf16_t*)(P.ws + WS_WSB);
          for (int i = gt; i < 8 * 16384 / 8; i += nth) { const int e = i * 8, t = (e >> 7) & 127, s0 = e & 127;
              const f32x4 a = *(const f32x4*)(wsrc + e), b = *(const f32x4*)(wsrc + e + 4); float o[8] = {a[0], a[1], a[2], a[3], b[0], b[1], b[2], b[3]};
#pragma unroll
              for (int q = 0; q < 8; ++q) if (s0 + q > t) o[q] = 0.f;
              *(u32x4*)(WSB + e) = pack8(o); } }
    } else {
        const float* w = INP(14) + (size_t)j * DM * ODD_IN;
        conv_w(WIN, w, DM, ODD_IN, N1A_O, pre_g, MapO1a(), gt, nth);
        conv_w(WIN + (size_t)N1A_O * DM, w, DM, ODD_IN, N1B_O, pre_g, MapO1b(), gt, nth);
        conv_w(WOUT, INP(17) + (size_t)j * 2048 * DM, 2048, DM, DM, nullptr, MapId(), gt, nth);
    }
}

__device__ __forceinline__ void phase_prologue(const Ptrs& P, int G, int bid, int tid) {
    const int lane = tid & 63, wid = tid >> 6;
    const float* x = INP(0); bf16_t* HBA = (bf16_t*)(P.ws + WS_HBA); float* SSQA = (float*)(P.ws + WS_SSQA);
    for (int row = bid * 8 + wid; row < M; row += G * 8) {
        float sq = 0.f;
#pragma unroll
        for (int i = 0; i < 2; ++i) { const size_t off = (size_t)row * DM + i * 512 + lane * 8;
            const f32x4 a = *(const f32x4*)(x + off), b = *(const f32x4*)(x + off + 4);
            const float o[8] = {a[0], a[1], a[2], a[3], b[0], b[1], b[2], b[3]};
#pragma unroll
            for (int j = 0; j < 8; ++j) sq += o[j] * o[j];
            *(u32x4*)(HBA + off) = pack8(o); }
        sq = wave_sum(sq, lane);
        if (lane < 16) SSQA[(size_t)row * 16 + lane] = (lane == 0) ? sq : 0.f;
    }
    const int gt = bid * 512 + tid, nth = G * 512;
    for (int L = 0; L < DEPTH; ++L) {
        conv_w((bf16_t*)(P.ws + WS_WG) + (size_t)L * DM * DM, INP(6) + (size_t)L * DM * DM, DM, DM, DM, INP(4) + (size_t)L * DM, MapId(), gt, nth);
        conv_w((bf16_t*)(P.ws + WS_WP) + (size_t)L * DM * PLE, INP(5) + (size_t)L * PLE * DM, PLE, DM, DM, nullptr, MapId(), gt, nth);
    }
    prep_layer_weights(P, 0, gt, nth);
}

__device__ __forceinline__ void phase_p4(const Ptrs& P, int L, int G, int bid, int tid, bool dry = false) {
    const int lane = tid & 63, wid = tid >> 6;
    const bf16_t* HBA = (const bf16_t*)(P.ws + WS_HBA);
    const bf16_t* Y = (const bf16_t*)(P.ws + WS_R1); const float* SSQY = (const float*)(P.ws + WS_SSQY);
    bf16_t* HBB = (bf16_t*)(P.ws + WS_R3); float* RSTD1 = (float*)(P.ws + WS_RSTD1);
    const float* pg = INP(3) + (size_t)L * DM;
    f32x4 g[2][2];
#pragma unroll
    for (int i = 0; i < 2; ++i) { g[i][0] = *(const f32x4*)(pg + i * 512 + lane * 8); g[i][1] = *(const f32x4*)(pg + i * 512 + lane * 8 + 4); }
    for (int row = bid * 8 + wid; row < M; row += G * 8) {
        float s = (lane < 16) ? SSQY[(size_t)row * 16 + lane] : 0.f;
        s = wave_sum(s, lane);
        const float rsy = rsqrtf(s * (1.0f / 1024.0f) + EPS);
        float sq = 0.f;
#pragma unroll
        for (int i = 0; i < 2; ++i) { const size_t off = (size_t)row * DM + i * 512 + lane * 8;
            float yv[8], hv[8]; unpack8(*(const u32x4*)(Y + off), yv); unpack8(*(const u32x4*)(HBA + off), hv);
            float o[8];
#pragma unroll
            for (int j = 0; j < 8; ++j) { o[j] = hv[j] + yv[j] * rsy * g[i][j >> 2][j & 3]; sq += o[j] * o[j]; }
            if (!dry) *(u32x4*)(HBB + off) = pack8(o); }
        sq = wave_sum(sq, lane);
        if (lane == 0 && !dry) RSTD1[row] = rsqrtf(sq * (1.0f / 1024.0f) + EPS);
    }
    const int gt = bid * 512 + tid, nth = G * 512;
    const float* pl = INP(1) + (size_t)L * M * PLE; bf16_t* PB = (bf16_t*)(P.ws + WS_R3 + 64 * MiB);
    for (int i = gt; i < M * PLE / 8; i += nth) { const f32x4 a = *(const f32x4*)(pl + (size_t)i * 8), b = *(const f32x4*)(pl + (size_t)i * 8 + 4);
        const float o[8] = {a[0], a[1], a[2], a[3], b[0], b[1], b[2], b[3]}; *(u32x4*)(PB + (size_t)i * 8) = pack8(o); }
    if (L + 1 < DEPTH) prep_layer_weights(P, L + 1, gt, nth);
}

typedef short bf16x8 __attribute__((ext_vector_type(8)));
typedef short s16x4 __attribute__((ext_vector_type(4)));
typedef float f32x16 __attribute__((ext_vector_type(16)));
__device__ __forceinline__ bf16x8 tr_frag(const LAS3 unsigned char* img, int a0, int a1) {
    const s16x4 x = __builtin_amdgcn_ds_read_tr16_b64_v4i16((LAS3 s16x4*)(img + a0)), y = __builtin_amdgcn_ds_read_tr16_b64_v4i16((LAS3 s16x4*)(img + a1));
    return (bf16x8){x[0], x[1], x[2], x[3], y[0], y[1], y[2], y[3]};
}
constexpr int RS_K = 272, RS_V = 576, RS_KW = 320;

__device__ __forceinline__ void gm_stage_load(u32x4 (&vq)[4], const bf16_t* BV, int r0, int g, int tid) {
#pragma unroll
    for (int i = 0; i < 4; ++i) { const int e8 = tid + 512 * i, s = e8 >> 4, c8 = e8 & 15; vq[i] = *(const u32x4*)(BV + (size_t)(r0 + s) * 1024 + g * 128 + c8 * 8); }
}
__device__ __forceinline__ void gm_stage_store(const u32x4 (&vq)[4], LAS3 unsigned char* img, const LAS3 float* mu, const LAS3 float* rsd, const float* lg, const float* lb, int g, int tid) {
#pragma unroll
    for (int i = 0; i < 4; ++i) { const int e8 = tid + 512 * i, s = e8 >> 4, c8 = e8 & 15;
        float x[8]; unpack8(vq[i], x); const float m_ = mu[s], r_ = rsd[s];
        const f32x4 g0 = *(const f32x4*)(lg + g * 128 + c8 * 8), g1 = *(const f32x4*)(lg + g * 128 + c8 * 8 + 4), b0 = *(const f32x4*)(lb + g * 128 + c8 * 8), b1 = *(const f32x4*)(lb + g * 128 + c8 * 8 + 4);
#pragma unroll
        for (int q = 0; q < 8; ++q) x[q] = (x[q] - m_) * r_ * (q < 4 ? g0[q & 3] : g1[q & 3]) + (q < 4 ? b0[q & 3] : b1[q & 3]);
        *(LAS3 u32x4*)(img + s * RS_KW + c8 * 16) = pack8(x); }
}
__device__ __forceinline__ void phase_gm(LAS3 unsigned char* lds, const Ptrs& P, int j, int G, int bid, int tid_in) {
    LAS3 float* mu = (LAS3 float*)(lds + 81920); LAS3 float* rsd = mu + 128;
    const bf16_t* BV = (const bf16_t*)(P.ws + WS_R2); bf16_t* S = (bf16_t*)(P.ws + WS_R3); const bf16_t* WSB = (const bf16_t*)(P.ws + WS_WSB);
    const float* bs = INP(12) + (size_t)j * 128 * 8;
    const float* lg = INP(9) + (size_t)j * 1024; const float* lb = INP(10) + (size_t)j * 1024; const float* cwp = INP(8) + (size_t)j * 3 * 1024;
    for (int c = bid; c < M / 128; c += G) {
        int tid = tid_in; asm volatile("" : "+v"(tid));
        const int lane = tid & 63, wid = __builtin_amdgcn_readfirstlane(tid >> 6), hh = lane >> 5, l31 = lane & 31, tb = wid & 3, chf = wid >> 2;
        const int r0 = c * 128;
        u32x4 vq[4];
        gm_stage_load(vq, BV, r0, 0, tid);
#pragma unroll 2
        for (int rr = 0; rr < 16; ++rr) { const int row = wid * 16 + rr; const bf16_t* p = BV + (size_t)(r0 + row) * 1024;
            float a[8], b[8]; unpack8(*(const u32x4*)(p + lane * 8), a); unpack8(*(const u32x4*)(p + 512 + lane * 8), b);
            float s = 0.f;
#pragma unroll
            for (int q = 0; q < 8; ++q) s += a[q] + b[q];
            s = wave_sum(s, lane); const float mean = s * (1.0f / 1024.0f); float v = 0.f;
#pragma unroll
            for (int q = 0; q < 8; ++q) { const float d0 = a[q] - mean, d1 = b[q] - mean; v += d0 * d0 + d1 * d1; }
            v = wave_sum(v, lane);
            if (lane == 0) { mu[row] = mean; rsd[row] = rsqrtf(v * (1.0f / 1024.0f) + EPS); } }
        __syncthreads();
        gm_stage_store(vq, lds, mu, rsd, lg, lb, 0, tid);
        __syncthreads();
        const int blk = (lane >> 4) & 1, q4 = (lane & 15) >> 2, p4 = lane & 3;
        const int trk = (q4 + 8 * hh) * RS_KW + (chf * 64 + 16 * blk + 4 * p4) * 2;
#pragma unroll 1
        for (int g = 0; g < 8; ++g) {
            LAS3 unsigned char* cur = lds + (g & 1) * 40960; LAS3 unsigned char* nxt = lds + ((g & 1) ^ 1) * 40960;
            if (g < 7) gm_stage_load(vq, BV, r0, g + 1, tid);
            f32x16 acc[2];
#pragma unroll
            for (int cb = 0; cb < 2; ++cb)
#pragma unroll
                for (int r = 0; r < 16; ++r) acc[cb][r] = 0.f;
            const bf16_t* wrow = WSB + (size_t)g * 16384 + (size_t)(tb * 32 + l31) * 128 + 8 * hh;
#pragma unroll
            for (int ks = 0; ks < 8; ++ks) {
                if (ks <= 2 * tb + 1) {
                    const bf16x8 af = *(const bf16x8*)(wrow + 16 * ks);
#pragma unroll
                    for (int cb = 0; cb < 2; ++cb) { const bf16x8 bfr = tr_frag(cur, trk + 16 * ks * RS_KW + cb * 64, trk + (16 * ks + 4) * RS_KW + cb * 64);
                        acc[cb] = __builtin_amdgcn_mfma_f32_32x32x16_bf16(af, bfr, acc[cb], 0, 0, 0); }
                }
            }
#pragma unroll
            for (int r = 0; r < 16; ++r) { const int t = tb * 32 + (r & 3) + 8 * (r >> 2) + 4 * hh; const float bt = bs[t * 8 + g];
#pragma unroll
                for (int cb = 0; cb < 2; ++cb) S[(size_t)(r0 + t) * 1024 + g * 128 + chf * 64 + cb * 32 + l31] = f2bf(acc[cb][r] + bt); }
            if (g < 7) gm_stage_store(vq, nxt, mu, rsd, lg, lb, g + 1, tid);
            __syncthreads();
        }
        {
            const bf16_t* U = (const bf16_t*)(P.ws + WS_R1); bf16_t* CU = (bf16_t*)(P.ws + WS_R3) + (size_t)32 * MiB;
            const int cc = (tid & 127) * 8, rg = tid >> 7, rbeg = r0 + rg * 32;
            float w0[8], w1[8], w2[8];
#pragma unroll
            for (int q = 0; q < 8; ++q) { w0[q] = cwp[cc + q]; w1[q] = cwp[1024 + cc + q]; w2[q] = cwp[2048 + cc + q]; }
            const bool has1 = (rbeg & (SEQ - 1)) >= 1, has2 = (rbeg & (SEQ - 1)) >= 2;
            u32x4 pm1 = (u32x4){0u, 0u, 0u, 0u}, pm2 = (u32x4){0u, 0u, 0u, 0u};
            if (has1) pm1 = *(const u32x4*)(U + (size_t)(rbeg - 1) * 1024 + cc);
            if (has2) pm2 = *(const u32x4*)(U + (size_t)(rbeg - 2) * 1024 + cc);
#pragma unroll 1
            for (int r8 = 0; r8 < 32; r8 += 8) {
                u32x4 cur[8];
#pragma unroll
                for (int q = 0; q < 8; ++q) cur[q] = *(const u32x4*)(U + (size_t)(rbeg + r8 + q) * 1024 + cc);
#pragma unroll
                for (int q = 0; q < 8; ++q) { float a2[8], a1[8], a0[8], o[8]; unpack8(cur[q], a2); unpack8(pm1, a1); unpack8(pm2, a0);
#pragma unroll
                    for (int e = 0; e < 8; ++e) o[e] = w2[e] * a2[e] + w1[e] * a1[e] + w0[e] * a0[e];
                    *(u32x4*)(CU + (size_t)(rbeg + r8 + q) * 1024 + cc) = pack8(o); pm2 = pm1; pm1 = cur[q]; }
            }
        }
    }
}

__device__ __forceinline__ void phase_o2(LAS3 unsigned char* lds, const Ptrs& P, int j, int G, int bid, int tid_in) {
    LAS3 unsigned char* KW = lds; LAS3 unsigned char* VI = lds + 40960; LAS3 float* sc = (LAS3 float*)(lds + 40960 + 73728); LAS3 float* wv = sc + 128;
    const bf16_t* Kb = (const bf16_t*)(P.ws + WS_R2); const bf16_t* Vb = (const bf16_t*)(P.ws + WS_R3);
    const float* GATE = (const float*)(P.ws + WS_GATE); float* GB = (float*)(P.ws + WS_GB); float* CS = (float*)(P.ws + WS_CS);
    bf16_t* UC = (bf16_t*)(P.ws + WS_R4); float* NS = (float*)(P.ws + WS_NS);
    const float* bif = INP(15) + (size_t)j * 16;
    for (int unit = bid; unit < NUNIT_O; unit += G) {
        int tid = tid_in; asm volatile("" : "+v"(tid));
        const int lane = tid & 63, wid = __builtin_amdgcn_readfirstlane(tid >> 6), hh = lane >> 5, l31 = lane & 31;
        const int chain = unit >> 7, n = unit & 127, b = chain >> 3, h = chain & 7, r0 = b * SEQ + n * 128;
        u32x4 kq[4], vq[8];
#pragma unroll
        for (int i = 0; i < 4; ++i) { const int e8 = tid + 512 * i, s = e8 >> 4, k8 = e8 & 15; kq[i] = *(const u32x4*)(Kb + (size_t)(r0 + s) * 1024 + h * 128 + k8 * 8); }
#pragma unroll
        for (int i = 0; i < 8; ++i) { const int e8 = tid + 512 * i, s = e8 >> 5, v8 = e8 & 31; vq[i] = *(const u32x4*)(Vb + (size_t)(r0 + s) * 2048 + h * 256 + v8 * 8); }
        float ii = 0.f, a = 0.f;
        if (tid < 128) { const float fi = GATE[(size_t)(r0 + tid) * 16 + 8 + h] + bif[8 + h]; ii = GATE[(size_t)(r0 + tid) * 16 + h] + bif[h]; sc[tid] = logsigmoidf_(fi); }
        __syncthreads();
        for (int off = 1; off < 128; off <<= 1) { float v = 0.f; if (tid < 128) v = sc[tid] + (tid >= off ? sc[tid - off] : 0.f); __syncthreads(); if (tid < 128) sc[tid] = v; __syncthreads(); }
        const float gtot = sc[127];
        if (tid < 128) { a = gtot - sc[tid] + ii; wv[tid] = a; GB[((size_t)(r0 + tid) * 8 + h) * 2] = sc[tid]; GB[((size_t)(r0 + tid) * 8 + h) * 2 + 1] = ii; }
        __syncthreads();
        float amax = -3.0e38f;
#pragma unroll 8
        for (int t = 0; t < 128; ++t) amax = fmaxf(amax, wv[t]);
        __syncthreads();
        if (tid < 128) wv[tid] = __expf(a - amax);
        if (tid == 0) { CS[(size_t)unit * 2] = gtot; CS[(size_t)unit * 2 + 1] = amax; }
        __syncthreads();
#pragma unroll
        for (int i = 0; i < 4; ++i) { const int e8 = tid + 512 * i, s = e8 >> 4, k8 = e8 & 15;
            float kv[8]; unpack8(kq[i], kv); const float w = wv[s];
#pragma unroll
            for (int q = 0; q < 8; ++q) kv[q] *= w;
            *(LAS3 u32x4*)(KW + s * RS_KW + k8 * 16) = pack8(kv); }
#pragma unroll
        for (int i = 0; i < 8; ++i) { const int e8 = tid + 512 * i, s = e8 >> 5, v8 = e8 & 31; *(LAS3 u32x4*)(VI + s * RS_V + v8 * 16) = vq[i]; }
        __syncthreads();
        {
            const int blk = (lane >> 4) & 1, q = (lane & 15) >> 2, p = lane & 3;
            const int trv = (q + 8 * hh) * RS_V + (wid * 32 + 16 * blk + 4 * p) * 2, trk = (q + 8 * hh) * RS_KW + (16 * blk + 4 * p) * 2;
            f32x16 acc[4];
#pragma unroll
            for (int db = 0; db < 4; ++db)
#pragma unroll
                for (int r = 0; r < 16; ++r) acc[db][r] = 0.f;
#pragma unroll
            for (int ks = 0; ks < 8; ++ks) {
                const bf16x8 af = tr_frag(VI, trv + 16 * ks * RS_V, trv + (16 * ks + 4) * RS_V);
#pragma unroll
                for (int db = 0; db < 4; ++db) { const bf16x8 bfr = tr_frag(KW, trk + 16 * ks * RS_KW + db * 64, trk + (16 * ks + 4) * RS_KW + db * 64);
                    acc[db] = __builtin_amdgcn_mfma_f32_32x32x16_bf16(af, bfr, acc[db], 0, 0, 0); }
            }
            bf16_t* up = UC + (size_t)unit * 32768;
#pragma unroll
            for (int db = 0; db < 4; ++db)
#pragma unroll
                for (int r = 0; r < 16; ++r) { const int v = wid * 32 + (r & 3) + 8 * (r >> 2) + 4 * hh; up[v * 128 + db * 32 + l31] = f2bf(acc[db][r]); }
        }
        if (tid < 128) { float ns = 0.f;
#pragma unroll 8
            for (int s = 0; s < 128; ++s) ns += bf2f(*(const LAS3 bf16_t*)(KW + s * RS_KW + tid * 2));
            NS[(size_t)unit * 128 + tid] = ns; }
        __syncthreads();
    }
}

__device__ __forceinline__ void phase_o3(LAS3 unsigned char* lds, const Ptrs& P, int G, int bid, int tid, bool dry = false) {
    LAS3 float* dec = (LAS3 float*)lds; LAS3 float* scl = dec + 128; LAS3 float* gg = scl + 128; LAS3 float* am = gg + 128;
    const float* CS = (const float*)(P.ws + WS_CS); float* MS = (float*)(P.ws + WS_MS); bf16_t* UC = (bf16_t*)(P.ws + WS_R4); float* NS = (float*)(P.ws + WS_NS);
    for (int task = bid; task < 256; task += G) {
        const int chain = task >> 4, eb = task & 15;
        if (tid < 128) { gg[tid] = CS[((size_t)chain * 128 + tid) * 2]; am[tid] = CS[((size_t)chain * 128 + tid) * 2 + 1]; }
        __syncthreads();
        if (tid == 0) { float m = 0.f;
            for (int n = 0; n < 128; ++n) { const float g = gg[n], a = am[n], mn = fmaxf(g + m, a); dec[n] = __expf(g + m - mn); scl[n] = __expf(a - mn); if (eb == 0) MS[chain * 128 + n] = m; m = mn; } }
        __syncthreads();
        const size_t e = (size_t)eb * 2048 + tid * 4;
        float c0 = 0.f, c1 = 0.f, c2 = 0.f, c3 = 0.f;
        for (int n0 = 0; n0 < 128; n0 += 8) {
            u32x2 u[8];
#pragma unroll
            for (int q = 0; q < 8; ++q) u[q] = *(const u32x2*)(UC + ((size_t)chain * 128 + n0 + q) * 32768 + e);
#pragma unroll
            for (int q = 0; q < 8; ++q) { u32x2 w; w.x = pk2(c0, c1); w.y = pk2(c2, c3); if (dry) w = u[q]; *(u32x2*)(UC + ((size_t)chain * 128 + n0 + q) * 32768 + e) = w;
                const float d = dec[n0 + q], s = scl[n0 + q];
                c0 = d * c0 + s * __uint_as_float(u[q].x << 16); c1 = d * c1 + s * __uint_as_float(u[q].x & 0xffff0000u);
                c2 = d * c2 + s * __uint_as_float(u[q].y << 16); c3 = d * c3 + s * __uint_as_float(u[q].y & 0xffff0000u); }
        }
        if (eb == 0 && tid < 128) { float cn = 0.f;
            for (int n = 0; n < 128; ++n) { const size_t o = ((size_t)chain * 128 + n) * 128 + tid; const float v = NS[o]; NS[o] = dry ? v : cn; cn = dec[n] * cn + scl[n] * v; } }
        __syncthreads();
    }
}


__device__ __forceinline__ void phase_o4(LAS3 unsigned char* lds, const Ptrs& P, int j, int G, int bid, int tid_in, bool dry = false) {
    LAS3 unsigned char* RA = lds;
    LAS3 unsigned char* RB = lds + 73728;
    LAS3 float* bb = (LAS3 float*)(lds + 143360); LAS3 float* cc = bb + 128; LAS3 float* MM = cc + 128; LAS3 float* isc = MM + 128; LAS3 float* nst = isc + 128; LAS3 float* red = nst + 128;
    const bf16_t* Qb = (const bf16_t*)(P.ws + WS_R1); const bf16_t* Kb = (const bf16_t*)(P.ws + WS_R2); bf16_t* Vb = (bf16_t*)(P.ws + WS_R3);
    const bf16_t* UC = (const bf16_t*)(P.ws + WS_R4); const float* NS = (const float*)(P.ws + WS_NS); const float* MS = (const float*)(P.ws + WS_MS); const float* GB = (const float*)(P.ws + WS_GB);
    const float* mhg = INP(16) + (size_t)j * 8 * 256;
    for (int unit = bid; unit < NUNIT_O; unit += G) {
        int tid = tid_in; asm volatile("" : "+v"(tid));
        const int lane = tid & 63, wid = __builtin_amdgcn_readfirstlane(tid >> 6), hh = lane >> 5, l31 = lane & 31, tb = wid & 3, vh = wid >> 2;
        const int chain = unit >> 7, n = unit & 127, b = chain >> 3, h = chain & 7, r0 = b * SEQ + n * 128;
        const float mst = MS[chain * 128 + n];
        const int t = tb * 32 + l31;
        {
            u32x4 kq[4], cq[8];
#pragma unroll
            for (int i = 0; i < 4; ++i) { const int e8 = tid + 512 * i, s = e8 >> 4, k8 = e8 & 15; kq[i] = *(const u32x4*)(Kb + (size_t)(r0 + s) * 1024 + h * 128 + k8 * 8); }
#pragma unroll
            for (int i = 0; i < 8; ++i) { const int e8 = tid + 512 * i; cq[i] = *(const u32x4*)(UC + (size_t)unit * 32768 + (size_t)e8 * 8); }
            if (tid < 128) { const float bv = GB[((size_t)(r0 + tid) * 8 + h) * 2], iv = GB[((size_t)(r0 + tid) * 8 + h) * 2 + 1]; bb[tid] = bv; cc[tid] = iv - bv; nst[tid] = NS[(size_t)unit * 128 + tid]; }
#pragma unroll
            for (int i = 0; i < 4; ++i) { const int e8 = tid + 512 * i, s = e8 >> 4, k8 = e8 & 15; *(LAS3 u32x4*)(RA + s * RS_K + k8 * 16) = kq[i]; }
#pragma unroll
            for (int i = 0; i < 8; ++i) { const int e8 = tid + 512 * i, v = e8 >> 4, k8 = e8 & 15; *(LAS3 u32x4*)(RB + v * RS_K + k8 * 16) = cq[i]; }
        }
        bf16x8 qf[8];
#pragma unroll
        for (int ks = 0; ks < 8; ++ks) qf[ks] = *(const bf16x8*)(Qb + (size_t)(r0 + t) * 1024 + h * 128 + 16 * ks + 8 * hh);
        __syncthreads();
        if (tid < 128) { float mx = mst;
#pragma unroll 1
            for (int s = 0; s <= tid; ++s) mx = fmaxf(mx, cc[s]);
            MM[tid] = mx; isc[tid] = __expf(mst - mx); }
        f32x16 accS[4], acc[4];
#pragma unroll
        for (int sb = 0; sb < 4; ++sb) {
#pragma unroll
            for (int r = 0; r < 16; ++r) accS[sb][r] = 0.f;
            if (sb <= tb) {
#pragma unroll
                for (int ks = 0; ks < 8; ++ks) { const bf16x8 af = *(const LAS3 bf16x8*)(RA + (sb * 32 + l31) * RS_K + (16 * ks + 8 * hh) * 2); accS[sb] = __builtin_amdgcn_mfma_f32_32x32x16_bf16(af, qf[ks], accS[sb], 0, 0, 0); }
            }
        }
#pragma unroll
        for (int vb = 0; vb < 4; ++vb) {
#pragma unroll
            for (int r = 0; r < 16; ++r) acc[vb][r] = 0.f;
#pragma unroll
            for (int ks = 0; ks < 8; ++ks) { const bf16x8 af = *(const LAS3 bf16x8*)(RB + ((vh * 4 + vb) * 32 + l31) * RS_K + (16 * ks + 8 * hh) * 2); acc[vb] = __builtin_amdgcn_mfma_f32_32x32x16_bf16(af, qf[ks], acc[vb], 0, 0, 0); }
        }
        float qn = 0.f;
#pragma unroll
        for (int ks = 0; ks < 8; ++ks) { const f32x4 n0 = *(const LAS3 f32x4*)&nst[16 * ks + 8 * hh], n1 = *(const LAS3 f32x4*)&nst[16 * ks + 8 * hh + 4];
            float qv[8]; unpack8(__builtin_bit_cast(u32x4, qf[ks]), qv);
            qn += (qv[0] * n0[0] + qv[1] * n0[1]) + (qv[2] * n0[2] + qv[3] * n0[3]) + (qv[4] * n1[0] + qv[5] * n1[1]) + (qv[6] * n1[2] + qv[7] * n1[3]); }
        qn += bperm(lane ^ 32, qn);
        __syncthreads();
        u32x4 vq[8];
#pragma unroll
        for (int i = 0; i < 8; ++i) { const int e8 = tid + 512 * i, s = e8 >> 5, v8 = e8 & 31; vq[i] = *(const u32x4*)(Vb + (size_t)(r0 + s) * 2048 + h * 256 + v8 * 8); }
        const float MMt = MM[t], isct = isc[t];
        bf16x8 pf[8]; float dsum = 0.f;
#pragma unroll
        for (int sb = 0; sb < 4; ++sb) {
            u32x4 w0 = (u32x4){0u, 0u, 0u, 0u}, w1 = (u32x4){0u, 0u, 0u, 0u};
            if (sb <= tb) {
                float pv[16];
#pragma unroll
                for (int rg = 0; rg < 4; ++rg) { const f32x4 c4 = *(const LAS3 f32x4*)&cc[sb * 32 + 8 * rg + 4 * hh];
#pragma unroll
                    for (int e = 0; e < 4; ++e) { const int s = sb * 32 + 8 * rg + 4 * hh + e; const float pvv = (s <= t) ? __expf(c4[e] - MMt) * accS[sb][rg * 4 + e] : 0.f; pv[rg * 4 + e] = pvv; dsum += pvv; } }
                w0.x = pk2(pv[0], pv[1]); w0.y = pk2(pv[2], pv[3]); w0.z = pk2(pv[4], pv[5]); w0.w = pk2(pv[6], pv[7]);
                w1.x = pk2(pv[8], pv[9]); w1.y = pk2(pv[10], pv[11]); w1.z = pk2(pv[12], pv[13]); w1.w = pk2(pv[14], pv[15]);
            }
            pf[2 * sb] = __builtin_bit_cast(bf16x8, w0); pf[2 * sb + 1] = __builtin_bit_cast(bf16x8, w1);
        }
#pragma unroll
        for (int vb = 0; vb < 4; ++vb)
#pragma unroll
            for (int r = 0; r < 16; ++r) acc[vb][r] *= isct;
#pragma unroll
        for (int i = 0; i < 8; ++i) { const int e8 = tid + 512 * i, s = e8 >> 5, v8 = e8 & 31; *(LAS3 u32x4*)(RA + s * RS_V + v8 * 16) = vq[i]; }
        __syncthreads();
        {
            const int blk = (lane >> 4) & 1, q = (lane & 15) >> 2, p = lane & 3;
            const int trv = (q + 4 * hh) * RS_V + (vh * 128 + 16 * blk + 4 * p) * 2;
#pragma unroll
            for (int sp = 0; sp < 8; ++sp) {
                if (sp <= 2 * tb + 1) {
#pragma unroll
                    for (int vb = 0; vb < 4; ++vb) { const bf16x8 af = tr_frag(RA, trv + 16 * sp * RS_V + vb * 64, trv + (16 * sp + 8) * RS_V + vb * 64);
                        acc[vb] = __builtin_amdgcn_mfma_f32_32x32x16_bf16(af, pf[sp], acc[vb], 0, 0, 0); }
                }
            }
        }
        dsum += bperm(lane ^ 32, dsum);
        const float den = isct * qn + dsum, dn = fmaxf(fabsf(den), __expf(-(bb[t] + MMt))), inv = 1.0f / dn;
        float ssq = 0.f;
#pragma unroll
        for (int vb = 0; vb < 4; ++vb)
#pragma unroll
            for (int r = 0; r < 16; ++r) { acc[vb][r] *= inv; ssq += acc[vb][r] * acc[vb][r]; }
        ssq += bperm(lane ^ 32, ssq);
        if (hh == 0) red[t * 2 + vh] = ssq;
        __syncthreads();
        const float rn = rsqrtf((red[t * 2] + red[t * 2 + 1]) * (1.0f / 256.0f) + EPS);
#pragma unroll
        for (int vb = 0; vb < 4; ++vb)
#pragma unroll
            for (int rg = 0; rg < 4; ++rg) { const int v0 = (vh * 4 + vb) * 32 + 8 * rg + 4 * hh; const f32x4 g4 = *(const f32x4*)(mhg + h * 256 + v0);
                u32x2 w; w.x = pk2(acc[vb][rg * 4 + 0] * rn * g4[0], acc[vb][rg * 4 + 1] * rn * g4[1]); w.y = pk2(acc[vb][rg * 4 + 2] * rn * g4[2], acc[vb][rg * 4 + 3] * rn * g4[3]);
                if (!dry) *(u32x2*)(Vb + (size_t)(r0 + t) * 2048 + h * 256 + v0) = w; }
        __syncthreads();
    }
}

constexpr int NPHASE = 1 + 8 * DEPTH;
__host__ __device__ constexpr bool phase_exists(int ph) { return ph == 0 || !((((ph - 1) >> 3) & 1) == 0 && (((ph - 1) & 7) == 2 || ((ph - 1) & 7) == 3)); }
struct Args { const float* in[18]; float* out; unsigned char* ws; int ph_lo, ph_hi; };

__global__ void __launch_bounds__(512, 2) fwd(Args args) {
    extern __shared__ __attribute__((aligned(16))) unsigned char lds_raw[];
    LAS3 unsigned char* lds = (LAS3 unsigned char*)lds_raw;
    const int tid0 = threadIdx.x, bid = blockIdx.x, G = gridDim.x;
    const int wbase = __builtin_amdgcn_readfirstlane(tid0 & ~63);
#define REMAT_TID(t) do { unsigned z_ = 0u; asm volatile("" : "+v"(z_)); (t) = wbase + (int)__builtin_amdgcn_mbcnt_hi(~0u, __builtin_amdgcn_mbcnt_lo(~0u, z_)); } while (0)
    Ptrs P; P.out = args.out; P.ws = args.ws;
    const int lo0 = args.ph_lo, hi0 = args.ph_hi;
    const bool multi = (hi0 - lo0) > 1;
    const bool dryflag = (hi0 >= 0);
    XcdBarrier bar; bar.bar = (unsigned*)(P.ws + WS_CTL); bar.x = 0; bar.st = nullptr;
    if (multi) {
        if (tid0 < 4) ((LAS3 unsigned*)(lds + LDS_BAR_OFF))[tid0] = 0u;
        __syncthreads();
        bar = xcd_barrier_post((unsigned*)(P.ws + WS_CTL), (volatile LAS unsigned*)(lds + LDS_BAR_OFF));
    }
#ifndef PHMASK
#define PHMASK 0xFFFF
#endif
#define PHM(k) (((PHMASK) >> (k)) & 1)
#ifndef DUPMASK
#define DUPMASK 0
#endif
#define DUPN(k) ((((DUPMASK) >> (k)) & 1) ? 2 : 1)
#define RUN(ph) (lo <= (ph) && (ph) < hi)
#define SEAM(ph) do { if ((ph) + 1 < hi) xcd_barrier(bar); } while (0)
    bf16_t* const HBA = (bf16_t*)(P.ws + WS_HBA); bf16_t* const WIN = (bf16_t*)(P.ws + WS_WIN); bf16_t* const WOUT = (bf16_t*)(P.ws + WS_WOUT);
    bf16_t* const R1 = (bf16_t*)(P.ws + WS_R1); bf16_t* const R2 = (bf16_t*)(P.ws + WS_R2); bf16_t* const R3 = (bf16_t*)(P.ws + WS_R3); bf16_t* const R4 = (bf16_t*)(P.ws + WS_R4);
    float* const SSQA = (float*)(P.ws + WS_SSQA); float* const SSQY = (float*)(P.ws + WS_SSQY);

    { const int tid = tid0, lo = lo0, hi = hi0; if (PHM(0) && RUN(0)) { phase_prologue(P, G, bid, tid); SEAM(0); } }
#pragma unroll 1
    for (int L0 = 0; L0 < DEPTH; ++L0) {
        int tid, lo = lo0, hi = hi0; REMAT_TID(tid); asm volatile("" : "+s"(lo), "+s"(hi));
        const int pb = 1 + 8 * L0;
        if ((L0 & 1) == 0) {
            if (PHM(1) && RUN(pb + 0)) { int L = L0; asm volatile("" : "+s"(L)); const int j = L >> 1; (void)j; for (int rep = 0; rep < DUPN(1); ++rep) { pg8::Gemm g{HBA, WIN, M, N1A_E, DM}; pg8::StaticOrder S; S.init(M, N1A_E, G, bid);
                pg8::EpiE1a E{SSQA, R1, R2}; pg8::gemm_phase<pg8::EpiE1a, pg8::StaticOrder>(lds, g, S, E, nullptr, wbase); } SEAM(pb + 0); }
            if (PHM(2) && RUN(pb + 1)) { int L = L0; asm volatile("" : "+s"(L)); const int j = L >> 1; (void)j; for (int rep = 0; rep < DUPN(2); ++rep) phase_gm(lds, P, j, G, bid, tid); SEAM(pb + 1); }
            if (PHM(3) && RUN(pb + 4)) { int L = L0; asm volatile("" : "+s"(L)); const int j = L >> 1; (void)j; for (int rep = 0; rep < DUPN(3); ++rep) { pg8::Gemm g{HBA, WIN + (size_t)N1A_E * DM, M, N1B_E, DM}; pg8::StaticOrder S; S.init(M, N1B_E, G, bid);
                pg8::EpiE1b E{SSQA, R3 + (size_t)32 * MiB, R3, R4}; pg8::gemm_phase<pg8::EpiE1b, pg8::StaticOrder>(lds, g, S, E, nullptr, wbase); } SEAM(pb + 4); }
        } else {
            if (PHM(4) && RUN(pb + 0)) { int L = L0; asm volatile("" : "+s"(L)); const int j = L >> 1; (void)j; for (int rep = 0; rep < DUPN(4); ++rep) { pg8::Gemm g{HBA, WIN, M, N1A_O, DM}; pg8::StaticOrder S; S.init(M, N1A_O, G, bid);
                pg8::EpiO1a E{SSQA, R1, R2, R3, (float*)(P.ws + WS_GATE)}; pg8::gemm_phase<pg8::EpiO1a, pg8::StaticOrder>(lds, g, S, E, nullptr, wbase); } SEAM(pb + 0); }
            if (PHM(5) && RUN(pb + 1)) { int L = L0; asm volatile("" : "+s"(L)); const int j = L >> 1; (void)j; for (int rep = 0; rep < DUPN(5); ++rep) phase_o2(lds, P, j, G, bid, tid); SEAM(pb + 1); }
            if (PHM(6) && RUN(pb + 2)) { int L = L0; asm volatile("" : "+s"(L)); const int j = L >> 1; (void)j; if (DUPN(6) > 1) phase_o3(lds, P, G, bid, tid, dryflag); phase_o3(lds, P, G, bid, tid); SEAM(pb + 2); }
            if (PHM(7) && RUN(pb + 3)) { int L = L0; asm volatile("" : "+s"(L)); const int j = L >> 1; (void)j; if (DUPN(7) > 1) phase_o4(lds, P, j, G, bid, tid, dryflag); phase_o4(lds, P, j, G, bid, tid); SEAM(pb + 3); }
            if (PHM(8) && RUN(pb + 4)) { int L = L0; asm volatile("" : "+s"(L)); const int j = L >> 1; (void)j; for (int rep = 0; rep < DUPN(8); ++rep) { pg8::Gemm g{HBA, WIN + (size_t)N1A_O * DM, M, N1B_O, DM}; pg8::StaticOrder S; S.init(M, N1B_O, G, bid);
                pg8::EpiO1b E{SSQA, R3, R4}; pg8::gemm_phase<pg8::EpiO1b, pg8::StaticOrder>(lds, g, S, E, nullptr, wbase); } SEAM(pb + 4); }
        }
        if (PHM(9) && RUN(pb + 5)) { int L = L0; asm volatile("" : "+s"(L)); const int j = L >> 1; (void)j; for (int rep = 0; rep < DUPN(9); ++rep) { pg8::Gemm g{R4, WOUT, M, DM, 2048}; pg8::StaticOrder S; S.init(M, DM, G, bid);
            pg8::EpiOut E{R1, SSQY}; pg8::gemm_phase<pg8::EpiOut, pg8::StaticOrder>(lds, g, S, E, nullptr, wbase); } SEAM(pb + 5); }
        if (PHM(10) && RUN(pb + 6)) { int L = L0; asm volatile("" : "+s"(L)); const int j = L >> 1; (void)j; if (DUPN(10) > 1) phase_p4(P, L, G, bid, tid, dryflag); phase_p4(P, L, G, bid, tid); SEAM(pb + 6); }
        if (PHM(11) && RUN(pb + 7)) { int L = L0; asm volatile("" : "+s"(L)); const int j = L >> 1; (void)j; for (int rep = 0; rep < DUPN(11); ++rep) {
            { pg8::Gemm g{R3 + (size_t)32 * MiB, (bf16_t*)(P.ws + WS_WP) + (size_t)L * DM * PLE, M, DM, PLE}; pg8::StaticOrder S; S.init(M, DM, G, bid);
              pg8::EpiPw E{R2}; pg8::gemm_phase<pg8::EpiPw, pg8::StaticOrder>(lds, g, S, E, nullptr, wbase); }
            __syncthreads();
            { pg8::Gemm g{R3, (bf16_t*)(P.ws + WS_WG) + (size_t)L * DM * DM, M, DM, DM}; pg8::StaticOrder S; S.init(M, DM, G, bid);
              pg8::EpiGate E{(const float*)(P.ws + WS_RSTD1), R2, R3, HBA, SSQA, (L == DEPTH - 1) ? P.out : nullptr, rep + 1 < DUPN(11) ? dryflag : false}; pg8::gemm_phase<pg8::EpiGate, pg8::StaticOrder>(lds, g, S, E, nullptr, wbase); }
            __syncthreads(); }
            SEAM(pb + 7);
        }
    }
#undef RUN
#undef SEAM
}

#ifndef ONE_LAUNCH
#define ONE_LAUNCH 1
#endif
extern "C" void kernel_launch(void* const* d_in, const int* in_sizes, int n_in, void* d_out, int out_size, void* d_ws, size_t ws_size, hipStream_t stream) {
    static int grid = 0;
    if (grid == 0) {
        if (n_in != 18 || out_size != M * DM || ws_size < WS_END) { fprintf(stderr, "kernel_launch: unexpected shapes (n_in %d out %d ws %zu)\n", n_in, out_size, ws_size); grid = -1; return; }
        int dev = 0, cus = 0, per_cu = 0;
        if (hipGetDevice(&dev) != hipSuccess || hipDeviceGetAttribute(&cus, hipDeviceAttributeMultiprocessorCount, dev) != hipSuccess) { grid = -1; return; }
        if (hipFuncSetAttribute((const void*)fwd, hipFuncAttributeMaxDynamicSharedMemorySize, LDS_BYTES) != hipSuccess) { fprintf(stderr, "kernel_launch: hipFuncSetAttribute failed\n"); grid = -1; return; }
        if (hipOccupancyMaxActiveBlocksPerMultiprocessor(&per_cu, (const void*)fwd, 512, LDS_BYTES) != hipSuccess || per_cu < 1) { fprintf(stderr, "kernel_launch: occupancy query says %d\n", per_cu); }
        (void)hipGetLastError();
        grid = cus;
    }
    if (grid < 0) return;
    (void)hipMemsetAsync((char*)d_ws + WS_CTL, 0, CTL_BYTES, stream);
    Args a{};
    for (int i = 0; i < 18; ++i) a.in[i] = (const float*)d_in[i];
    a.out = (float*)d_out; a.ws = (unsigned char*)d_ws;
#if ONE_LAUNCH
    a.ph_lo = 0; a.ph_hi = NPHASE;
    hipLaunchKernelGGL(fwd, dim3(grid), dim3(512), LDS_BYTES, stream, a);
#else
    for (int ph = 0; ph < NPHASE; ++ph) { if (!phase_exists(ph)) continue; a.ph_lo = ph; a.ph_hi = ph + 1; hipLaunchKernelGGL(fwd, dim3(grid), dim3(512), LDS_BYTES, stream, a); }
#endif
}
```
